# Optimizing an MI355X kernel written in HIP

```python
import math
import jax, jax.numpy as jnp
from jax import lax
import numpy as np

D_MODEL = 1024
BATCH = 4
SEQ = 8192
DEPTH = 2

GRID_W = 64
CTX_LEN = 256
N_MIXERS = 2
N_POOL_LAYERS = (DEPTH + N_MIXERS - 1) // N_MIXERS
N_DN_LAYERS = DEPTH // N_MIXERS
POOL_WINDOWS = (2, 4, 8, 16)
N_POOL_GROUPS = 4
POOL_GC = D_MODEL // N_POOL_GROUPS
DN_HEADS = 8
DN_DK = D_MODEL // DN_HEADS
DN_DV = D_MODEL // DN_HEADS
DN_CONV_W = 4
DN_CHUNK = 64
DN_IN = 4 * D_MODEL + 4 * DN_HEADS
N_GROUPS = 4
EXPERTS_PER_GROUP = 8
N_EXPERTS = N_GROUPS * EXPERTS_PER_GROUP
TOP_K_EXPERT = 2
D_EXPERT = 512
EPS = 1e-6

kernel_name = "hybrid_pool_deltanet_hmoe_dit"


def rmsnorm(x, w):
    x32 = x.astype(jnp.float32)
    return x32 * lax.rsqrt(jnp.mean(x32 * x32, axis=-1, keepdims=True) + EPS) * w.astype(jnp.float32)


def l2norm(t):
    return t * lax.rsqrt(jnp.sum(t * t, axis=-1, keepdims=True) + EPS)


def adaln_mod(cond, w, b):
    m = jax.nn.silu(cond.astype(jnp.float32)) @ w + b
    return jnp.split(m, 6, axis=-1)


def box_mean(x, win, axis):
    n = x.shape[axis]
    cs = jnp.cumsum(x.astype(jnp.float32), axis=axis)
    cs = jnp.concatenate([jnp.zeros_like(lax.slice_in_dim(cs, 0, 1, axis=axis)), cs], axis=axis)
    t = np.arange(n)
    lo = np.maximum(t - win // 2, 0)
    hi = np.minimum(t + win // 2, n)
    shape = [1] * x.ndim
    shape[axis] = n
    cnt = jnp.asarray((hi - lo).astype(np.float32)).reshape(shape)
    return (jnp.take(cs, hi, axis=axis) - jnp.take(cs, lo, axis=axis)) / cnt


def pool_mixer(h, w_pool, b_pool, scale, rows):
    B, L, _ = h.shape
    hg = h.astype(jnp.float32).reshape(B, L, N_POOL_GROUPS, POOL_GC)
    diffs = []
    for gi, win in enumerate(POOL_WINDOWS):
        u = hg[:, :, gi, :]
        if rows is not None:
            ug = u.reshape(B, rows, GRID_W, POOL_GC)
            m = box_mean(box_mean(ug, win, 1), win, 2).reshape(B, L, POOL_GC)
        else:
            m = box_mean(u, win, 1)
        diffs.append(m - u)
    d = jnp.stack(diffs, axis=2)
    y = jnp.einsum('blgc,gce->blge', d, w_pool).reshape(B, L, D_MODEL)
    return (y + b_pool) * scale


def short_conv(u, w):
    L = u.shape[1]
    left = DN_CONV_W // 2
    right = DN_CONV_W - 1 - left
    up = jnp.pad(u, ((0, 0), (left, right), (0, 0)))
    out = up[:, 0:L] * w[0]
    for k in range(1, DN_CONV_W):
        out = out + up[:, k:k + L] * w[k]
    return out


def dn_project(h, w_in, w_conv):
    B, L, _ = h.shape
    D = D_MODEL
    p = h @ w_in
    qkv = jax.nn.silu(short_conv(p[..., :3 * D], w_conv))
    z = p[..., 3 * D:4 * D]
    ab = p[..., 4 * D:].astype(jnp.float32).reshape(B, L, 4, DN_HEADS).transpose(2, 0, 3, 1)

    def heads(t, dh):
        return t.reshape(B, L, DN_HEADS, dh).transpose(0, 2, 1, 3).astype(jnp.float32)

    q = l2norm(heads(qkv[..., :D], DN_DK)) * (DN_DK ** -0.5)
    k = l2norm(heads(qkv[..., D:2 * D], DN_DK))
    v = heads(qkv[..., 2 * D:], DN_DV)
    return q, k, v, z, ab


def gated_delta_chunked(q, k, v, beta, g, s0, need_output):
    B, H, L, dk = q.shape
    dv = v.shape[-1]
    C = DN_CHUNK
    n = L // C
    q = q.reshape(B, H, n, C, dk)
    k = k.reshape(B, H, n, C, dk)
    v = v.reshape(B, H, n, C, dv)
    beta = beta.reshape(B, H, n, C)
    gc = jnp.cumsum(g.reshape(B, H, n, C), axis=-1)
    strict = np.tril(np.ones((C, C), dtype=bool), -1)
    diff = gc[..., :, None] - gc[..., None, :]
    kb = k * beta[..., None]
    lmat = jnp.where(strict, jnp.einsum('bhnid,bhnjd->bhnij', kb, k) * jnp.exp(jnp.where(strict, diff, 0.0)), 0.0)
    rhs = jnp.concatenate([v * beta[..., None], kb * jnp.exp(gc)[..., None]], axis=-1)
    sol = lax.linalg.triangular_solve(lmat, rhs, left_side=True, lower=True, unit_diagonal=True)
    u, w = sol[..., :dv], sol[..., dv:]
    g_last = gc[..., -1]
    k_dec = k * jnp.exp(g_last[..., None] - gc)[..., None]
    xs = {'u': u, 'w': w, 'k_dec': k_dec}
    if need_output:
        incl = np.tril(np.ones((C, C), dtype=bool), 0)
        xs['qk'] = jnp.where(incl, jnp.einsum('bhnid,bhnjd->bhnij', q, k) * jnp.exp(jnp.where(incl, diff, 0.0)), 0.0)
        xs['q_dec'] = q * jnp.exp(gc)[..., None]
    xs = {name: jnp.moveaxis(t, 2, 0) for name, t in xs.items()}
    xs['g_last'] = jnp.moveaxis(g_last, 2, 0)

    def step(S, xc):
        v_new = xc['u'] - jnp.einsum('bhck,bhkv->bhcv', xc['w'], S)
        S_next = S * jnp.exp(xc['g_last'])[..., None, None] + jnp.einsum('bhck,bhcv->bhkv', xc['k_dec'], v_new)
        if need_output:
            o = jnp.einsum('bhck,bhkv->bhcv', xc['q_dec'], S) + jnp.einsum('bhij,bhjv->bhiv', xc['qk'], v_new)
            return S_next, o
        return S_next, None

    S_final, o = lax.scan(step, s0, xs)
    if need_output:
        o = jnp.moveaxis(o, 0, 2).reshape(B, H, L, dv)
    return o, S_final


def run_direction(q, k, v, a, b, a_log, dt_bias, s0, reverse, need_output):
    g = -jnp.exp(a_log)[None, :, None] * jax.nn.softplus(a + dt_bias[None, :, None])
    beta = jax.nn.sigmoid(b)
    if reverse:
        q, k, v = jnp.flip(q, 2), jnp.flip(k, 2), jnp.flip(v, 2)
        g, beta = jnp.flip(g, 2), jnp.flip(beta, 2)
    o, S = gated_delta_chunked(q, k, v, beta, g, s0, need_output)
    if reverse and need_output:
        o = jnp.flip(o, 2)
    return o, S


def dn_output(o, z, norm_w, w_out):
    B, H, L, dv = o.shape
    o = o.transpose(0, 2, 1, 3)
    o = o * lax.rsqrt(jnp.mean(o * o, axis=-1, keepdims=True) + EPS) * norm_w
    o = o * jax.nn.silu(z.astype(jnp.float32).reshape(B, L, H, dv))
    return o.reshape(B, L, H * dv) @ w_out


def deltanet_mixer(h, hc, w_in, w_conv, a_log, dt_bias, norm_w, w_out, ctx_out):
    q, k, v, z, ab = dn_project(h, w_in, w_conv)
    qc, kc, vc, zc, abc = dn_project(hc, w_in, w_conv)
    s0 = jnp.zeros((h.shape[0], DN_HEADS, DN_DK, DN_DV), jnp.float32)
    o_lat, o_ctx = None, None
    for d in range(2):
        oc_d, s_ctx = run_direction(qc, kc, vc, abc[2 * d], abc[2 * d + 1], a_log[d], dt_bias[d], s0, d == 1, ctx_out)
        o_d, _ = run_direction(q, k, v, ab[2 * d], ab[2 * d + 1], a_log[d], dt_bias[d], s_ctx, d == 1, True)
        o_lat = o_d if o_lat is None else o_lat + o_d
        if ctx_out:
            o_ctx = oc_d if o_ctx is None else o_ctx + oc_d
    y = dn_output(o_lat, z, norm_w, w_out)
    yc = dn_output(o_ctx, zc, norm_w, w_out) if ctx_out else None
    return y, yc


def hier_moe(h, w_rg, b_rg, w_re, b_re, w_gate, w_up, w_down):
    shp = h.shape
    t = h.reshape(-1, D_MODEL)
    pg = jax.nn.softmax((t @ w_rg + b_rg).astype(jnp.float32), axis=-1)
    pg_top, g_idx = lax.top_k(pg, 1)
    elog = (t @ w_re + b_re).astype(jnp.float32).reshape(-1, N_GROUPS, EXPERTS_PER_GROUP)
    elog_sel = jnp.einsum('tge,tg->te', elog, jax.nn.one_hot(g_idx[:, 0], N_GROUPS, dtype=jnp.float32))
    e_top, e_idx = lax.top_k(elog_sel, TOP_K_EXPERT)
    wts = pg_top * jax.nn.softmax(e_top, axis=-1)
    ids = g_idx * EXPERTS_PER_GROUP + e_idx
    gates = jnp.sum(jax.nn.one_hot(ids, N_EXPERTS, dtype=jnp.float32) * wts[..., None], axis=1)

    def expert(acc, xs):
        wg, wu, wd, gt = xs
        hid = jax.nn.silu(t @ wg) * (t @ wu)
        return acc + gt[:, None] * (hid @ wd), None

    acc, _ = lax.scan(expert, jnp.zeros(t.shape, jnp.float32), (w_gate, w_up, w_down, gates.T))
    return acc.reshape(shp)


def setup_inputs(seed: int = 0) -> dict:
    key = jax.random.key(seed)
    ks = jax.random.split(key, 32)
    D = D_MODEL

    def nrm(k, shape, s):
        return jax.random.normal(k, shape, jnp.float32) * s

    dt = jnp.exp(jax.random.uniform(ks[15], (N_DN_LAYERS, 2, DN_HEADS), jnp.float32,
                                    minval=math.log(1e-3), maxval=math.log(1e-1)))
    return {
        'x': nrm(ks[0], (BATCH, SEQ, D), 1.0),
        'c': nrm(ks[1], (BATCH, D), 1.0),
        'ctx': nrm(ks[2], (BATCH, CTX_LEN, D), 1.0),
        'c_ctx': nrm(ks[3], (D,), 1.0),
        'w_ada': nrm(ks[4], (DEPTH, D, 6 * D), 0.5 * D ** -0.5),
        'b_ada': nrm(ks[5], (DEPTH, 6 * D), 0.02),
        'norm_mix': 1.0 + nrm(ks[6], (DEPTH, D), 0.1),
        'norm_ffn': 1.0 + nrm(ks[7], (DEPTH, D), 0.1),
        'w_pool': nrm(ks[8], (N_POOL_LAYERS, N_POOL_GROUPS, POOL_GC, POOL_GC), POOL_GC ** -0.5),
        'b_pool': nrm(ks[9], (N_POOL_LAYERS, D), 0.02),
        'pool_scale': 1.0 + nrm(ks[10], (N_POOL_LAYERS, D), 0.1),
        'w_dn_in': nrm(ks[11], (N_DN_LAYERS, D, DN_IN), D ** -0.5),
        'w_dn_conv': nrm(ks[12], (N_DN_LAYERS, DN_CONV_W, 3 * D), DN_CONV_W ** -0.5),
        'dn_a_log': jnp.log(jax.random.uniform(ks[13], (N_DN_LAYERS, 2, DN_HEADS), jnp.float32, minval=1.0, maxval=16.0)),
        'dn_dt_bias': dt + jnp.log(-jnp.expm1(-dt)),
        'dn_norm': 1.0 + nrm(ks[14], (N_DN_LAYERS, DN_DV), 0.1),
        'w_dn_out': nrm(ks[16], (N_DN_LAYERS, D, D), D ** -0.5),
        'w_rg': nrm(ks[17], (DEPTH, D, N_GROUPS), D ** -0.5),
        'b_rg': nrm(ks[18], (DEPTH, N_GROUPS), 0.01),
        'w_re': nrm(ks[19], (DEPTH, D, N_EXPERTS), D ** -0.5),
        'b_re': nrm(ks[20], (DEPTH, N_EXPERTS), 0.01),
        'w_e_gate': nrm(ks[21], (DEPTH, N_EXPERTS, D, D_EXPERT), D ** -0.5),
        'w_e_up': nrm(ks[22], (DEPTH, N_EXPERTS, D, D_EXPERT), D ** -0.5),
        'w_e_down': nrm(ks[23], (DEPTH, N_EXPERTS, D_EXPERT, D), D_EXPERT ** -0.5),
        'norm_final': 1.0 + nrm(ks[24], (D,), 0.1),
    }


def reference(x, c, ctx, c_ctx, w_ada, b_ada, norm_mix, norm_ffn, w_pool, b_pool, pool_scale,
              w_dn_in, w_dn_conv, dn_a_log, dn_dt_bias, dn_norm, w_dn_out,
              w_rg, b_rg, w_re, b_re, w_e_gate, w_e_up, w_e_down, norm_final):
    out_dtype = x.dtype
    rows = x.shape[1] // GRID_W
    xs = x.astype(jnp.float32)
    cs = ctx.astype(jnp.float32)
    for i in range(DEPTH):
        last = i == DEPTH - 1
        j = i // N_MIXERS
        is_pool = i % N_MIXERS == 0
        sh_m, sc_m, gt_m, sh_f, sc_f, gt_f = [m[:, None, :] for m in adaln_mod(c, w_ada[i], b_ada[i])]
        csh_m, csc_m, cgt_m, csh_f, csc_f, cgt_f = adaln_mod(c_ctx, w_ada[i], b_ada[i])
        hx = rmsnorm(xs, norm_mix[i]) * (1.0 + sc_m) + sh_m
        if is_pool:
            xs = xs + gt_m * pool_mixer(hx, w_pool[j], b_pool[j], pool_scale[j], rows)
            if not last:
                hc = rmsnorm(cs, norm_mix[i]) * (1.0 + csc_m) + csh_m
                cs = cs + cgt_m * pool_mixer(hc, w_pool[j], b_pool[j], pool_scale[j], None)
        else:
            hc = rmsnorm(cs, norm_mix[i]) * (1.0 + csc_m) + csh_m
            y, yc = deltanet_mixer(hx, hc, w_dn_in[j], w_dn_conv[j], dn_a_log[j], dn_dt_bias[j],
                                   dn_norm[j], w_dn_out[j], not last)
            xs = xs + gt_m * y
            if not last:
                cs = cs + cgt_m * yc
        hx = rmsnorm(xs, norm_ffn[i]) * (1.0 + sc_f) + sh_f
        if last:
            xs = xs + gt_f * hier_moe(hx, w_rg[i], b_rg[i], w_re[i], b_re[i], w_e_gate[i], w_e_up[i], w_e_down[i])
        else:
            hc = rmsnorm(cs, norm_ffn[i]) * (1.0 + csc_f) + csh_f
            n_ctx = hc.shape[1]
            f = hier_moe(jnp.concatenate([hc, hx], axis=1), w_rg[i], b_rg[i], w_re[i], b_re[i],
                         w_e_gate[i], w_e_up[i], w_e_down[i])
            cs = cs + cgt_f * f[:, :n_ctx]
            xs = xs + gt_f * f[:, n_ctx:]
    return rmsnorm(xs, norm_final).astype(out_dtype)
```

```cpp
#include <hip/hip_runtime.h>
#include <cstdio>
#include <cstdint>

#ifndef MK_ONE_LAUNCH
#define MK_ONE_LAUNCH 1
#endif

#define GAS __attribute__((address_space(1)))
#define LAS __attribute__((address_space(3)))
typedef unsigned short bf16;
typedef short bf16x8 __attribute__((ext_vector_type(8)));
typedef short bf16x4 __attribute__((ext_vector_type(4)));
typedef float f32x4 __attribute__((ext_vector_type(4)));
typedef float f32x2 __attribute__((ext_vector_type(2)));
typedef unsigned u32x4 __attribute__((ext_vector_type(4)));
typedef unsigned u32x2 __attribute__((ext_vector_type(2)));
#define DI __device__ __forceinline__

constexpr int D = 1024, NB = 4, SEQ = 8192, CTXL = 256;
constexpr int TL = NB * SEQ;
constexpr int TC = NB * CTXL;
constexpr int T = TL + TC;
constexpr int NE = 32, DE = 512, NH = 8;
constexpr int NCID = 528;
constexpr int DN_IN = 4128;
constexpr float EPS = 1e-6f;
constexpr int CAP = T;
constexpr int NWAVES = 8, NTHR = 512;

constexpr size_t MiB = 1u << 20;
constexpr size_t WS_CTL = 0, CTL_BYTES = 1 * MiB;
constexpr size_t WS_BTP = 1 * MiB;
constexpr size_t WS_BTOUT = 1 * MiB + 512 * 1024;
constexpr size_t WS_BTIN = 3 * MiB + 512 * 1024;
constexpr size_t WS_MOD = 12 * MiB;
constexpr size_t WS_WRT = 12 * MiB + 256 * 1024;
constexpr size_t WS_WAB = 12 * MiB + 576 * 1024;
constexpr size_t WS_RSTD = 12 * MiB + 704 * 1024;
constexpr size_t WS_WR2 = 13 * MiB;
constexpr size_t WS_C0 = 13 * MiB + 512 * 1024;
constexpr size_t WS_XC = 14 * MiB;
constexpr size_t WS_TI = 18 * MiB;
constexpr size_t WS_GU = 20 * MiB;
constexpr size_t WS_DN = 84 * MiB;
constexpr size_t WS_TM = 20 * MiB;
constexpr size_t WS_AB = 86 * MiB;
constexpr size_t WS_HALO = 91 * MiB;
constexpr size_t WS_GCB = 101 * MiB;
constexpr size_t WS_HX = 116 * MiB;
constexpr size_t WS_PM = 116 * MiB;
constexpr size_t WS_XS1 = 182 * MiB;
constexpr size_t WS_XS3 = 472 * MiB;
constexpr size_t WS_DD = 182 * MiB;
constexpr size_t WS_YP = 248 * MiB;
constexpr size_t WS_Y2 = 380 * MiB;
constexpr size_t WS_HID = 248 * MiB;
constexpr size_t WS_Y = 322 * MiB;
constexpr size_t WS_PQKV = 182 * MiB;
constexpr size_t WS_Z = 380 * MiB;
constexpr size_t WS_LM = 444 * MiB;
constexpr size_t WS_O = 444 * MiB;
constexpr size_t WS_ENT = 572 * MiB;
constexpr size_t WS_END = 572 * MiB + (size_t)NE * CAP * 8;
static_assert(WS_END <= 581 * MiB, "ws map");
constexpr int CW_BAR = 4096;
constexpr int CW_CNT = 16384, CNT_STRIDE = 1024;
constexpr int LDS_BYTES = 147456;
constexpr int LDS_MISC = 131072;
constexpr int PH_N = 17;

struct Entry { int ts; float w; };
struct KP { const float* in[25]; float* out; unsigned char* ws; int ph_lo, ph_hi; };

typedef __bf16 hwbf2 __attribute__((ext_vector_type(2)));
DI unsigned f2bf(float f) { const __bf16 h = (__bf16)f; return (unsigned)__builtin_bit_cast(unsigned short, h); }
DI unsigned pk2(float lo, float hi) { const f32x2 v = {lo, hi}; const hwbf2 r = __builtin_convertvector(v, hwbf2); return __builtin_bit_cast(unsigned, r); }
DI float bflo(unsigned w) { return __builtin_bit_cast(float, w << 16); }
DI float bfhi(unsigned w) { return __builtin_bit_cast(float, w & 0xffff0000u); }
DI float bf2f(unsigned short b) { return __builtin_bit_cast(float, ((unsigned)b) << 16); }
DI void unpk8(const u32x4 q, f32x4& a, f32x4& b) { a = (f32x4){bflo(q.x), bfhi(q.x), bflo(q.y), bfhi(q.y)}; b = (f32x4){bflo(q.z), bfhi(q.z), bflo(q.w), bfhi(q.w)}; }
DI u32x4 pk8(const f32x4 a, const f32x4 b) { u32x4 q; q.x = pk2(a.x, a.y); q.y = pk2(a.z, a.w); q.z = pk2(b.x, b.y); q.w = pk2(b.z, b.w); return q; }
DI float wave_sum(float v) {
#pragma unroll
    for (int o = 1; o < 64; o <<= 1) v += __shfl_xor(v, o);
    return v;
}
DI float siluf(float x) { return x / (1.f + __expf(-x)); }
DI float sigmoidf_(float x) { return 1.f / (1.f + __expf(-x)); }
DI float softplusf_(float x) { return fmaxf(x, 0.f) + log1pf(__expf(-fabsf(x))); }

#define XB_TMO      128
#define XB_XCNT(j)  (256  + 64 * (j))
#define XB_XSUB(j)  (1280 + 64 * (j))
#define XB_XGEN(j)  (2304 + 64 * (j))
#define XB_TOP      3328
#define XB_TOPGEN   3392
#define XCD_BAR_WORDS 3456
#define XB_SPIN_CAP (1u << 18)
__device__ __forceinline__ unsigned xb_ld(unsigned* p)              { return __hip_atomic_load(p, __ATOMIC_RELAXED, __HIP_MEMORY_SCOPE_AGENT); }
__device__ __forceinline__ unsigned xb_add(unsigned* p, unsigned v) { return __hip_atomic_fetch_add(p, v, __ATOMIC_RELAXED, __HIP_MEMORY_SCOPE_AGENT); }
__device__ __forceinline__ unsigned xb_xcc_id() { return (unsigned)__builtin_amdgcn_s_getreg((3 << 11) | 20) & 0xFu; }
#define XB_SPIN(cond, bar) do { unsigned _sp = 0; while (cond) { __builtin_amdgcn_s_sleep(1); \
    if ((++_sp & 255u) == 0u) { if (xb_ld(&(bar)[XB_TMO])) break; if (_sp > XB_SPIN_CAP) { atomicAdd(&(bar)[XB_TMO], 1u); break; } } } } while (0)
struct XcdBarrier { unsigned* bar; unsigned x; volatile LAS unsigned* st; };
__device__ __forceinline__ XcdBarrier xcd_barrier_post(unsigned* bar, volatile LAS unsigned* st) {
    XcdBarrier b; b.bar = bar; b.x = xb_xcc_id(); b.st = st;
    if (threadIdx.x == 0) (void)xb_add(&bar[XB_XCNT(b.x)], 1u);
    return b;
}
__device__ __forceinline__ void xcd_barrier_complete(unsigned* bar, unsigned x, unsigned& nloc, unsigned& nx) {
    const unsigned G = gridDim.x * gridDim.y * gridDim.z;
    unsigned sum, cnt, mine, sp = 0u;
    for (;;) {
        sum = 0u; cnt = 0u; mine = 0u;
#pragma unroll
        for (unsigned j = 0; j < 16; ++j) { const unsigned c = xb_ld(&bar[XB_XCNT(j)]); sum += c; cnt += (c > 0u) ? 1u : 0u; mine = (j == x) ? c : mine; }
        if (sum == G) break;
        __builtin_amdgcn_s_sleep(1);
        if ((++sp & 255u) == 0u) { if (xb_ld(&bar[XB_TMO])) break; if (sp > XB_SPIN_CAP) { atomicAdd(&bar[XB_TMO], 1u); break; } }
    }
    nloc = mine > 0u ? mine : 1u; nx = cnt > 0u ? cnt : 1u;
}
__device__ __forceinline__ void xcd_barrier(const XcdBarrier& b) {
    asm volatile("s_waitcnt vmcnt(0)" ::: "memory");
    __syncthreads();
    if (threadIdx.x == 0) {
        unsigned* bar = b.bar;
        __builtin_amdgcn_s_waitcnt(0);
        unsigned nloc = b.st[0], nx = b.st[1];
        if (nloc == 0u) { xcd_barrier_complete(bar, b.x, nloc, nx); b.st[0] = nloc; b.st[1] = nx; }
        const unsigned old = xb_add(&bar[XB_XSUB(b.x)], 1u);
        const unsigned gen = old / nloc;
        if (old + 1u == (gen + 1u) * nloc) {
            __builtin_amdgcn_fence(__ATOMIC_RELEASE, "agent");
            asm volatile("s_waitcnt vmcnt(0)" ::: "memory");
            const unsigned og = xb_add(&bar[XB_TOP], 1u);
            const unsigned tg = og / nx;
            if (og + 1u == (tg + 1u) * nx) xb_add(&bar[XB_TOPGEN], 1u);
            else XB_SPIN(xb_ld(&bar[XB_TOPGEN]) == tg, bar);
            __builtin_amdgcn_fence(__ATOMIC_ACQUIRE, "agent");
            xb_add(&bar[XB_XGEN(b.x)], 1u);
            asm volatile("s_waitcnt vmcnt(0)" ::: "memory");
        } else {
            XB_SPIN(xb_ld(&bar[XB_XGEN(b.x)]) == gen, bar);
            __builtin_amdgcn_fence(__ATOMIC_ACQUIRE, "agent");
            asm volatile("s_waitcnt vmcnt(0)" ::: "memory");
        }
    }
    __syncthreads();
}

namespace pg8 {
constexpr int BM = 256, BK = 64, HALF = 128, HTB = HALF * BK * 2, STAGE_BYTES = 8 * HTB;
DI int lds_byte(int r, int c) { const int st = (r >> 4) * 2 + (c >> 5), rr = r & 15, cc = c & 31, ob = rr * 64 + cc * 2; return st * 1024 + (ob ^ (((ob >> 9) & 1) << 5)); }
DI void stage_rc(int b, int& R, int& C) { const int st = b / 1024, sb = b % 1024, swz = sb ^ (((sb >> 9) & 1) << 5); R = (st >> 1) * 16 + swz / 64; C = (st & 1) * 32 + (swz % 64) / 2; }
DI int perm32(int rho) { const int n = rho >> 4, i = rho & 15; return 8 * (i >> 2) + 4 * n + (i & 3); }
struct Unit { int pm, pn, e, rt, nvalid; };
struct Gemm { const bf16* A; const bf16* Bt; int K; };

template <class Epi, class Sched, bool GATHER>
DI void gemm_phase(LAS unsigned char* lds, const Gemm g, const Sched& S, const Epi& E) {
    const int tid = threadIdx.x, wid = __builtin_amdgcn_readfirstlane(tid >> 6), lane = tid & 63, wr = wid >> 2, wc = wid & 3, fr = lane & 15, fq = lane >> 4;
    const int K = g.K, nt = K / BK;
    unsigned voffA[2], voffB[2]; int Rr[2], Cc[2];
#pragma unroll
    for (int i = 0; i < 2; ++i) { int R, C; stage_rc(tid * 16 + i * 8192, R, C); const int Rb = Epi::PERM ? ((R & ~31) + perm32(R & 31)) : R;
        voffA[i] = (unsigned)(R * K + C) * 2u; voffB[i] = (unsigned)((Epi::PERM ? (64 * (R >> 5) + perm32(R & 31)) : Rb) * K + C) * 2u; Rr[i] = R; Cc[i] = C; }
    const size_t kstep = (size_t)(BK * 2);
    const size_t hstep = (size_t)HALF * K * 2;
    const size_t tstep = 2 * hstep;
    const size_t hstepB = Epi::PERM ? (size_t)32 * K * 2 : hstep;
    const unsigned ldsw = (unsigned)wid * 1024u;
    const int aoff = lds_byte(wr * 64 + fr, fq * 8), boff = lds_byte(wc * 32 + fr, fq * 8);
#define PG8_SA(b, h) (((b) * 2 + (h)) * HTB)
#define PG8_SB(b, h) ((4 + (b) * 2 + (h)) * HTB)
#define PG8_STAGE(bufoff, gbase, voff) do { _Pragma("unroll") for (int _i = 0; _i < 2; ++_i) \
        __builtin_amdgcn_global_load_lds((const unsigned*)((const char*)(gbase) + (voff)[_i]), (LAS unsigned*)(lds + (bufoff) + ldsw + _i * 8192), 16, 0, 0); } while (0)
#define PG8_STAGE_A(bufoff, ptr, offs, h, kb) do { _Pragma("unroll") for (int _i = 0; _i < 2; ++_i) { \
        const char* _src = GATHER ? ((const char*)g.A + (offs)[(h) * 2 + _i] + (kb)) : ((const char*)(ptr) + voffA[_i]); \
        __builtin_amdgcn_global_load_lds((const unsigned*)_src, (LAS unsigned*)(lds + (bufoff) + ldsw + _i * 8192), 16, 0, 0); } } while (0)
#define PG8_LDA(dst, b, h) do { _Pragma("unroll") for (int m = 0; m < 4; ++m) _Pragma("unroll") for (int k = 0; k < 2; ++k) dst[m][k] = *(const LAS bf16x8*)(lds + PG8_SA(b, h) + aoff + m * 2048 + k * 1024); } while (0)
#define PG8_LDB(dst, b, h) do { _Pragma("unroll") for (int n = 0; n < 2; ++n) _Pragma("unroll") for (int k = 0; k < 2; ++k) dst[n][k] = *(const LAS bf16x8*)(lds + PG8_SB(b, h) + boff + n * 2048 + k * 1024); } while (0)
#define PG8_MMA(ai, bj, At, Bt) do { __builtin_amdgcn_s_setprio(1); _Pragma("unroll") for (int m = 0; m < 4; ++m) _Pragma("unroll") for (int n = 0; n < 2; ++n) _Pragma("unroll") for (int k = 0; k < 2; ++k) \
        acc[ai][bj][m][n] = __builtin_amdgcn_mfma_f32_16x16x32_bf16(Bt[n][k], At[m][k], acc[ai][bj][m][n], 0, 0, 0); __builtin_amdgcn_s_setprio(0); } while (0)
#define PG8_WAIT_V(n) asm volatile("s_waitcnt vmcnt(" #n ")" ::: "memory")
#define PG8_WAIT_L(n) asm volatile("s_waitcnt lgkmcnt(" #n ")" ::: "memory")
#define PG8_BAR __builtin_amdgcn_s_barrier()
#define PG8_SCHED __builtin_amdgcn_sched_barrier(0)
#define PG8_OFFS(u, o) do { _Pragma("unroll") for (int _h = 0; _h < 2; ++_h) _Pragma("unroll") for (int _i = 0; _i < 2; ++_i) (o)[_h * 2 + _i] = S.row_off((u), _h * HALF + Rr[_i]) + (unsigned)Cc[_i] * 2u; } while (0)
    Unit cur, nxt; int ui = 0;
    if (!S.next(0, cur)) return;
    f32x4 acc[2][2][4][2];
#pragma unroll
    for (int a = 0; a < 2; ++a)
#pragma unroll
        for (int b = 0; b < 2; ++b)
#pragma unroll
            for (int m = 0; m < 4; ++m)
#pragma unroll
                for (int n = 0; n < 2; ++n) acc[a][b][m][n] = (f32x4){0.f, 0.f, 0.f, 0.f};
    bf16x8 At[4][2], B0[2][2], B1[2][2];
    unsigned oc[4] = {0u, 0u, 0u, 0u}, on[4] = {0u, 0u, 0u, 0u};
    const char* cA = GATHER ? (const char*)g.A : (const char*)g.A + (size_t)cur.pm * tstep; const char* cB = (const char*)g.Bt + (size_t)cur.pn * tstep;
    if (GATHER) PG8_OFFS(cur, oc);
    PG8_STAGE(PG8_SB(0, 0), cB, voffB); PG8_STAGE_A(PG8_SA(0, 0), cA, oc, 0, 0); PG8_STAGE(PG8_SB(0, 1), cB + hstepB, voffB); PG8_STAGE_A(PG8_SA(0, 1), cA + hstep, oc, 1, 0);
    if (wr == 1) PG8_BAR;
    PG8_WAIT_V(4); PG8_BAR;
    PG8_STAGE(PG8_SB(1, 0), cB + kstep, voffB); PG8_STAGE_A(PG8_SA(1, 0), cA + kstep, oc, 0, kstep); PG8_STAGE(PG8_SB(1, 1), cB + hstepB + kstep, voffB);
    PG8_WAIT_V(6); PG8_BAR;
    for (;;) {
        const bool has_next = S.next(ui + 1, nxt);
        const char* nA = GATHER ? cA : (has_next ? (const char*)g.A + (size_t)nxt.pm * tstep : cA); const char* nB = has_next ? (const char*)g.Bt + (size_t)nxt.pn * tstep : cB;
        if (GATHER) { if (has_next) PG8_OFFS(nxt, on); else {
#pragma unroll
            for (int q = 0; q < 4; ++q) on[q] = oc[q]; } }
        for (int t = 0; t < nt; t += 2) {
            const bool last = (t == nt - 2);
            const char* a1 = cA + (size_t)(t + 1) * kstep;
            const char* a2 = last ? nA : cA + (size_t)(t + 2) * kstep; const char* b2 = last ? nB : cB + (size_t)(t + 2) * kstep;
            const char* a3 = a2 + kstep; const char* b3 = b2 + kstep;
            const size_t k1 = (size_t)(t + 1) * kstep, k2 = last ? (size_t)0 : (size_t)(t + 2) * kstep, k3 = k2 + kstep;
            unsigned o2[4];
#pragma unroll
            for (int q = 0; q < 4; ++q) o2[q] = last ? on[q] : oc[q];
            PG8_LDB(B0, 0, 0); PG8_SCHED; PG8_LDA(At, 0, 0); PG8_STAGE_A(PG8_SA(1, 1), a1 + hstep, oc, 1, k1);
            PG8_WAIT_L(8); PG8_BAR; PG8_WAIT_L(0); PG8_MMA(0, 0, At, B0); PG8_BAR; PG8_SCHED;
            PG8_LDB(B1, 0, 1); PG8_STAGE(PG8_SB(0, 0), b2, voffB);
            PG8_BAR; PG8_WAIT_L(0); PG8_MMA(0, 1, At, B1); PG8_BAR;
            PG8_LDA(At, 0, 1); PG8_STAGE_A(PG8_SA(0, 0), a2, o2, 0, k2);
            PG8_BAR; PG8_WAIT_L(0); PG8_MMA(1, 0, At, B0); PG8_BAR; PG8_SCHED;
            PG8_STAGE(PG8_SB(0, 1), b2 + hstepB, voffB);
            PG8_WAIT_V(6); PG8_BAR; PG8_MMA(1, 1, At, B1); PG8_BAR;
            PG8_LDB(B0, 1, 0); PG8_SCHED; PG8_LDA(At, 1, 0); PG8_STAGE_A(PG8_SA(0, 1), a2 + hstep, o2, 1, k2);
            PG8_WAIT_L(8); PG8_BAR; PG8_WAIT_L(0); PG8_MMA(0, 0, At, B0); PG8_BAR; PG8_SCHED;
            PG8_LDB(B1, 1, 1); PG8_STAGE(PG8_SB(1, 0), b3, voffB);
            PG8_BAR; PG8_WAIT_L(0); PG8_MMA(0, 1, At, B1); PG8_BAR;
            PG8_LDA(At, 1, 1); PG8_STAGE_A(PG8_SA(1, 0), a3, o2, 0, k3);
            PG8_BAR; PG8_WAIT_L(0); PG8_MMA(1, 0, At, B0); PG8_BAR; PG8_SCHED;
            PG8_STAGE(PG8_SB(1, 1), b3 + hstepB, voffB);
            PG8_WAIT_V(6); PG8_BAR; PG8_MMA(1, 1, At, B1); PG8_BAR;
        }
        E(acc, cur, wr, wc, fr, fq);
        if (!has_next) break;
#pragma unroll
        for (int a = 0; a < 2; ++a)
#pragma unroll
            for (int b = 0; b < 2; ++b)
#pragma unroll
                for (int m = 0; m < 4; ++m)
#pragma unroll
                    for (int n = 0; n < 2; ++n) acc[a][b][m][n] = (f32x4){0.f, 0.f, 0.f, 0.f};
        cur = nxt; cA = nA; cB = nB; ++ui;
#pragma unroll
        for (int q = 0; q < 4; ++q) oc[q] = on[q];
    }
    PG8_WAIT_V(0);
    if (wr == 0) PG8_BAR;
    PG8_BAR;
#undef PG8_SA
#undef PG8_SB
#undef PG8_STAGE
#undef PG8_STAGE_A
#undef PG8_LDA
#undef PG8_LDB
#undef PG8_MMA
#undef PG8_WAIT_V
#undef PG8_WAIT_L
#undef PG8_BAR
#undef PG8_SCHED
#undef PG8_OFFS
}
}
using pg8::Unit;

struct Frame {
    LAS unsigned char* lds;
    int tid, lane, wave, bid, G;
    unsigned char* ws; float* out;
};
DI float* xs_row(const Frame& F, int t) { return t < TL ? F.out + (size_t)t * D : (float*)(F.ws + WS_XC) + (size_t)(t - TL) * D; }
DI int mod_row(int t) { return t < TL ? (t >> 13) : 4; }
DI const float* modp(const Frame& F, int l, int r, int chunk) { return (const float*)(F.ws + WS_MOD) + ((size_t)(l * 5 + r) * 6 + chunk) * D; }

DI void tr_item(const float* W, int N, int k0, int n0, bf16* WT, int K, int drow0, LAS float* scr, int lane) {
    float wv[32];
#pragma unroll
    for (int i = 0; i < 32; ++i) wv[i] = W[(size_t)(k0 + 2 * i + (lane >> 5)) * N + n0 + (lane & 31)];
#pragma unroll
    for (int i = 0; i < 32; ++i) scr[(2 * i + (lane >> 5)) * 33 + (lane & 31)] = wv[i];
    asm volatile("s_waitcnt lgkmcnt(0)" ::: "memory");
    const int c = lane & 7;
#pragma unroll
    for (int j = 0; j < 4; ++j) { const int n = (lane >> 3) + 8 * j; const LAS float* s = scr + (8 * c) * 33 + n;
        u32x4 o; o.x = pk2(s[0 * 33], s[1 * 33]); o.y = pk2(s[2 * 33], s[3 * 33]); o.z = pk2(s[4 * 33], s[5 * 33]); o.w = pk2(s[6 * 33], s[7 * 33]);
        *(u32x4*)(WT + (size_t)(drow0 + n) * K + k0 + 8 * c) = o; }
    asm volatile("s_waitcnt lgkmcnt(0)" ::: "memory");
}
DI void convert_experts(const Frame& F, const KP& p, int l) {
    LAS float* scr = (LAS float*)(F.lds + F.wave * 16384);
    const int gw = F.bid * NWAVES + F.wave, NGW = F.G * NWAVES;
    const float* wg = p.in[21] + (size_t)l * NE * D * DE; const float* wu = p.in[22] + (size_t)l * NE * D * DE; const float* wd = p.in[23] + (size_t)l * NE * DE * D;
    bf16* GU = (bf16*)(F.ws + WS_GU); bf16* DN = (bf16*)(F.ws + WS_DN);
    for (int it = gw; it < 3 * 8192; it += NGW) {
        const int which = it >> 13, r8 = it & 8191, e = r8 >> 8, r = r8 & 255;
        if (which < 2) { const int kb = r >> 4, nb = r & 15, n0 = 32 * nb;
            tr_item((which ? wu : wg) + (size_t)e * D * DE, DE, 64 * kb, n0, GU, D, e * 1024 + 256 * (n0 >> 7) + 64 * ((n0 & 127) >> 5) + (which ? 32 : 0), scr, F.lane); }
        else { const int kb = r >> 5, nb = r & 31, n0 = 32 * nb;
            tr_item(wd + (size_t)e * DE * D, D, 64 * kb, n0, DN, DE, e * 1024 + n0, scr, F.lane); }
    }
}
DI void p0_prologue(const Frame& F, const KP& p) {
    const int gw = F.bid * NWAVES + F.wave, NGW = F.G * NWAVES;
    {
        LAS float* sc = (LAS float*)(F.lds);
        LAS float* part = (LAS float*)(F.lds + 32768);
        for (int i = F.tid; i < 5 * D; i += NTHR) { const int r = i >> 10, k = i & 1023; const float v = r < 4 ? p.in[1][r * D + k] : p.in[3][k]; sc[i] = siluf(v); }
        __syncthreads();
        for (int item = F.bid; item < 192; item += F.G) {
            const int l = item / 96, n0 = (item % 96) * 64;
            const float* w = p.in[4] + (size_t)l * D * 6144 + n0 + F.lane;
            float a0 = 0.f, a1 = 0.f, a2 = 0.f, a3 = 0.f, a4 = 0.f;
            const int kb = F.wave * 128;
#pragma unroll 32
            for (int k = 0; k < 128; ++k) { const float wv = w[(size_t)(kb + k) * 6144];
                a0 += sc[kb + k] * wv; a1 += sc[D + kb + k] * wv; a2 += sc[2 * D + kb + k] * wv; a3 += sc[3 * D + kb + k] * wv; a4 += sc[4 * D + kb + k] * wv; }
            part[(F.wave * 5 + 0) * 64 + F.lane] = a0; part[(F.wave * 5 + 1) * 64 + F.lane] = a1; part[(F.wave * 5 + 2) * 64 + F.lane] = a2;
            part[(F.wave * 5 + 3) * 64 + F.lane] = a3; part[(F.wave * 5 + 4) * 64 + F.lane] = a4;
            __syncthreads();
            if (F.tid < 320) { const int r = F.tid >> 6, n = F.tid & 63; float s = p.in[5][l * 6144 + n0 + n];
#pragma unroll
                for (int w8 = 0; w8 < 8; ++w8) s += part[(w8 * 5 + r) * 64 + n];
                ((float*)(F.ws + WS_MOD))[(size_t)(l * 5 + r) * 6144 + n0 + n] = s; }
            __syncthreads();
        }
        __syncthreads();
    }
    {
        LAS float* scr = (LAS float*)(F.lds + F.wave * 16384);
        constexpr int I_POOL = 128, I_IN = 2048 + 16, I_OUT = 512;
        for (int it = gw; it < I_POOL + I_IN + I_OUT; it += NGW) {
            int r = it;
            if (r < I_POOL) { const int g = r >> 5, q = r & 31, kb = q >> 3, nb = q & 7; tr_item(p.in[8] + (size_t)g * 65536, 256, 64 * kb, 32 * nb, (bf16*)(F.ws + WS_BTP), 256, g * 256 + 32 * nb, scr, F.lane); continue; }
            r -= I_POOL;
            if (r < I_IN) { const int kb = r < 2048 ? (r >> 7) : (r - 2048), nb = r < 2048 ? (r & 127) : 128; tr_item(p.in[11], DN_IN, 64 * kb, 32 * nb, (bf16*)(F.ws + WS_BTIN), D, 32 * nb, scr, F.lane); continue; }
            r -= I_IN;
            { const int kb = r >> 5, nb = r & 31; tr_item(p.in[16], D, 64 * kb, 32 * nb, (bf16*)(F.ws + WS_BTOUT), D, 32 * nb, scr, F.lane); }
        }
    }
    {
        const int gt = F.bid * NTHR + F.tid, NGT = F.G * NTHR;
        bf16* wr2 = (bf16*)(F.ws + WS_WR2);
        for (int i = gt; i < 2 * 48 * D; i += NGT) { const int l = i / (48 * D), r = i % (48 * D), j = r >> 10, k = r & 1023;
            const float w = j < 4 ? p.in[17][((size_t)l * D + k) * 4 + j] : (j < 36 ? p.in[19][((size_t)l * D + k) * 32 + (j - 4)] : 0.f);
            const unsigned hi = f2bf(w); const float rem = w - bf2f((unsigned short)hi);
            wr2[(size_t)(l * 2 + 0) * 48 * D + r] = (bf16)hi; wr2[(size_t)(l * 2 + 1) * 48 * D + r] = (bf16)f2bf(rem); }
        u32x4* zr = (u32x4*)((bf16*)(F.ws + WS_BTIN) + (size_t)4128 * D);
        for (int i = gt; i < 224 * D / 8; i += NGT) zr[i] = (u32x4){0u, 0u, 0u, 0u};
    }
    {
        float* rs = (float*)(F.ws + WS_RSTD);
        for (int t = gw; t < T; t += NGW) {
            const f32x4* xr = (const f32x4*)(t < TL ? p.in[0] + (size_t)t * D : p.in[2] + (size_t)(t - TL) * D) + F.lane;
            float s = 0.f;
#pragma unroll
            for (int j = 0; j < 4; ++j) { const f32x4 v = xr[64 * j]; s += (v.x * v.x + v.y * v.y) + (v.z * v.z + v.w * v.w); }
            s = wave_sum(s);
            if (F.lane == 0) rs[t] = rsqrtf(s * (1.f / D) + EPS);
        }
    }
}

DI void p1_pool_diff(const Frame& F, const KP& p) {
    const float* rs = (const float*)(F.ws + WS_RSTD);
    bf16* DD = (bf16*)(F.ws + WS_DD);
    LAS f32x4* Vs = (LAS f32x4*)(F.lds);
    const int ch4 = F.tid & 63, cg = F.tid >> 6;
    {
        const int gw = F.bid * NWAVES + F.wave;
        if (gw < 2 * 5 * 36) { const int l = gw / 180, q = gw % 180, r = q / 36, j = q % 36; const float* b2 = modp(F, l, r, 3); float s = 0.f;
            for (int i = 0; i < 16; ++i) { const int c = F.lane + 64 * i; const float w = j < 4 ? p.in[17][((size_t)l * D + c) * 4 + j] : p.in[19][((size_t)l * D + c) * 32 + (j - 4)]; s += b2[c] * w; }
            s = wave_sum(s);
            if (F.lane == 0) ((float*)(F.ws + WS_C0))[(l * 5 + r) * 48 + j] = s + (j < 4 ? p.in[18][l * 4 + j] : p.in[20][l * 32 + (j - 4)]); }
    }
    LAS float* rsl = (LAS float*)(F.lds + 65536);
    for (int it = F.bid; it < 256 + 64; it += F.G) {
        if (it < 256) {
            const int g = it & 3, bb = it >> 2, b = bb >> 4, r0 = (bb & 15) * 8, hw = 1 << g;
            const int ch = g * 256 + 4 * ch4;
            f32x4 A4 = *(const f32x4*)(p.in[6] + ch); { const f32x4 s4 = *(const f32x4*)(modp(F, 0, b, 1) + ch); A4 = A4 * (s4 + 1.f); }
            const int rlo = max(r0 - hw, 0), rhi = min(r0 + 8 + hw, 128);
            for (int i = F.tid; i < (rhi - rlo) * 64; i += NTHR) rsl[i] = rs[b * SEQ + rlo * 64 + i];
            __syncthreads();
            const float* xb = p.in[0] + (size_t)b * SEQ * D + ch + (size_t)(8 * cg) * D;
            f32x4 S[8];
#pragma unroll
            for (int cc = 0; cc < 8; ++cc) S[cc] = (f32x4){0.f, 0.f, 0.f, 0.f};
            for (int rr = rlo; rr < min(r0 + hw, 128); ++rr) {
#pragma unroll
                for (int cc = 0; cc < 8; ++cc) S[cc] += *(const f32x4*)(xb + (size_t)(rr * 64 + cc) * D) * rsl[(rr - rlo) * 64 + 8 * cg + cc]; }
            for (int r = r0; r < r0 + 8; ++r) {
                const int lo_r = max(r - hw, 0), hi_r = min(r + hw, 128);
                f32x4 xc[8], xa[8], xs_[8];
                const bool ha = (r + hw) < 128, hs = (r - hw) >= 0;
#pragma unroll
                for (int cc = 0; cc < 8; ++cc) { xc[cc] = *(const f32x4*)(xb + (size_t)(r * 64 + cc) * D);
                    xa[cc] = ha ? *(const f32x4*)(xb + (size_t)((r + hw) * 64 + cc) * D) : (f32x4){0.f, 0.f, 0.f, 0.f};
                    xs_[cc] = hs ? *(const f32x4*)(xb + (size_t)((r - hw) * 64 + cc) * D) : (f32x4){0.f, 0.f, 0.f, 0.f}; }
#pragma unroll
                for (int cc = 0; cc < 8; ++cc) Vs[(8 * cg + cc) * 64 + ch4] = S[cc];
                __syncthreads();
                f32x4 h = {0.f, 0.f, 0.f, 0.f};
                { const int c0 = 8 * cg, l0 = max(c0 - hw, 0), h0 = min(c0 + hw, 64); for (int c2 = l0; c2 < h0; ++c2) h += Vs[c2 * 64 + ch4]; }
#pragma unroll
                for (int cc = 0; cc < 8; ++cc) { const int col = 8 * cg + cc, lo_c = max(col - hw, 0), hi_c = min(col + hw, 64);
                    if (cc > 0) { if (col + hw <= 64) h += Vs[(col + hw - 1) * 64 + ch4]; if (col - hw > 0) h -= Vs[(col - hw - 1) * 64 + ch4]; }
                    const int t = b * SEQ + r * 64 + col; const float inv = 1.f / (float)((hi_r - lo_r) * (hi_c - lo_c));
                    const f32x4 xn = xc[cc] * rsl[(r - rlo) * 64 + col];
                    const f32x4 d = A4 * (h * inv - xn);
                    u32x2 o; o.x = pk2(d.x, d.y); o.y = pk2(d.z, d.w);
                    *(u32x2*)(DD + ((size_t)g * T + t) * 256 + 4 * ch4) = o; }
#pragma unroll
                for (int cc = 0; cc < 8; ++cc) { if (ha) S[cc] += xa[cc] * rsl[(r + hw - rlo) * 64 + 8 * cg + cc]; if (hs) S[cc] -= xs_[cc] * rsl[(r - hw - rlo) * 64 + 8 * cg + cc]; }
                __syncthreads();
            }
        } else {
            const int i2 = it - 256, g = i2 & 3, b = (i2 >> 2) & 3, q4 = i2 >> 4, hw = 1 << g;
            const int ch = g * 256 + 4 * ch4;
            f32x4 A4 = *(const f32x4*)(p.in[6] + ch); { const f32x4 s4 = *(const f32x4*)(modp(F, 0, 4, 1) + ch); A4 = A4 * (s4 + 1.f); }
#pragma unroll
            for (int cc = 0; cc < 8; ++cc) { const int j = 64 * q4 + 8 * cg + cc, lo = max(j - hw, 0), hi = min(j + hw, CTXL); f32x4 a = {0.f, 0.f, 0.f, 0.f};
                for (int jj = lo; jj < hi; ++jj) a += *(const f32x4*)(p.in[2] + (size_t)(b * CTXL + jj) * D + ch) * rs[TL + b * CTXL + jj];
                const int t = TL + b * CTXL + j; const float inv = 1.f / (float)(hi - lo);
                const f32x4 xn = *(const f32x4*)(p.in[2] + (size_t)(b * CTXL + j) * D + ch) * rs[t];
                const f32x4 d = A4 * (a * inv - xn);
                u32x2 o; o.x = pk2(d.x, d.y); o.y = pk2(d.z, d.w);
                *(u32x2*)(DD + ((size_t)g * T + t) * 256 + 4 * ch4) = o; }
        }
    }
}

struct PoolOrder {
    int G, c;
    DI bool next(int i, Unit& u) const { const int L = i * G + c; if (L >= 528) return false; u.pm = L; u.pn = L / 132; u.e = 0; u.rt = 0; u.nvalid = 0; return true; }
    DI unsigned row_off(const Unit&, int) const { return 0u; }
};
struct G1Order {
    int G, c;
    DI bool next(int i, Unit& u) const {
        if (G == 256) { if (i < 8) { const int x = c & 7, j = c >> 3; u.pm = (i * 8 + x) * 2 + (j >> 4); u.pn = j & 15; }
            else { const int q = (i - 8) * 256 + c; if (q >= 48 + 132) return false; if (q < 48) { u.pm = 128 + q / 12; u.pn = q % 12; } else { u.pm = q - 48; u.pn = 16; } } }
        else { const int L = i * G + c; if (L >= 2176 + 52) return false;
            if (L < 2176) { u.pm = L / 17; u.pn = L % 17; } else { const int q = L - 2176, q13 = q % 13; u.pm = 128 + q / 13; u.pn = q13 < 12 ? q13 : 16; } }
        u.e = 0; u.rt = 0; u.nvalid = 0; return true; }
    DI unsigned row_off(const Unit&, int) const { return 0u; }
};
struct G2Order {
    int G, c;
    DI bool next(int i, Unit& u) const {
        if (G == 256) { if (i >= 2) return false; const int x = c & 7, j = c >> 3; u.pm = (i * 8 + x) * 8 + (j >> 2); u.pn = j & 3; }
        else { const int L = i * G + c; if (L >= 512) return false; u.pm = L >> 2; u.pn = L & 3; }
        u.e = 0; u.rt = 0; u.nvalid = 0; return true; }
    DI unsigned row_off(const Unit&, int) const { return 0u; }
};
struct MoeOrder {
    int G, c, total; const LAS int* tb; const LAS int* cn; const Entry* ent;
    DI bool next(int i, Unit& u) const { int rtg, ct;
        if (G == 256) { const int x = c & 7, j = c >> 3; ct = j & 3; rtg = 64 * i + 8 * x + (j >> 2); if (rtg >= total) return false; }
        else { const int L = i * G + c; if (L >= 4 * total) return false; rtg = L >> 2; ct = L & 3; }
        int e = 0;
        for (int q = 1; q < NE; ++q) e += (tb[q] <= rtg) ? 1 : 0;
        u.pm = rtg; u.pn = e * 4 + ct; u.e = e; u.rt = rtg - tb[e]; u.nvalid = cn[e] - u.rt * 256; return true; }
    DI unsigned row_off(const Unit& u, int row) const { int tok = 0; if (row < u.nvalid) tok = ent[(size_t)u.e * CAP + u.rt * 256 + row].ts >> 1; return (unsigned)tok * (unsigned)(D * 2); }
};
DI void moe_tables(const Frame& F, int l, LAS int* tb, LAS int* cn) {
    if (F.tid < 64) { const unsigned* cnt = (const unsigned*)(F.ws + WS_CTL) + CW_CNT + l * 32 * CNT_STRIDE;
        const int c = F.tid < NE ? (int)__hip_atomic_load(cnt + F.tid * CNT_STRIDE, __ATOMIC_RELAXED, __HIP_MEMORY_SCOPE_AGENT) : 0;
        const int ntl = (c + 255) >> 8; int inc = ntl;
#pragma unroll
        for (int o = 1; o < 32; o <<= 1) { const int up = __shfl_up(inc, o); if (F.lane >= o) inc += up; }
        if (F.tid < NE) { cn[F.tid] = c; tb[F.tid] = inc - ntl; if (F.tid == NE - 1) tb[NE] = inc; } }
    __syncthreads();
}

struct EpiRaw {
    static constexpr bool PERM = true;
    bf16* o; int pool;
    DI void operator()(const f32x4 (&acc)[2][2][4][2], const Unit& u, int, int, int, int) const {
        int tz = threadIdx.x; asm volatile("" : "+v"(tz)); const int wr = tz >> 8, wc = (tz >> 6) & 3, fr = tz & 15, fq = (tz >> 4) & 3;
        const int rt = pool ? u.pm - 132 * u.pn : u.pm;
#pragma unroll
        for (int ai = 0; ai < 2; ++ai)
#pragma unroll
            for (int m = 0; m < 4; ++m) { bf16* dst = o + (size_t)(rt * 256 + ai * 128 + wr * 64 + m * 16 + fr) * D + u.pn * 256 + wc * 64 + 8 * fq;
#pragma unroll
                for (int bj = 0; bj < 2; ++bj) { const f32x4 v0 = acc[ai][bj][m][0], v1 = acc[ai][bj][m][1];
                    u32x4 w; w.x = pk2(v0.x, v0.y); w.y = pk2(v0.z, v0.w); w.z = pk2(v1.x, v1.y); w.w = pk2(v1.z, v1.w);
                    *(u32x4*)(dst + bj * 32) = w; } }
    }
};
struct EpiGU {
    static constexpr bool PERM = true;
    bf16* hid;
    DI void operator()(const f32x4 (&acc)[2][2][4][2], const Unit& u, int, int, int, int) const {
        int tz = threadIdx.x; asm volatile("" : "+v"(tz)); const int wr = tz >> 8, wc = (tz >> 6) & 3, fr = tz & 15, fq = (tz >> 4) & 3;
        const int ct = u.pn & 3;
#pragma unroll
        for (int ai = 0; ai < 2; ++ai)
#pragma unroll
            for (int m = 0; m < 4; ++m) { const size_t row = (size_t)u.pm * 256 + ai * 128 + wr * 64 + m * 16 + fr;
                const f32x4 g0 = acc[ai][0][m][0], g1 = acc[ai][0][m][1], u0 = acc[ai][1][m][0], u1 = acc[ai][1][m][1];
                u32x4 w; w.x = pk2(siluf(g0.x) * u0.x, siluf(g0.y) * u0.y); w.y = pk2(siluf(g0.z) * u0.z, siluf(g0.w) * u0.w);
                w.z = pk2(siluf(g1.x) * u1.x, siluf(g1.y) * u1.y); w.w = pk2(siluf(g1.z) * u1.z, siluf(g1.w) * u1.w);
                *(u32x4*)(hid + row * DE + ct * 128 + wc * 32 + 8 * fq) = w; }
    }
};
struct EpiDown {
    static constexpr bool PERM = true;
    bf16* y;
    DI void operator()(const f32x4 (&acc)[2][2][4][2], const Unit& u, int, int, int, int) const {
        int tz = threadIdx.x; asm volatile("" : "+v"(tz)); const int wr = tz >> 8, wc = (tz >> 6) & 3, fr = tz & 15, fq = (tz >> 4) & 3;
        const int ct = u.pn & 3;
#pragma unroll
        for (int ai = 0; ai < 2; ++ai)
#pragma unroll
            for (int m = 0; m < 4; ++m) { const size_t row = (size_t)u.pm * 256 + ai * 128 + wr * 64 + m * 16 + fr;
                bf16* dst = y + row * D + ct * 256 + wc * 64 + 8 * fq;
#pragma unroll
                for (int bj = 0; bj < 2; ++bj) { const f32x4 v0 = acc[ai][bj][m][0], v1 = acc[ai][bj][m][1];
                    u32x4 w; w.x = pk2(v0.x, v0.y); w.y = pk2(v0.z, v0.w); w.z = pk2(v1.x, v1.y); w.w = pk2(v1.z, v1.w);
                    *(u32x4*)(dst + bj * 32) = w; } }
    }
};
struct EpiG1 {
    static constexpr bool PERM = true;
    bf16* pqkv; bf16* z; bf16* halo; float* ab;
    DI void operator()(const f32x4 (&acc)[2][2][4][2], const Unit& u, int, int, int, int) const {
        int tz = threadIdx.x; asm volatile("" : "+v"(tz)); const int wr = tz >> 8, wc = (tz >> 6) & 3, fr = tz & 15, fq = (tz >> 4) & 3;
#pragma unroll
        for (int ai = 0; ai < 2; ++ai)
#pragma unroll
            for (int m = 0; m < 4; ++m) { const int t = u.pm * 256 + ai * 128 + wr * 64 + m * 16 + fr, rr = m * 16 + fr;
#pragma unroll
                for (int bj = 0; bj < 2; ++bj) { const f32x4 v0 = acc[ai][bj][m][0], v1 = acc[ai][bj][m][1];
                    u32x4 w; w.x = pk2(v0.x, v0.y); w.y = pk2(v0.z, v0.w); w.z = pk2(v1.x, v1.y); w.w = pk2(v1.z, v1.w);
                    const int col = u.pn * 256 + wc * 64 + bj * 32 + 8 * fq;
                    if (u.pn < 12) { *(u32x4*)(pqkv + (size_t)t * 3072 + col) = w;
                        if (rr == 0 || rr >= 62) { const int slot = rr == 0 ? 0 : rr - 61; *(u32x4*)(halo + ((size_t)(t >> 6) * 3 + slot) * 3072 + col) = w; } }
                    else if (u.pn < 16) *(u32x4*)(z + (size_t)t * D + (col - 3072)) = w;
                    else if (bj == 0 && wc == 0) { *(f32x4*)(ab + (size_t)t * 32 + 8 * fq) = v0; *(f32x4*)(ab + (size_t)t * 32 + 8 * fq + 4) = v1; } } }
    }
};
DI void p_router(const Frame& F, const KP& p, int l, int ntok) {
    LAS float* A2s = (LAS float*)(F.lds); LAS float* gBs = A2s + 1024; LAS float* gAs = (LAS float*)(F.lds + 126976);
    const bf16* DL = (const bf16*)(F.ws + (l == 0 ? WS_YP : WS_Y2));
    LAS float* part = (LAS float*)(F.lds + 8192);
    LAS float* pss = (LAS float*)(F.lds + 108544);
    LAS float* lgs = (LAS float*)(F.lds + 110592);
    LAS float* rsl = (LAS float*)(F.lds + 123136);
    LAS int* hist = (LAS int*)(F.lds + 123648);
    LAS int* basee = (LAS int*)(F.lds + 123648 + 128);
    LAS int* tiE = (LAS int*)(F.lds + 123648 + 256);
    LAS int* tiP = (LAS int*)(F.lds + 123648 + 256 + 1024);
    LAS float* tiW = (LAS float*)(F.lds + 123648 + 256 + 2048);
    const bf16* whi = (const bf16*)(F.ws + WS_WR2) + (size_t)(l * 2) * 48 * D; const bf16* wlo = whi + (size_t)48 * D;
    bf16* HX = (bf16*)(F.ws + WS_HX);
    unsigned* cnt = (unsigned*)(F.ws + WS_CTL) + CW_CNT + l * 32 * CNT_STRIDE;
    Entry* ent = (Entry*)(F.ws + WS_ENT);
    const float* nf = p.in[7] + l * D;
    const int fr = F.lane & 15, fq = F.lane >> 4, kw = 128 * F.wave;
    const int nunits = 256 + (ntok > TL ? 64 : 0);
    for (int un = F.bid; un < nunits; un += F.G) {
        const int t0 = un < 256 ? un * 128 : TL + (un - 256) * 16, nt16 = un < 256 ? 8 : 1, r = mod_row(t0);
        bf16x8 bh[4][3], bl[4][3];
        { int zo = 0; asm volatile("" : "+s"(zo));
#pragma unroll
          for (int ks = 0; ks < 4; ++ks)
#pragma unroll
            for (int n = 0; n < 3; ++n) { bh[ks][n] = *(const bf16x8*)(whi + zo + (size_t)(16 * n + fr) * D + kw + 32 * ks + 8 * fq); bl[ks][n] = *(const bf16x8*)(wlo + zo + (size_t)(16 * n + fr) * D + kw + 32 * ks + 8 * fq); } }
        for (int i = F.tid; i < D; i += NTHR) { A2s[i] = nf[i] * (modp(F, l, r, 4)[i] + 1.f); const float gm = modp(F, l, r, 2)[i];
            if (l == 0) { const float ps = p.in[10][i]; gAs[i] = gm * ps; gBs[i] = gm * p.in[9][i] * ps; } else { gAs[i] = gm; gBs[i] = 0.f; } }
        if (F.tid < 32) hist[F.tid] = 0;
        __syncthreads();
        const float* c0 = (const float*)(F.ws + WS_C0) + (l * 5 + r) * 48;
        const float* xbase = l == 0 ? (t0 < TL ? p.in[0] + (size_t)t0 * D : p.in[2] + (size_t)(t0 - TL) * D) : nullptr;
        const bf16* xb16 = (const bf16*)F.out + (size_t)t0 * D;
        for (int hh = 0; hh * 4 < nt16; ++hh) {
            const int mts = min(4, nt16 - 4 * hh);
#pragma unroll 2
            for (int mt = 0; mt < mts; ++mt) {
                const int tq = 64 * hh + 16 * mt;
                const float* xr = xbase + (size_t)(tq + fr) * D + kw + 8 * fq;
                const bf16* xr16 = xb16 + (size_t)(tq + fr) * D + kw + 8 * fq;
                const bf16* dr = DL + (size_t)(t0 + tq + fr) * D + kw + 8 * fq;
                f32x4 acc[3] = {{0.f, 0.f, 0.f, 0.f}, {0.f, 0.f, 0.f, 0.f}, {0.f, 0.f, 0.f, 0.f}}; float ssq = 0.f;
#pragma unroll
                for (int ks = 0; ks < 4; ++ks) {
                    f32x4 x0, x1;
                    if (l == 0) { x0 = *(const f32x4*)(xr + 32 * ks); x1 = *(const f32x4*)(xr + 32 * ks + 4); }
                    else { const u32x4 xq = *(const u32x4*)(xr16 + 32 * ks); x0 = (f32x4){bflo(xq.x), bfhi(xq.x), bflo(xq.y), bfhi(xq.y)}; x1 = (f32x4){bflo(xq.z), bfhi(xq.z), bflo(xq.w), bfhi(xq.w)}; }
                    { const u32x4 dv = *(const u32x4*)(dr + 32 * ks); const LAS float* ga = gAs + kw + 32 * ks + 8 * fq; const LAS float* gb = gBs + kw + 32 * ks + 8 * fq;
                      x0 += *(const LAS f32x4*)gb + *(const LAS f32x4*)ga * (f32x4){bflo(dv.x), bfhi(dv.x), bflo(dv.y), bfhi(dv.y)};
                      x1 += *(const LAS f32x4*)(gb + 4) + *(const LAS f32x4*)(ga + 4) * (f32x4){bflo(dv.z), bfhi(dv.z), bflo(dv.w), bfhi(dv.w)}; }
                    ssq += (x0.x * x0.x + x0.y * x0.y) + (x0.z * x0.z + x0.w * x0.w) + (x1.x * x1.x + x1.y * x1.y) + (x1.z * x1.z + x1.w * x1.w);
                    const f32x4 y0 = x0 * *(const LAS f32x4*)(A2s + kw + 32 * ks + 8 * fq), y1 = x1 * *(const LAS f32x4*)(A2s + kw + 32 * ks + 8 * fq + 4);
                    const float ya[8] = {y0.x, y0.y, y0.z, y0.w, y1.x, y1.y, y1.z, y1.w};
                    bf16x8 ah, al;
#pragma unroll
                    for (int e = 0; e < 8; ++e) { const unsigned hb = f2bf(ya[e]); ah[e] = (short)hb; al[e] = (short)f2bf(ya[e] - bf2f((unsigned short)hb)); }
#pragma unroll
                    for (int n = 0; n < 3; ++n) {
                        acc[n] = __builtin_amdgcn_mfma_f32_16x16x32_bf16(ah, bh[ks][n], acc[n], 0, 0, 0);
                        acc[n] = __builtin_amdgcn_mfma_f32_16x16x32_bf16(al, bh[ks][n], acc[n], 0, 0, 0);
                        acc[n] = __builtin_amdgcn_mfma_f32_16x16x32_bf16(ah, bl[ks][n], acc[n], 0, 0, 0); }
                }
                ssq += __shfl_xor(ssq, 16); ssq += __shfl_xor(ssq, 32);
                if (fq == 0) pss[F.wave * 64 + 16 * mt + fr] = ssq;
#pragma unroll
                for (int n = 0; n < 3; ++n)
#pragma unroll
                    for (int q = 0; q < 4; ++q) part[(F.wave * 64 + 16 * mt + 4 * fq + q) * 49 + 16 * n + fr] = acc[n][q];
            }
            __syncthreads();
            { const int tl = F.tid >> 3, jj = F.tid & 7;
              if (tl < 16 * mts) { float s = 0.f;
#pragma unroll
                for (int w = 0; w < 8; ++w) s += pss[w * 64 + tl];
                const float rstd = rsqrtf(s * (1.f / D) + EPS);
                if (jj == 0) rsl[64 * hh + tl] = rstd;
#pragma unroll
                for (int j = jj; j < 48; j += 8) { float g = 0.f;
#pragma unroll
                    for (int w = 0; w < 8; ++w) g += part[(w * 64 + tl) * 49 + j];
                    lgs[tl * 49 + j] = g * rstd + c0[j]; } } }
            __syncthreads();
            if (F.tid < 16 * mts) {
                const LAS float* lg = lgs + F.tid * 49;
                const float g0 = lg[0], g1 = lg[1], g2 = lg[2], g3 = lg[3];
                int gi = 0; float gm = g0; if (g1 > gm) { gm = g1; gi = 1; } if (g2 > gm) { gm = g2; gi = 2; } if (g3 > gm) { gm = g3; gi = 3; }
                const float pg = 1.f / (__expf(g0 - gm) + __expf(g1 - gm) + __expf(g2 - gm) + __expf(g3 - gm));
                float e1 = -3.0e38f, e2 = -3.0e38f; int i1 = 0, i2 = 0;
#pragma unroll
                for (int j = 0; j < 8; ++j) { const float v = lg[4 + gi * 8 + j];
                    if (v > e1) { e2 = e1; i2 = i1; e1 = v; i1 = j; } else if (v > e2) { e2 = v; i2 = j; } }
                const float w1 = pg / (1.f + __expf(e2 - e1)), w2 = pg - w1;
                const int E0 = gi * 8 + i1, E1 = gi * 8 + i2, tl = 64 * hh + F.tid;
                tiE[tl * 2] = E0; tiE[tl * 2 + 1] = E1; tiW[tl * 2] = w1; tiW[tl * 2 + 1] = w2;
                tiP[tl * 2] = atomicAdd((int*)&hist[E0], 1); tiP[tl * 2 + 1] = atomicAdd((int*)&hist[E1], 1);
            }
        }
        { const int rpw = 2 * nt16, tl0 = rpw * F.wave, tw = t0 + tl0;
          bf16* xo16 = (bf16*)(F.ws + (l == 0 ? WS_XS1 : WS_XS3)) + (size_t)tw * D;
          float* xo32 = (float*)(F.ws + WS_XC) + (size_t)(tw - TL) * D;
          for (int k = 0; k < rpw; k += 2) { f32x4 xa[2][2], xb[2][2]; u32x4 dv[2][2];
#pragma unroll
            for (int kk = 0; kk < 2; ++kk)
#pragma unroll
                for (int i = 0; i < 2; ++i) { const int c = 8 * F.lane + 512 * i;
                    if (l == 0) { xa[kk][i] = *(const f32x4*)(xbase + (size_t)(tl0 + k + kk) * D + c); xb[kk][i] = *(const f32x4*)(xbase + (size_t)(tl0 + k + kk) * D + c + 4); }
                    else unpk8(*(const u32x4*)(xb16 + (size_t)(tl0 + k + kk) * D + c), xa[kk][i], xb[kk][i]);
                    dv[kk][i] = *(const u32x4*)(DL + (size_t)(tw + k + kk) * D + c); }
#pragma unroll
            for (int kk = 0; kk < 2; ++kk) { const float rstd = rsl[tl0 + k + kk];
#pragma unroll
                for (int i = 0; i < 2; ++i) { const int c = 8 * F.lane + 512 * i; f32x4 da, db; unpk8(dv[kk][i], da, db);
                    const f32x4 sa = xa[kk][i] + *(const LAS f32x4*)(gBs + c) + *(const LAS f32x4*)(gAs + c) * da, sb = xb[kk][i] + *(const LAS f32x4*)(gBs + c + 4) + *(const LAS f32x4*)(gAs + c + 4) * db;
                    if (l == 0 && tw >= TL) { *(f32x4*)(xo32 + (size_t)(k + kk) * D + c) = sa; *(f32x4*)(xo32 + (size_t)(k + kk) * D + c + 4) = sb; }
                    else *(u32x4*)(xo16 + (size_t)(k + kk) * D + c) = pk8(sa, sb);
                    const float* b2 = modp(F, l, r, 3) + c;
                    const f32x4 va = sa * rstd * *(const LAS f32x4*)(A2s + c) + *(const f32x4*)b2, vb = sb * rstd * *(const LAS f32x4*)(A2s + c + 4) + *(const f32x4*)(b2 + 4);
                    *(u32x4*)(HX + (size_t)(tw + k + kk) * D + c) = pk8(va, vb); } } } }
        __syncthreads();
        { int tz = threadIdx.x; asm volatile("" : "+v"(tz));
          if (tz < 32) { const int hcount = hist[tz]; basee[tz] = hcount > 0 ? (int)__hip_atomic_fetch_add(cnt + tz * CNT_STRIDE, (unsigned)hcount, __ATOMIC_RELAXED, __HIP_MEMORY_SCOPE_AGENT) : 0; } }
        __syncthreads();
        if (F.tid < 32 * nt16) { const int tl = F.tid >> 1, E = tiE[F.tid], pos = basee[E] + tiP[F.tid]; Entry en; en.ts = (t0 + tl) * 2 + (F.tid & 1); en.w = tiW[F.tid];
            ent[(size_t)E * CAP + pos] = en;
            Entry ti; ti.ts = (E << 16) | pos; ti.w = en.w; ((Entry*)(F.ws + WS_TI))[(size_t)(t0 + tl) * 2 + (F.tid & 1)] = ti; }
        __syncthreads();
    }
}

DI void p6_n1(const Frame& F, const KP& p, const LAS int* tb) {
    const int gw = F.bid * NWAVES + F.wave, NGW = F.G * NWAVES;
    const bf16* Y = (const bf16*)(F.ws + WS_Y); bf16* HX = (bf16*)(F.ws + WS_HX); const Entry* TI = (const Entry*)(F.ws + WS_TI);
    for (int t = gw; t < T; t += NGW) {
        const int r = mod_row(t); const bool lat = t < TL;
        float* xr = (float*)(F.ws + WS_XC) + (size_t)(t - TL) * D;
        const bf16* xi16 = (const bf16*)(F.ws + WS_XS1) + (size_t)t * D; bf16* xo16 = (bf16*)F.out + (size_t)t * D;
        const Entry ta = TI[(size_t)2 * t], tbb = TI[(size_t)2 * t + 1]; const float w0 = ta.w, w1 = tbb.w;
        const size_t r0 = ((size_t)tb[ta.ts >> 16] * 256 + (ta.ts & 0xffff)) * D, r1 = ((size_t)tb[tbb.ts >> 16] * 256 + (tbb.ts & 0xffff)) * D;
        f32x4 va[2], vb[2]; u32x4 y0[2], y1[2]; float s = 0.f;
#pragma unroll
        for (int i = 0; i < 2; ++i) { const int c = 8 * F.lane + 512 * i;
            if (lat) unpk8(*(const u32x4*)(xi16 + c), va[i], vb[i]); else { va[i] = *(const f32x4*)(xr + c); vb[i] = *(const f32x4*)(xr + c + 4); }
            y0[i] = *(const u32x4*)(Y + r0 + c); y1[i] = *(const u32x4*)(Y + r1 + c); }
#pragma unroll
        for (int i = 0; i < 2; ++i) { const int c = 8 * F.lane + 512 * i; f32x4 a0, b0, a1, b1; unpk8(y0[i], a0, b0); unpk8(y1[i], a1, b1);
            const float* gp = modp(F, 0, r, 5) + c;
            va[i] = va[i] + *(const f32x4*)gp * (a0 * w0 + a1 * w1); vb[i] = vb[i] + *(const f32x4*)(gp + 4) * (b0 * w0 + b1 * w1);
            if (lat) *(u32x4*)(xo16 + c) = pk8(va[i], vb[i]); else { *(f32x4*)(xr + c) = va[i]; *(f32x4*)(xr + c + 4) = vb[i]; }
            s += (va[i].x * va[i].x + va[i].y * va[i].y) + (va[i].z * va[i].z + va[i].w * va[i].w) + (vb[i].x * vb[i].x + vb[i].y * vb[i].y) + (vb[i].z * vb[i].z + vb[i].w * vb[i].w); }
        const float rstd = rsqrtf(wave_sum(s) * (1.f / D) + EPS);
#pragma unroll
        for (int i = 0; i < 2; ++i) { const int c = 8 * F.lane + 512 * i; const float* nm = p.in[6] + D + c; const float* sc = modp(F, 1, r, 1) + c; const float* sh = modp(F, 1, r, 0) + c;
            const f32x4 oa = va[i] * rstd * (*(const f32x4*)nm * (*(const f32x4*)sc + 1.f)) + *(const f32x4*)sh, ob = vb[i] * rstd * (*(const f32x4*)(nm + 4) * (*(const f32x4*)(sc + 4) + 1.f)) + *(const f32x4*)(sh + 4);
            *(u32x4*)(HX + (size_t)t * D + c) = pk8(oa, ob); }
    }
}

DI bf16x8 lds_frag(LAS unsigned char* base, int byteoff) { return *(const LAS bf16x8*)(base + byteoff); }
DI void p8_c1a(const Frame& F, const KP& p) {
    bf16* PQ = (bf16*)(F.ws + WS_PQKV); const bf16* HALO = (const bf16*)(F.ws + WS_HALO); const float* AB = (const float*)(F.ws + WS_AB);
    float* LM = (float*)(F.ws + WS_LM); bf16* PM = (bf16*)(F.ws + WS_PM); float* GCB = (float*)(F.ws + WS_GCB);
    constexpr int RS = 272;
    LAS unsigned char* qs = F.lds; LAS unsigned char* ks = F.lds + 64 * RS;
    LAS float* KKs = (LAS float*)(F.lds + 53248);
    LAS float* QKs = (LAS float*)(F.lds + 53248 + 17408);
    LAS float* gcs = (LAS float*)(F.lds + 53248 + 2 * 17408);
    LAS float* bes = gcs + 128;
    const int fr = F.lane & 15, fq = F.lane >> 4;
    const int grp = F.tid >> 4, l16 = F.tid & 15, which = grp >> 3, ro = grp & 7;
    u32x4 raw[11]; float abA = 0.f, abB = 0.f;
#define C1_LOAD(unit_) do { const int cid_ = (unit_) >> 3, h_ = (unit_) & 7, tok0_ = cid_ * 64, col_ = which * 1024 + h_ * 128 + 8 * l16; \
        const bool first_ = cid_ < 512 ? ((cid_ & 127) == 0) : (((cid_ - 512) & 3) == 0), last_ = cid_ < 512 ? ((cid_ & 127) == 127) : (((cid_ - 512) & 3) == 3); \
        if (F.wave < 6) { _Pragma("unroll") for (int q = 0; q < 11; ++q) { const int rr = 8 * ro + q - 2; u32x4 v = {0u, 0u, 0u, 0u}; \
                if (rr < 0) { if (!first_) v = *(const u32x4*)(HALO + ((size_t)(cid_ - 1) * 3 + (rr + 3)) * 3072 + col_); } \
                else if (rr > 63) { if (!last_) v = *(const u32x4*)(HALO + ((size_t)(cid_ + 1) * 3 + 0) * 3072 + col_); } \
                else v = *(const u32x4*)(PQ + (size_t)(tok0_ + rr) * 3072 + col_); \
                raw[q] = v; } } \
        else { const int d_ = F.wave - 6, jj_ = d_ ? 63 - F.lane : F.lane; const float* ab_ = AB + (size_t)(tok0_ + jj_) * 32; abA = ab_[(2 * d_) * 8 + h_]; abB = ab_[(2 * d_ + 1) * 8 + h_]; } } while (0)
    if (F.bid < NCID * NH) C1_LOAD(F.bid);
    for (int unit = F.bid; unit < NCID * NH; unit += F.G) {
        const int cid = unit >> 3, h = unit & 7;
        const int tok0 = cid * 64;
        u32x4 res[8];
        const int col = which * 1024 + h * 128 + 8 * l16;
        if (F.wave < 6) {
            f32x4 w0[4], w1[4];
#pragma unroll
            for (int k = 0; k < 4; ++k) { w0[k] = *(const f32x4*)(p.in[12] + k * 3072 + col); w1[k] = *(const f32x4*)(p.in[12] + k * 3072 + col + 4); }
#pragma unroll
            for (int j = 0; j < 8; ++j) { float o[8];
#pragma unroll
                for (int e = 0; e < 8; ++e) o[e] = 0.f;
#pragma unroll
                for (int k = 0; k < 4; ++k) { const u32x4 rw = raw[j + k];
                    o[0] += bflo(rw.x) * w0[k].x; o[1] += bfhi(rw.x) * w0[k].y; o[2] += bflo(rw.y) * w0[k].z; o[3] += bfhi(rw.y) * w0[k].w;
                    o[4] += bflo(rw.z) * w1[k].x; o[5] += bfhi(rw.z) * w1[k].y; o[6] += bflo(rw.w) * w1[k].z; o[7] += bfhi(rw.w) * w1[k].w; }
                float ss = 0.f;
#pragma unroll
                for (int e = 0; e < 8; ++e) { o[e] = siluf(o[e]); ss += o[e] * o[e]; }
                ss += __shfl_xor(ss, 1); ss += __shfl_xor(ss, 2); ss += __shfl_xor(ss, 4); ss += __shfl_xor(ss, 8);
                float sc = 1.f;
                if (which == 0) sc = rsqrtf(ss + EPS) * 0.08838834764831845f; else if (which == 1) sc = rsqrtf(ss + EPS);
                u32x4 w; w.x = pk2(o[0] * sc, o[1] * sc); w.y = pk2(o[2] * sc, o[3] * sc); w.z = pk2(o[4] * sc, o[5] * sc); w.w = pk2(o[6] * sc, o[7] * sc);
                res[j] = w;
                if (which < 2) *(LAS u32x4*)((which == 0 ? qs : ks) + (8 * ro + j) * RS + l16 * 16) = w; }
        } else { const int d = F.wave - 6;
            const float a = abA, bb = abB;
            const float g = -__expf(p.in[13][d * 8 + h]) * softplusf_(a + p.in[14][d * 8 + h]); const float be = sigmoidf_(bb);
            float gc = g;
#pragma unroll
            for (int o = 1; o < 64; o <<= 1) { const float up = __shfl_up(gc, o); if (F.lane >= o) gc += up; }
            gcs[d * 64 + F.lane] = gc; bes[d * 64 + F.lane] = be;
            const float eg = __expf(gc), glast = __shfl(gc, 63);
            float* gp = GCB + ((size_t)unit * 2 + d) * 256; gp[F.lane] = be; gp[64 + F.lane] = be * eg; gp[128 + F.lane] = eg; gp[192 + F.lane] = __expf(glast - gc); }
        __syncthreads();
        if (unit + F.G < NCID * NH) C1_LOAD(unit + F.G);
        if (F.wave < 6) {
#pragma unroll
            for (int j = 0; j < 8; ++j) *(u32x4*)(PQ + (size_t)(tok0 + 8 * ro + j) * 3072 + col) = res[j]; }
#pragma unroll
        for (int tt = 0; tt < 2; ++tt) { const int ti = 2 * F.wave + tt, mt = ti >> 2, nt = ti & 3;
            f32x4 ak = {0.f, 0.f, 0.f, 0.f}, aq = {0.f, 0.f, 0.f, 0.f};
#pragma unroll
            for (int kk = 0; kk < 4; ++kk) { const int ko = (32 * kk + 8 * fq) * 2;
                const bf16x8 bfr = lds_frag(ks, (16 * nt + fr) * RS + ko), akf = lds_frag(ks, (16 * mt + fr) * RS + ko), aqf = lds_frag(qs, (16 * mt + fr) * RS + ko);
                ak = __builtin_amdgcn_mfma_f32_16x16x32_bf16(akf, bfr, ak, 0, 0, 0); aq = __builtin_amdgcn_mfma_f32_16x16x32_bf16(aqf, bfr, aq, 0, 0, 0); }
#pragma unroll
            for (int r = 0; r < 4; ++r) { KKs[(16 * mt + 4 * fq + r) * 68 + 16 * nt + fr] = ak[r]; QKs[(16 * mt + 4 * fq + r) * 68 + 16 * nt + fr] = aq[r]; } }
        __syncthreads();
#pragma unroll
        for (int itr = 0; itr < 2; ++itr) { const int idx = (F.tid + NTHR * itr) * 4, i1 = idx >> 6, i2b = idx & 63; f32x4 v;
#pragma unroll
            for (int e = 0; e < 4; ++e) { const int i2 = i2b + e; float x = 0.f;
                if (i2 < i1) x = bes[i1] * KKs[i1 * 68 + i2] * __expf(gcs[i1] - gcs[i2]);
                else if (i2 > i1) { const int j1 = 63 - i1, j2 = 63 - i2; x = bes[64 + j1] * KKs[i1 * 68 + i2] * __expf(gcs[64 + j1] - gcs[64 + j2]); }
                v[e] = x; }
            *(f32x4*)(LM + (size_t)unit * 4096 + idx) = v; }
#pragma unroll
        for (int itr = 0; itr < 2; ++itr) { const int idx = (F.tid + NTHR * itr) * 8, d = idx >> 12, j1 = (idx >> 6) & 63, jb = idx & 63;
            const int t1 = d ? 63 - j1 : j1; float x[8];
#pragma unroll
            for (int e = 0; e < 8; ++e) { const int j2 = jb + e; x[e] = 0.f;
                if (j2 <= j1) { const int t2 = d ? 63 - j2 : j2; x[e] = QKs[t1 * 68 + t2] * __expf(gcs[d * 64 + j1] - gcs[d * 64 + j2]); } }
            u32x4 w; w.x = pk2(x[0], x[1]); w.y = pk2(x[2], x[3]); w.z = pk2(x[4], x[5]); w.w = pk2(x[6], x[7]);
            *(u32x4*)(PM + ((size_t)unit * 2 + d) * 4096 + j1 * 64 + jb) = w; }
        __syncthreads();
    }
#undef C1_LOAD
}

DI void p9_c1b(const Frame& F) {
    const float* LM = (const float*)(F.ws + WS_LM); bf16* TM = (bf16*)(F.ws + WS_TM);
    LAS float* Ls = (LAS float*)(F.lds);
    for (int k0 = 0; F.bid + k0 * F.G < NCID * NH; k0 += 4) {
        {
            f32x4 lv[8];
#pragma unroll
            for (int itr = 0; itr < 8; ++itr) { const int uqs = itr >> 1, un = F.bid + (k0 + uqs) * F.G;
                lv[itr] = un < NCID * NH ? *(const f32x4*)(LM + (size_t)un * 4096 + (size_t)(F.tid + NTHR * (itr & 1)) * 4) : (f32x4){0.f, 0.f, 0.f, 0.f}; }
#pragma unroll
            for (int itr = 0; itr < 8; ++itr) { const int uq = itr >> 1, e0 = (F.tid + NTHR * (itr & 1)) * 4, i1 = e0 >> 6;
#pragma unroll
                for (int e = 0; e < 4; ++e) { const int i2 = (e0 & 63) + e; const float v = lv[itr][e];
                    if (i2 < i1) Ls[((uq * 2 + 0) * 64 + i1) * 64 + i2] = v; else if (i2 > i1) Ls[((uq * 2 + 1) * 64 + (63 - i1)) * 64 + (63 - i2)] = v; } }
        }
        __syncthreads();
        {
            const int uq = F.wave >> 1, d = F.wave & 1, c = F.lane;
            LAS float* L = Ls + (uq * 2 + d) * 4096;
            float Tc[64];
            Tc[0] = (c == 0) ? 1.f : 0.f;
#pragma unroll
            for (int i = 1; i < 64; ++i) {
                f32x4 lr[16];
#pragma unroll
                for (int q = 0; q < (i + 3) / 4; ++q) lr[q] = *(const LAS f32x4*)(L + i * 64 + 4 * q);
                float a0 = (c == i) ? 1.f : 0.f, a1 = 0.f, a2 = 0.f, a3 = 0.f;
#pragma unroll
                for (int q = 0; q < (i + 3) / 4; ++q) { const f32x4 l4 = lr[q]; const int j4 = 4 * q;
                    a0 -= l4.x * Tc[j4];
                    if (j4 + 1 < i) a1 -= l4.y * Tc[j4 + 1];
                    if (j4 + 2 < i) a2 -= l4.z * Tc[j4 + 2];
                    if (j4 + 3 < i) a3 -= l4.w * Tc[j4 + 3]; }
                Tc[i] = (a0 + a1) + (a2 + a3);
            }
            LAS unsigned short* Tl = (LAS unsigned short*)L;
#pragma unroll
            for (int i = 0; i < 64; ++i) Tl[i * 64 + c] = (unsigned short)f2bf(Tc[i]);
            asm volatile("s_waitcnt lgkmcnt(0)" ::: "memory");
            const int un = F.bid + (k0 + uq) * F.G;
            if (un < NCID * NH) { bf16* dst = TM + ((size_t)un * 2 + d) * 4096;
#pragma unroll
                for (int q = 0; q < 8; ++q) *(u32x4*)(dst + (size_t)(q * 64 + c) * 8) = *(const LAS u32x4*)(Tl + (q * 64 + c) * 8); }
        }
        __syncthreads();
    }
}

typedef short s16x4 __attribute__((ext_vector_type(4)));
constexpr int SB_K = 0, SB_Q = 16384, SB_T = 32768, SB_P = 40960, SB_V = 49152, SB_G = 53248, SB_SIZE = 54272;
constexpr int SW_SBT = 2 * SB_SIZE, SW_XT = SW_SBT + 8704, SW_VNT = SW_XT + 4608, SW_VDT = SW_VNT + 4608;
static_assert(SW_VDT + 4608 <= LDS_MISC, "scan LDS map");
DI unsigned offb(unsigned row, unsigned ch) { return 256u * row + 16u * (ch ^ (((row & 3u) << 2) | ((row >> 2) & 3u))); }
DI unsigned offt(unsigned row, unsigned ch) { return 128u * row + 16u * (ch ^ ((row >> 1) & 7u)); }
#define SC_GLDS(src, ldsoff) __builtin_amdgcn_global_load_lds((const unsigned*)(src), (LAS unsigned*)(F.lds + (ldsoff)), 16, 0, 0)
#define SC_LBAR() do { asm volatile("s_waitcnt lgkmcnt(0)" ::: "memory"); __builtin_amdgcn_s_barrier(); asm volatile("" ::: "memory"); } while (0)
DI void scan_chunk(int s, int b, int d, int& cid, int& outp) {
    if (s < 4) { const int cc = d ? 3 - s : s; cid = 512 + b * 4 + cc; outp = 0; } else { const int c2 = s - 4, cc = d ? 127 - c2 : c2; cid = b * 128 + cc; outp = 1; }
}
DI void scan_issue(const Frame& F, int buf, int s, int b, int h, int d, int v0) {
    const unsigned char* PQ = F.ws + WS_PQKV; const float* GCB = (const float*)(F.ws + WS_GCB);
    int cid, outp; scan_chunk(s, b, d, cid, outp);
    const int tok0 = cid * 64, w = F.wave, L = F.lane, bo = buf * SB_SIZE;
    const size_t mb = ((size_t)(cid * 8 + h) * 2 + d);
    const unsigned char* TMb = F.ws + WS_TM + mb * 8192; const unsigned char* PMb = F.ws + WS_PM + mb * 8192;
#pragma unroll
    for (int ii = 0; ii < 2; ++ii) { const int i = 2 * w + ii, row = 4 * i + (L >> 4), slot = L & 15, ch = slot ^ (((row & 3) << 2) | ((row >> 2) & 3)), tok = tok0 + (d ? 63 - row : row);
        const unsigned off = (unsigned)tok * 6144u + (unsigned)(h * 256 + ch * 16);
        SC_GLDS(PQ + 2048 + off, bo + SB_K + i * 1024); if (outp) SC_GLDS(PQ + off, bo + SB_Q + i * 1024); }
    { const int row = 8 * w + (L >> 3), slot = L & 7, ch = slot ^ ((row >> 1) & 7); const unsigned off = (unsigned)(row * 128 + ch * 16);
        SC_GLDS(TMb + off, bo + SB_T + w * 1024); if (outp) SC_GLDS(PMb + off, bo + SB_P + w * 1024); }
    if (w < 4) { const int row = 16 * w + (L >> 2), c = L & 3, tok = tok0 + (d ? 63 - row : row);
        SC_GLDS(PQ + 4096 + ((unsigned)tok * 6144u + (unsigned)(h * 256 + v0 * 2 + 16 * c)), bo + SB_V + w * 1024); }
    else if (w == 4) SC_GLDS(GCB + mb * 256 + L * 4, bo + SB_G);
}
DI void scan_step(const Frame& F, int buf, int s, int b, int h, int d, int v0, f32x4 (&Sacc)[2], int mt, int nt, int fr, int fq) {
    LAS unsigned char* L = F.lds; LAS unsigned char* B = F.lds + buf * SB_SIZE;
    bf16* OD = (bf16*)(F.ws + WS_O) + (size_t)d * TL * D;
    int cid, outp; scan_chunk(s, b, d, cid, outp);
    const int tok0 = cid * 64;
    f32x4 aX = {0.f, 0.f, 0.f, 0.f}, aO = {0.f, 0.f, 0.f, 0.f};
#pragma unroll
    for (int ks = 0; ks < 4; ++ks) { const bf16x8 sb = *(const LAS bf16x8*)(L + SW_SBT + (16 * nt + fr) * 272 + (32 * ks + 8 * fq) * 2);
        const bf16x8 kA = *(const LAS bf16x8*)(B + SB_K + offb(16 * mt + fr, 4 * ks + fq));
        aX = __builtin_amdgcn_mfma_f32_16x16x32_bf16(kA, sb, aX, 0, 0, 0);
        if (outp) { const bf16x8 qA = *(const LAS bf16x8*)(B + SB_Q + offb(16 * mt + fr, 4 * ks + fq)); aO = __builtin_amdgcn_mfma_f32_16x16x32_bf16(sb, qA, aO, 0, 0, 0); } }
    const LAS unsigned char* Gr = B + SB_G + (16 * mt + 4 * fq) * 4;
    const f32x4 be = *(const LAS f32x4*)Gr, s1 = *(const LAS f32x4*)(Gr + 256), eg = *(const LAS f32x4*)(Gr + 512), dr = *(const LAS f32x4*)(Gr + 768);
    float x[4];
#pragma unroll
    for (int r = 0; r < 4; ++r) { const float vv = bf2f(*(const LAS unsigned short*)(B + SB_V + (16 * mt + 4 * fq + r) * 64 + (16 * nt + fr) * 2));
        x[r] = vv * be[r] - s1[r] * aX[r]; }
    if (outp) { const float egj = *(const LAS float*)(B + SB_G + 512 + (16 * mt + fr) * 4); aO = aO * egj; }
    { u32x2 w; w.x = pk2(x[0], x[1]); w.y = pk2(x[2], x[3]); *(LAS u32x2*)(L + SW_XT + (16 * nt + fr) * 144 + (16 * mt + 4 * fq) * 2) = w; }
    SC_LBAR();
    f32x4 aV = {0.f, 0.f, 0.f, 0.f};
#pragma unroll
    for (int ks = 0; ks < 2; ++ks) { const bf16x8 xb = *(const LAS bf16x8*)(L + SW_XT + (16 * nt + fr) * 144 + (32 * ks + 8 * fq) * 2);
        const bf16x8 tA = *(const LAS bf16x8*)(B + SB_T + offt(16 * mt + fr, 4 * ks + fq));
        aV = __builtin_amdgcn_mfma_f32_16x16x32_bf16(tA, xb, aV, 0, 0, 0); }
    { u32x2 w; w.x = pk2(aV[0], aV[1]); w.y = pk2(aV[2], aV[3]); *(LAS u32x2*)(L + SW_VNT + (16 * nt + fr) * 144 + (16 * mt + 4 * fq) * 2) = w;
      w.x = pk2(aV[0] * dr[0], aV[1] * dr[1]); w.y = pk2(aV[2] * dr[2], aV[3] * dr[3]); *(LAS u32x2*)(L + SW_VDT + (16 * nt + fr) * 144 + (16 * mt + 4 * fq) * 2) = w; }
    SC_LBAR();
    const float decay = *(const LAS float*)(B + SB_G + 512 + 63 * 4);
    const int w8 = 2 * mt + nt;
    bf16x8 kt[2];
    { const unsigned q4 = (unsigned)fr >> 2, p4 = (unsigned)fr & 3u, kb = (unsigned)(size_t)(B + SB_K) + 8u * (p4 & 1u);
      const unsigned a00 = kb + offb(8 * fq + 0 + q4, 2 * w8 + (p4 >> 1)), a01 = kb + offb(8 * fq + 4 + q4, 2 * w8 + (p4 >> 1));
      const unsigned a10 = kb + offb(32 + 8 * fq + 0 + q4, 2 * w8 + (p4 >> 1)), a11 = kb + offb(32 + 8 * fq + 4 + q4, 2 * w8 + (p4 >> 1));
      s16x4 t00, t01, t10, t11;
      asm volatile("ds_read_b64_tr_b16 %0, %4\n\tds_read_b64_tr_b16 %1, %5\n\tds_read_b64_tr_b16 %2, %6\n\tds_read_b64_tr_b16 %3, %7\n\ts_waitcnt lgkmcnt(0)"
                   : "=&v"(t00), "=&v"(t01), "=&v"(t10), "=&v"(t11) : "v"(a00), "v"(a01), "v"(a10), "v"(a11) : "memory");
      kt[0] = (bf16x8){t00[0], t00[1], t00[2], t00[3], t01[0], t01[1], t01[2], t01[3]};
      kt[1] = (bf16x8){t10[0], t10[1], t10[2], t10[3], t11[0], t11[1], t11[2], t11[3]}; }
#pragma unroll
    for (int n = 0; n < 2; ++n) { Sacc[n] = Sacc[n] * decay;
#pragma unroll
        for (int ks = 0; ks < 2; ++ks) { const bf16x8 vd = *(const LAS bf16x8*)(L + SW_VDT + (16 * n + fr) * 144 + (32 * ks + 8 * fq) * 2);
            Sacc[n] = __builtin_amdgcn_mfma_f32_16x16x32_bf16(kt[ks], vd, Sacc[n], 0, 0, 0); } }
    if (outp) {
#pragma unroll
        for (int ks = 0; ks < 2; ++ks) { const bf16x8 vn = *(const LAS bf16x8*)(L + SW_VNT + (16 * nt + fr) * 144 + (32 * ks + 8 * fq) * 2);
            const bf16x8 pA = *(const LAS bf16x8*)(B + SB_P + offt(16 * mt + fr, 4 * ks + fq));
            aO = __builtin_amdgcn_mfma_f32_16x16x32_bf16(vn, pA, aO, 0, 0, 0); }
    }
#pragma unroll
    for (int n = 0; n < 2; ++n) { u32x2 w; w.x = pk2(Sacc[n][0], Sacc[n][1]); w.y = pk2(Sacc[n][2], Sacc[n][3]);
        *(LAS u32x2*)(L + SW_SBT + (16 * n + fr) * 272 + (16 * w8 + 4 * fq) * 2) = w; }
    if (outp) {
        { const int jc = 16 * mt + fr, tc = tok0 + (d ? 63 - jc : jc); u32x2 w; w.x = pk2(aO[0], aO[1]); w.y = pk2(aO[2], aO[3]);
          *(u32x2*)(OD + (size_t)tc * D + h * 128 + v0 + 16 * nt + 4 * fq) = w; }
        asm volatile("s_waitcnt vmcnt(1)" ::: "memory");
    } else asm volatile("s_waitcnt vmcnt(0)" ::: "memory");
    SC_LBAR();
}
DI void p10_scan(const Frame& F) {
    const int mt = F.wave >> 1, nt = F.wave & 1, fr = F.lane & 15, fq = F.lane >> 4;
    for (int u0 = F.bid; u0 < 256; u0 += F.G) {
        const int xcd = u0 & 7, qq = u0 >> 3, sl = qq & 3, chain = xcd + 8 * (qq >> 2);
        const int d = chain & 1, h = (chain >> 1) & 7, b = chain >> 4, v0 = sl * 32;
        for (int i = F.tid; i < 8704 / 4; i += NTHR) ((LAS unsigned*)(F.lds + SW_SBT))[i] = 0u;
        f32x4 Sacc[2] = {{0.f, 0.f, 0.f, 0.f}, {0.f, 0.f, 0.f, 0.f}};
        scan_issue(F, 0, 0, b, h, d, v0);
        asm volatile("s_waitcnt vmcnt(0)" ::: "memory");
        SC_LBAR();
        for (int s = 0; s < 132; ++s) {
            if (s + 1 < 132) scan_issue(F, (s + 1) & 1, s + 1, b, h, d, v0);
            scan_step(F, s & 1, s, b, h, d, v0, Sacc, mt, nt, fr, fq);
        }
    }
}

DI void p11_onorm(const Frame& F, const KP& p) {
    const int gw = F.bid * NWAVES + F.wave, NGW = F.G * NWAVES;
    const bf16* O0 = (const bf16*)(F.ws + WS_O); const bf16* O1 = O0 + (size_t)TL * D; const bf16* Z = (const bf16*)(F.ws + WS_Z); bf16* HX = (bf16*)(F.ws + WS_HX);
    for (int t = gw; t < TL; t += NGW) {
        const int c = 16 * F.lane;
        float o[16], zz[16]; float ss = 0.f;
#pragma unroll
        for (int q = 0; q < 2; ++q) { const u32x4 a = *(const u32x4*)(O0 + (size_t)t * D + c + 8 * q), bq = *(const u32x4*)(O1 + (size_t)t * D + c + 8 * q), zq = *(const u32x4*)(Z + (size_t)t * D + c + 8 * q);
            o[8 * q + 0] = bflo(a.x) + bflo(bq.x); o[8 * q + 1] = bfhi(a.x) + bfhi(bq.x); o[8 * q + 2] = bflo(a.y) + bflo(bq.y); o[8 * q + 3] = bfhi(a.y) + bfhi(bq.y);
            o[8 * q + 4] = bflo(a.z) + bflo(bq.z); o[8 * q + 5] = bfhi(a.z) + bfhi(bq.z); o[8 * q + 6] = bflo(a.w) + bflo(bq.w); o[8 * q + 7] = bfhi(a.w) + bfhi(bq.w);
            zz[8 * q + 0] = bflo(zq.x); zz[8 * q + 1] = bfhi(zq.x); zz[8 * q + 2] = bflo(zq.y); zz[8 * q + 3] = bfhi(zq.y); zz[8 * q + 4] = bflo(zq.z); zz[8 * q + 5] = bfhi(zq.z); zz[8 * q + 6] = bflo(zq.w); zz[8 * q + 7] = bfhi(zq.w); }
#pragma unroll
        for (int e = 0; e < 16; ++e) ss += o[e] * o[e];
        ss += __shfl_xor(ss, 1); ss += __shfl_xor(ss, 2); ss += __shfl_xor(ss, 4);
        const float rs = rsqrtf(ss * (1.f / 128.f) + EPS);
        const float* nw = p.in[15] + (c & 127);
        unsigned w[8];
#pragma unroll
        for (int e = 0; e < 8; ++e) w[e] = pk2(o[2 * e] * rs * nw[2 * e] * siluf(zz[2 * e]), o[2 * e + 1] * rs * nw[2 * e + 1] * siluf(zz[2 * e + 1]));
        *(u32x4*)(HX + (size_t)t * D + c) = (u32x4){w[0], w[1], w[2], w[3]}; *(u32x4*)(HX + (size_t)t * D + c + 8) = (u32x4){w[4], w[5], w[6], w[7]};
    }
}

DI void p16_final(const Frame& F, const KP& p, const LAS int* tb) {
    const int gw = F.bid * NWAVES + F.wave, NGW = F.G * NWAVES;
    const bf16* Y = (const bf16*)(F.ws + WS_Y); const Entry* TI = (const Entry*)(F.ws + WS_TI);
    for (int t = gw; t < TL; t += NGW) {
        const int r = t >> 13; float* xr = F.out + (size_t)t * D; const bf16* xi16 = (const bf16*)(F.ws + WS_XS3) + (size_t)t * D;
        const Entry ta = TI[(size_t)2 * t], tbb = TI[(size_t)2 * t + 1]; const float w0 = ta.w, w1 = tbb.w;
        const size_t r0 = ((size_t)tb[ta.ts >> 16] * 256 + (ta.ts & 0xffff)) * D, r1 = ((size_t)tb[tbb.ts >> 16] * 256 + (tbb.ts & 0xffff)) * D;
        f32x4 va[2], vb[2]; u32x4 y0[2], y1[2]; float s = 0.f;
#pragma unroll
        for (int i = 0; i < 2; ++i) { const int c = 8 * F.lane + 512 * i; unpk8(*(const u32x4*)(xi16 + c), va[i], vb[i]); y0[i] = *(const u32x4*)(Y + r0 + c); y1[i] = *(const u32x4*)(Y + r1 + c); }
#pragma unroll
        for (int i = 0; i < 2; ++i) { const int c = 8 * F.lane + 512 * i; f32x4 a0, b0, a1, b1; unpk8(y0[i], a0, b0); unpk8(y1[i], a1, b1);
            const float* gp = modp(F, 1, r, 5) + c;
            va[i] = va[i] + *(const f32x4*)gp * (a0 * w0 + a1 * w1); vb[i] = vb[i] + *(const f32x4*)(gp + 4) * (b0 * w0 + b1 * w1);
            s += (va[i].x * va[i].x + va[i].y * va[i].y) + (va[i].z * va[i].z + va[i].w * va[i].w) + (vb[i].x * vb[i].x + vb[i].y * vb[i].y) + (vb[i].z * vb[i].z + vb[i].w * vb[i].w); }
        const float rstd = rsqrtf(wave_sum(s) * (1.f / D) + EPS);
#pragma unroll
        for (int i = 0; i < 2; ++i) { const int c = 8 * F.lane + 512 * i; *(f32x4*)(xr + c) = va[i] * rstd * *(const f32x4*)(p.in[24] + c); *(f32x4*)(xr + c + 4) = vb[i] * rstd * *(const f32x4*)(p.in[24] + c + 4); }
    }
}

__global__ void __launch_bounds__(NTHR, 2) fwd_kernel(KP kp) {
    extern __shared__ __attribute__((aligned(16))) unsigned char lds_raw[];
    Frame F;
    F.lds = (LAS unsigned char*)lds_raw; F.tid = threadIdx.x; F.lane = F.tid & 63; F.wave = __builtin_amdgcn_readfirstlane(F.tid >> 6);
    F.bid = blockIdx.x; F.G = gridDim.x; F.ws = kp.ws; F.out = kp.out;
    volatile LAS unsigned* misc = (volatile LAS unsigned*)(F.lds + LDS_MISC);
    if (F.tid < 4) misc[F.tid] = 0u;
    __syncthreads();
    const int lo = kp.ph_lo, hi = kp.ph_hi;
    XcdBarrier bar; bar.bar = (unsigned*)(F.ws + WS_CTL) + CW_BAR; bar.x = 0; bar.st = misc;
    if (hi - lo > 1) bar = xcd_barrier_post((unsigned*)(F.ws + WS_CTL) + CW_BAR, misc);
#ifndef PHSEL
#define PHSEL 0x1FFFF
#endif
#define IN(k) (((PHSEL >> (k)) & 1) && lo <= (k) && (k) < hi)
#define SEAM(k) do { if (IN(k) && IN((k) + 1)) xcd_barrier(bar); } while (0)
    LAS int* tb = (LAS int*)(F.lds + LDS_MISC + 64); LAS int* cn = (LAS int*)(F.lds + LDS_MISC + 64 + 256);
    const float* MOD = (const float*)(F.ws + WS_MOD);

    if (IN(0)) { p0_prologue(F, kp); } SEAM(0);
    if (IN(1)) { p1_pool_diff(F, kp); __syncthreads(); convert_experts(F, kp, 0); } SEAM(1);
    if (IN(2)) { pg8::Gemm g{(const bf16*)(F.ws + WS_DD), (const bf16*)(F.ws + WS_BTP), 256}; PoolOrder S{F.G, F.bid};
        EpiRaw E{(bf16*)(F.ws + WS_YP), 1};
        pg8::gemm_phase<EpiRaw, PoolOrder, false>(F.lds, g, S, E); } SEAM(2);
    if (IN(3)) { p_router(F, kp, 0, T); } SEAM(3);
    if (IN(4)) { moe_tables(F, 0, tb, cn);
        pg8::Gemm g{(const bf16*)(F.ws + WS_HX), (const bf16*)(F.ws + WS_GU), 1024}; MoeOrder S{F.G, F.bid, tb[NE], tb, cn, (const Entry*)(F.ws + WS_ENT)};
        EpiGU E{(bf16*)(F.ws + WS_HID)};
        pg8::gemm_phase<EpiGU, MoeOrder, true>(F.lds, g, S, E); } SEAM(4);
    if (IN(5)) { moe_tables(F, 0, tb, cn);
        pg8::Gemm g{(const bf16*)(F.ws + WS_HID), (const bf16*)(F.ws + WS_DN), 512}; MoeOrder S{F.G, F.bid, tb[NE], tb, cn, (const Entry*)(F.ws + WS_ENT)};
        EpiDown E{(bf16*)(F.ws + WS_Y)};
        pg8::gemm_phase<EpiDown, MoeOrder, false>(F.lds, g, S, E); } SEAM(5);
    if (IN(6)) { moe_tables(F, 0, tb, cn); p6_n1(F, kp, tb); } SEAM(6);
    if (IN(7)) { pg8::Gemm g{(const bf16*)(F.ws + WS_HX), (const bf16*)(F.ws + WS_BTIN), 1024}; G1Order S{F.G, F.bid};
        EpiG1 E{(bf16*)(F.ws + WS_PQKV), (bf16*)(F.ws + WS_Z), (bf16*)(F.ws + WS_HALO), (float*)(F.ws + WS_AB)};
        pg8::gemm_phase<EpiG1, G1Order, false>(F.lds, g, S, E); } SEAM(7);
    if (IN(8)) { p8_c1a(F, kp); asm volatile("s_waitcnt vmcnt(0)" ::: "memory"); __syncthreads(); }
#ifdef PROBE_K
    SEAM(8);
#endif
    if (IN(9)) { p9_c1b(F); } SEAM(9);
    if (IN(10)) { p10_scan(F); } SEAM(10);
    if (IN(11)) { p11_onorm(F, kp); convert_experts(F, kp, 1); } SEAM(11);
    if (IN(12)) { pg8::Gemm g{(const bf16*)(F.ws + WS_HX), (const bf16*)(F.ws + WS_BTOUT), 1024}; G2Order S{F.G, F.bid};
        EpiRaw E{(bf16*)(F.ws + WS_Y2), 0};
        pg8::gemm_phase<EpiRaw, G2Order, false>(F.lds, g, S, E); } SEAM(12);
    if (IN(13)) { p_router(F, kp, 1, TL); } SEAM(13);
    if (IN(14)) { moe_tables(F, 1, tb, cn);
        pg8::Gemm g{(const bf16*)(F.ws + WS_HX), (const bf16*)(F.ws + WS_GU), 1024}; MoeOrder S{F.G, F.bid, tb[NE], tb, cn, (const Entry*)(F.ws + WS_ENT)};
        EpiGU E{(bf16*)(F.ws + WS_HID)};
        pg8::gemm_phase<EpiGU, MoeOrder, true>(F.lds, g, S, E); } SEAM(14);
    if (IN(15)) { moe_tables(F, 1, tb, cn);
        pg8::Gemm g{(const bf16*)(F.ws + WS_HID), (const bf16*)(F.ws + WS_DN), 512}; MoeOrder S{F.G, F.bid, tb[NE], tb, cn, (const Entry*)(F.ws + WS_ENT)};
        EpiDown E{(bf16*)(F.ws + WS_Y)};
        pg8::gemm_phase<EpiDown, MoeOrder, false>(F.lds, g, S, E); } SEAM(15);
    if (IN(16)) { moe_tables(F, 1, tb, cn); p16_final(F, kp, tb); }
#undef IN
#undef SEAM
}

extern "C" void kernel_launch(void* const* d_in, const int* in_sizes, int n_in, void* d_out, int out_size, void* d_ws, size_t ws_size, hipStream_t stream) {
    static int grid = 0;
    if (grid == 0) {
        if (n_in != 25 || out_size != TL * D || ws_size < WS_END) { fprintf(stderr, "kernel_launch: unexpected shapes (n_in %d, out %d, ws %zu < %zu)\n", n_in, out_size, ws_size, (size_t)WS_END); grid = -1; return; }
        int dev = 0, cus = 0, per_cu = 0;
        if (hipGetDevice(&dev) != hipSuccess || hipDeviceGetAttribute(&cus, hipDeviceAttributeMultiprocessorCount, dev) != hipSuccess) { grid = -1; return; }
        if (hipFuncSetAttribute((const void*)fwd_kernel, hipFuncAttributeMaxDynamicSharedMemorySize, LDS_BYTES) != hipSuccess) { fprintf(stderr, "kernel_launch: hipFuncSetAttribute failed\n"); grid = -1; return; }
        if (hipOccupancyMaxActiveBlocksPerMultiprocessor(&per_cu, (const void*)fwd_kernel, NTHR, LDS_BYTES) != hipSuccess || per_cu < 1) fprintf(stderr, "kernel_launch: occupancy query says %d\n", per_cu);
        (void)hipGetLastError();
        grid = cus;
    }
    if (grid < 0) return;
    (void)hipMemsetAsync((char*)d_ws + WS_CTL, 0, CTL_BYTES, stream);
    KP kp{};
    for (int i = 0; i < 25; ++i) kp.in[i] = (const float*)d_in[i];
    kp.out = (float*)d_out; kp.ws = (unsigned char*)d_ws;
#if MK_ONE_LAUNCH
    kp.ph_lo = 0; kp.ph_hi = PH_N;
    hipLaunchKernelGGL(fwd_kernel, dim3(grid), dim3(NTHR), LDS_BYTES, stream, kp);
#else
    for (int ph = 0; ph < PH_N; ++ph) { kp.ph_lo = ph; kp.ph_hi = ph + 1; hipLaunchKernelGGL(fwd_kernel, dim3(grid), dim3(NTHR), LDS_BYTES, stream, kp); }
#endif
}
```

```cpp
#include <hip/hip_runtime.h>
#include <cstdio>
#include <cstdint>

#ifndef MK_ONE_LAUNCH
#define MK_ONE_LAUNCH 1
#endif

#define GAS __attribute__((address_space(1)))
#define LAS __attribute__((address_space(3)))
typedef unsigned short bf16;
typedef short bf16x8 __attribute__((ext_vector_type(8)));
typedef short bf16x4 __attribute__((ext_vector_type(4)));
typedef float f32x4 __attribute__((ext_vector_type(4)));
typedef float f32x2 __attribute__((ext_vector_type(2)));
typedef unsigned u32x4 __attribute__((ext_vector_type(4)));
typedef unsigned u32x2 __attribute__((ext_vector_type(2)));
#define DI __device__ __forceinline__

constexpr int D = 1024, NB = 4, SEQ = 8192, CTXL = 256;
constexpr int TL = NB * SEQ;
constexpr int TC = NB * CTXL;
constexpr int T = TL + TC;
constexpr int NE = 32, DE = 512, NH = 8;
constexpr int NCID = 528;
constexpr int DN_IN = 4128;
constexpr float EPS = 1e-6f;
constexpr int CAP = T;
constexpr int NWAVES = 8, NTHR = 512;

constexpr size_t MiB = 1u << 20;
constexpr size_t WS_CTL = 0, CTL_BYTES = 1 * MiB;
constexpr size_t WS_BTP = 1 * MiB;
constexpr size_t WS_BTOUT = 1 * MiB + 512 * 1024;
constexpr size_t WS_BTIN = 3 * MiB + 512 * 1024;
constexpr size_t WS_MOD = 12 * MiB;
constexpr size_t WS_WRT = 12 * MiB + 256 * 1024;
constexpr size_t WS_WAB = 12 * MiB + 576 * 1024;
constexpr size_t WS_RSTD = 12 * MiB + 704 * 1024;
constexpr size_t WS_WR2 = 13 * MiB;
constexpr size_t WS_C0 = 13 * MiB + 512 * 1024;
constexpr size_t WS_XC = 14 * MiB;
constexpr size_t WS_TI = 18 * MiB;
constexpr size_t WS_GU = 20 * MiB;
constexpr size_t WS_DN = 84 * MiB;
constexpr size_t WS_TM = 20 * MiB;
constexpr size_t WS_AB = 86 * MiB;
constexpr size_t WS_HALO = 91 * MiB;
constexpr size_t WS_GCB = 101 * MiB;
constexpr size_t WS_HX = 116 * MiB;
constexpr size_t WS_PM = 116 * MiB;
constexpr size_t WS_XS1 = 182 * MiB;
constexpr size_t WS_XS3 = 472 * MiB;
constexpr size_t WS_DD = 182 * MiB;
constexpr size_t WS_YP = 248 * MiB;
constexpr size_t WS_Y2 = 380 * MiB;
constexpr size_t WS_HID = 248 * MiB;
constexpr size_t WS_Y = 322 * MiB;
constexpr size_t WS_PQKV = 182 * MiB;
constexpr size_t WS_Z = 380 * MiB;
constexpr size_t WS_LM = 444 * MiB;
constexpr size_t WS_O = 444 * MiB;
constexpr size_t WS_ENT = 572 * MiB;
constexpr size_t WS_END = 572 * MiB + (size_t)NE * CAP * 8;
static_assert(WS_END <= 581 * MiB, "ws map");
constexpr int CW_BAR = 4096;
constexpr int CW_CNT = 16384, CNT_STRIDE = 1024;
constexpr int LDS_BYTES = 147456;
constexpr int LDS_MISC = 131072;
constexpr int PH_N = 17;

struct Entry { int ts; float w; };
struct KP { const float* in[25]; float* out; unsigned char* ws; int ph_lo, ph_hi; };

typedef __bf16 hwbf2 __attribute__((ext_vector_type(2)));
DI unsigned f2bf(float f) { const __bf16 h = (__bf16)f; return (unsigned)__builtin_bit_cast(unsigned short, h); }
DI unsigned pk2(float lo, float hi) { const f32x2 v = {lo, hi}; const hwbf2 r = __builtin_convertvector(v, hwbf2); return __builtin_bit_cast(unsigned, r); }
DI float bflo(unsigned w) { return __builtin_bit_cast(float, w << 16); }
DI float bfhi(unsigned w) { return __builtin_bit_cast(float, w & 0xffff0000u); }
DI float bf2f(unsigned short b) { return __builtin_bit_cast(float, ((unsigned)b) << 16); }
DI void unpk8(const u32x4 q, f32x4& a, f32x4& b) { a = (f32x4){bflo(q.x), bfhi(q.x), bflo(q.y), bfhi(q.y)}; b = (f32x4){bflo(q.z), bfhi(q.z), bflo(q.w), bfhi(q.w)}; }
DI u32x4 pk8(const f32x4 a, const f32x4 b) { u32x4 q; q.x = pk2(a.x, a.y); q.y = pk2(a.z, a.w); q.z = pk2(b.x, b.y); q.w = pk2(b.z, b.w); return q; }
DI float wave_sum(float v) {
#pragma unroll
    for (int o = 1; o < 64; o <<= 1) v += __shfl_xor(v, o);
    return v;
}
DI float siluf(float x) { return x / (1.f + __expf(-x)); }
DI float sigmoidf_(float x) { return 1.f / (1.f + __expf(-x)); }
DI float softplusf_(float x) { return fmaxf(x, 0.f) + log1pf(__expf(-fabsf(x))); }

#define XB_TMO      128
#define XB_XCNT(j)  (256  + 64 * (j))
#define XB_XSUB(j)  (1280 + 64 * (j))
#define XB_XGEN(j)  (2304 + 64 * (j))
#define XB_TOP      3328
#define XB_TOPGEN   3392
#define XCD_BAR_WORDS 3456
#define XB_SPIN_CAP (1u << 18)
__device__ __forceinline__ unsigned xb_ld(unsigned* p)              { return __hip_atomic_load(p, __ATOMIC_RELAXED, __HIP_MEMORY_SCOPE_AGENT); }
__device__ __forceinline__ unsigned xb_add(unsigned* p, unsigned v) { return __hip_atomic_fetch_add(p, v, __ATOMIC_RELAXED, __HIP_MEMORY_SCOPE_AGENT); }
__device__ __forceinline__ unsigned xb_xcc_id() { return (unsigned)__builtin_amdgcn_s_getreg((3 << 11) | 20) & 0xFu; }
#define XB_SPIN(cond, bar) do { unsigned _sp = 0; while (cond) { __builtin_amdgcn_s_sleep(1); \
    if ((++_sp & 255u) == 0u) { if (xb_ld(&(bar)[XB_TMO])) break; if (_sp > XB_SPIN_CAP) { atomicAdd(&(bar)[XB_TMO], 1u); break; } } } } while (0)
struct XcdBarrier { unsigned* bar; unsigned x; volatile LAS unsigned* st; };
__device__ __forceinline__ XcdBarrier xcd_barrier_post(unsigned* bar, volatile LAS unsigned* st) {
    XcdBarrier b; b.bar = bar; b.x = xb_xcc_id(); b.st = st;
    if (threadIdx.x == 0) (void)xb_add(&bar[XB_XCNT(b.x)], 1u);
    return b;
}
__device__ __forceinline__ void xcd_barrier_complete(unsigned* bar, unsigned x, unsigned& nloc, unsigned& nx) {
    const unsigned G = gridDim.x * gridDim.y * gridDim.z;
    unsigned sum, cnt, mine, sp = 0u;
    for (;;) {
        sum = 0u; cnt = 0u; mine = 0u;
#pragma unroll
        for (unsigned j = 0; j < 16; ++j) { const unsigned c = xb_ld(&bar[XB_XCNT(j)]); sum += c; cnt += (c > 0u) ? 1u : 0u; mine = (j == x) ? c : mine; }
        if (sum == G) break;
        __builtin_amdgcn_s_sleep(1);
        if ((++sp & 255u) == 0u) { if (xb_ld(&bar[XB_TMO])) break; if (sp > XB_SPIN_CAP) { atomicAdd(&bar[XB_TMO], 1u); break; } }
    }
    nloc = mine > 0u ? mine : 1u; nx = cnt > 0u ? cnt : 1u;
}
__device__ __forceinline__ void xcd_barrier(const XcdBarrier& b) {
    asm volatile("s_waitcnt vmcnt(0)" ::: "memory");
    __syncthreads();
    if (threadIdx.x == 0) {
        unsigned* bar = b.bar;
        __builtin_amdgcn_s_waitcnt(0);
        unsigned nloc = b.st[0], nx = b.st[1];
        if (nloc == 0u) { xcd_barrier_complete(bar, b.x, nloc, nx); b.st[0] = nloc; b.st[1] = nx; }
        const unsigned old = xb_add(&bar[XB_XSUB(b.x)], 1u);
        const unsigned gen = old / nloc;
        if (old + 1u == (gen + 1u) * nloc) {
            __builtin_amdgcn_fence(__ATOMIC_RELEASE, "agent");
            asm volatile("s_waitcnt vmcnt(0)" ::: "memory");
            const unsigned og = xb_add(&bar[XB_TOP], 1u);
            const unsigned tg = og / nx;
            if (og + 1u == (tg + 1u) * nx) xb_add(&bar[XB_TOPGEN], 1u);
            else XB_SPIN(xb_ld(&bar[XB_TOPGEN]) == tg, bar);
            __builtin_amdgcn_fence(__ATOMIC_ACQUIRE, "agent");
            xb_add(&bar[XB_XGEN(b.x)], 1u);
            asm volatile("s_waitcnt vmcnt(0)" ::: "memory");
        } else {
            XB_SPIN(xb_ld(&bar[XB_XGEN(b.x)]) == gen, bar);
            __builtin_amdgcn_fence(__ATOMIC_ACQUIRE, "agent");
            asm volatile("s_waitcnt vmcnt(0)" ::: "memory");
        }
    }
    __syncthreads();
}

namespace pg8 {
constexpr int BM = 256, BK = 64, HALF = 128, HTB = HALF * BK * 2, STAGE_BYTES = 8 * HTB;
DI int lds_byte(int r, int c) { const int st = (r >> 4) * 2 + (c >> 5), rr = r & 15, cc = c & 31, ob = rr * 64 + cc * 2; return st * 1024 + (ob ^ (((ob >> 9) & 1) << 5)); }
DI void stage_rc(int b, int& R, int& C) { const int st = b / 1024, sb = b % 1024, swz = sb ^ (((sb >> 9) & 1) << 5); R = (st >> 1) * 16 + swz / 64; C = (st & 1) * 32 + (swz % 64) / 2; }
DI int perm32(int rho) { const int n = rho >> 4, i = rho & 15; return 8 * (i >> 2) + 4 * n + (i & 3); }
struct Unit { int pm, pn, e, rt, nvalid; };
struct Gemm { const bf16* A; const bf16* Bt; int K; };

template <class Epi, class Sched, bool GATHER>
DI void gemm_phase(LAS unsigned char* lds, const Gemm g, const Sched& S, const Epi& E) {
    const int tid = threadIdx.x, wid = __builtin_amdgcn_readfirstlane(tid >> 6), lane = tid & 63, wr = wid >> 2, wc = wid & 3, fr = lane & 15, fq = lane >> 4;
    const int K = g.K, nt = K / BK;
    unsigned voffA[2], voffB[2]; int Rr[2], Cc[2];
#pragma unroll
    for (int i = 0; i < 2; ++i) { int R, C; stage_rc(tid * 16 + i * 8192, R, C); const int Rb = Epi::PERM ? ((R & ~31) + perm32(R & 31)) : R;
        voffA[i] = (unsigned)(R * K + C) * 2u; voffB[i] = (unsigned)((Epi::PERM ? (64 * (R >> 5) + perm32(R & 31)) : Rb) * K + C) * 2u; Rr[i] = R; Cc[i] = C; }
    const size_t kstep = (size_t)(BK * 2);
    const size_t hstep = (size_t)HALF * K * 2;
    const size_t tstep = 2 * hstep;
    const size_t hstepB = Epi::PERM ? (size_t)32 * K * 2 : hstep;
    const unsigned ldsw = (unsigned)wid * 1024u;
    const int aoff = lds_byte(wr * 64 + fr, fq * 8), boff = lds_byte(wc * 32 + fr, fq * 8);
#define PG8_SA(b, h) (((b) * 2 + (h)) * HTB)
#define PG8_SB(b, h) ((4 + (b) * 2 + (h)) * HTB)
#define PG8_STAGE(bufoff, gbase, voff) do { _Pragma("unroll") for (int _i = 0; _i < 2; ++_i) \
        __builtin_amdgcn_global_load_lds((const unsigned*)((const char*)(gbase) + (voff)[_i]), (LAS unsigned*)(lds + (bufoff) + ldsw + _i * 8192), 16, 0, 0); } while (0)
#define PG8_STAGE_A(bufoff, ptr, offs, h, kb) do { _Pragma("unroll") for (int _i = 0; _i < 2; ++_i) { \
        const char* _src = GATHER ? ((const char*)g.A + (offs)[(h) * 2 + _i] + (kb)) : ((const char*)(ptr) + voffA[_i]); \
        __builtin_amdgcn_global_load_lds((const unsigned*)_src, (LAS unsigned*)(lds + (bufoff) + ldsw + _i * 8192), 16, 0, 0); } } while (0)
#define PG8_LDA(dst, b, h) do { _Pragma("unroll") for (int m = 0; m < 4; ++m) _Pragma("unroll") for (int k = 0; k < 2; ++k) dst[m][k] = *(const LAS bf16x8*)(lds + PG8_SA(b, h) + aoff + m * 2048 + k * 1024); } while (0)
#define PG8_LDB(dst, b, h) do { _Pragma("unroll") for (int n = 0; n < 2; ++n) _Pragma("unroll") for (int k = 0; k < 2; ++k) dst[n][k] = *(const LAS bf16x8*)(lds + PG8_SB(b, h) + boff + n * 2048 + k * 1024); } while (0)
#define PG8_MMA(ai, bj, At, Bt) do { __builtin_amdgcn_s_setprio(1); _Pragma("unroll") for (int m = 0; m < 4; ++m) _Pragma("unroll") for (int n = 0; n < 2; ++n) _Pragma("unroll") for (int k = 0; k < 2; ++k) \
        acc[ai][bj][m][n] = __builtin_amdgcn_mfma_f32_16x16x32_bf16(Bt[n][k], At[m][k], acc[ai][bj][m][n], 0, 0, 0); __builtin_amdgcn_s_setprio(0); } while (0)
#define PG8_WAIT_V(n) asm volatile("s_waitcnt vmcnt(" #n ")" ::: "memory")
#define PG8_WAIT_L(n) asm volatile("s_waitcnt lgkmcnt(" #n ")" ::: "memory")
#define PG8_BAR __builtin_amdgcn_s_barrier()
#define PG8_SCHED __builtin_amdgcn_sched_barrier(0)
#define PG8_OFFS(u, o) do { _Pragma("unroll") for (int _h = 0; _h < 2; ++_h) _Pragma("unroll") for (int _i = 0; _i < 2; ++_i) (o)[_h * 2 + _i] = S.row_off((u), _h * HALF + Rr[_i]) + (unsigned)Cc[_i] * 2u; } while (0)
    Unit cur, nxt; int ui = 0;
    if (!S.next(0, cur)) return;
    f32x4 acc[2][2][4][2];
#pragma unroll
    for (int a = 0; a < 2; ++a)
#pragma unroll
        for (int b = 0; b < 2; ++b)
#pragma unroll
            for (int m = 0; m < 4; ++m)
#pragma unroll
                for (int n = 0; n < 2; ++n) acc[a][b][m][n] = (f32x4){0.f, 0.f, 0.f, 0.f};
    bf16x8 At[4][2], B0[2][2], B1[2][2];
    unsigned oc[4] = {0u, 0u, 0u, 0u}, on[4] = {0u, 0u, 0u, 0u};
    const char* cA = GATHER ? (const char*)g.A : (const char*)g.A + (size_t)cur.pm * tstep; const char* cB = (const char*)g.Bt + (size_t)cur.pn * tstep;
    if (GATHER) PG8_OFFS(cur, oc);
    PG8_STAGE(PG8_SB(0, 0), cB, voffB); PG8_STAGE_A(PG8_SA(0, 0), cA, oc, 0, 0); PG8_STAGE(PG8_SB(0, 1), cB + hstepB, voffB); PG8_STAGE_A(PG8_SA(0, 1), cA + hstep, oc, 1, 0);
    if (wr == 1) PG8_BAR;
    PG8_WAIT_V(4); PG8_BAR;
    PG8_STAGE(PG8_SB(1, 0), cB + kstep, voffB); PG8_STAGE_A(PG8_SA(1, 0), cA + kstep, oc, 0, kstep); PG8_STAGE(PG8_SB(1, 1), cB + hstepB + kstep, voffB);
    PG8_WAIT_V(6); PG8_BAR;
    for (;;) {
        const bool has_next = S.next(ui + 1, nxt);
        const char* nA = GATHER ? cA : (has_next ? (const char*)g.A + (size_t)nxt.pm * tstep : cA); const char* nB = has_next ? (const char*)g.Bt + (size_t)nxt.pn * tstep : cB;
        if (GATHER) { if (has_next) PG8_OFFS(nxt, on); else {
#pragma unroll
            for (int q = 0; q < 4; ++q) on[q] = oc[q]; } }
        for (int t = 0; t < nt; t += 2) {
            const bool last = (t == nt - 2);
            const char* a1 = cA + (size_t)(t + 1) * kstep;
            const char* a2 = last ? nA : cA + (size_t)(t + 2) * kstep; const char* b2 = last ? nB : cB + (size_t)(t + 2) * kstep;
            const char* a3 = a2 + kstep; const char* b3 = b2 + kstep;
            const size_t k1 = (size_t)(t + 1) * kstep, k2 = last ? (size_t)0 : (size_t)(t + 2) * kstep, k3 = k2 + kstep;
            unsigned o2[4];
#pragma unroll
            for (int q = 0; q < 4; ++q) o2[q] = last ? on[q] : oc[q];
            PG8_LDB(B0, 0, 0); PG8_SCHED; PG8_LDA(At, 0, 0); PG8_STAGE_A(PG8_SA(1, 1), a1 + hstep, oc, 1, k1);
            PG8_WAIT_L(8); PG8_BAR; PG8_WAIT_L(0); PG8_MMA(0, 0, At, B0); PG8_BAR; PG8_SCHED;
            PG8_LDB(B1, 0, 1); PG8_STAGE(PG8_SB(0, 0), b2, voffB);
            PG8_BAR; PG8_WAIT_L(0); PG8_MMA(0, 1, At, B1); PG8_BAR;
            PG8_LDA(At, 0, 1); PG8_STAGE_A(PG8_SA(0, 0), a2, o2, 0, k2);
            PG8_BAR; PG8_WAIT_L(0); PG8_MMA(1, 0, At, B0); PG8_BAR; PG8_SCHED;
            PG8_STAGE(PG8_SB(0, 1), b2 + hstepB, voffB);
            PG8_WAIT_V(6); PG8_BAR; PG8_MMA(1, 1, At, B1); PG8_BAR;
            PG8_LDB(B0, 1, 0); PG8_SCHED; PG8_LDA(At, 1, 0); PG8_STAGE_A(PG8_SA(0, 1), a2 + hstep, o2, 1, k2);
            PG8_WAIT_L(8); PG8_BAR; PG8_WAIT_L(0); PG8_MMA(0, 0, At, B0); PG8_BAR; PG8_SCHED;
            PG8_LDB(B1, 1, 1); PG8_STAGE(PG8_SB(1, 0), b3, voffB);
            PG8_BAR; PG8_WAIT_L(0); PG8_MMA(0, 1, At, B1); PG8_BAR;
            PG8_LDA(At, 1, 1); PG8_STAGE_A(PG8_SA(1, 0), a3, o2, 0, k3);
            PG8_BAR; PG8_WAIT_L(0); PG8_MMA(1, 0, At, B0); PG8_BAR; PG8_SCHED;
            PG8_STAGE(PG8_SB(1, 1), b3 + hstepB, voffB);
            PG8_WAIT_V(6); PG8_BAR; PG8_MMA(1, 1, At, B1); PG8_BAR;
        }
        E(acc, cur, wr, wc, fr, fq);
        if (!has_next) break;
#pragma unroll
        for (int a = 0; a < 2; ++a)
#pragma unroll
            for (int b = 0; b < 2; ++b)
#pragma unroll
                for (int m = 0; m < 4; ++m)
#pragma unroll
                    for (int n = 0; n < 2; ++n) acc[a][b][m][n] = (f32x4){0.f, 0.f, 0.f, 0.f};
        cur = nxt; cA = nA; cB = nB; ++ui;
#pragma unroll
        for (int q = 0; q < 4; ++q) oc[q] = on[q];
    }
    PG8_WAIT_V(0);
    if (wr == 0) PG8_BAR;
    PG8_BAR;
#undef PG8_SA
#undef PG8_SB
#undef PG8_STAGE
#undef PG8_STAGE_A
#undef PG8_LDA
#undef PG8_LDB
#undef PG8_MMA
#undef PG8_WAIT_V
#undef PG8_WAIT_L
#undef PG8_BAR
#undef PG8_SCHED
#undef PG8_OFFS
}
}
using pg8::Unit;

struct Frame {
    LAS unsigned char* lds;
    int tid, lane, wave, bid, G;
    unsigned char* ws; float* out;
};
DI float* xs_row(const Frame& F, int t) { return t < TL ? F.out + (size_t)t * D : (float*)(F.ws + WS_XC) + (size_t)(t - TL) * D; }
DI int mod_row(int t) { return t < TL ? (t >> 13) : 4; }
DI const float* modp(const Frame& F, int l, int r, int chunk) { return (const float*)(F.ws + WS_MOD) + ((size_t)(l * 5 + r) * 6 + chunk) * D; }

DI void tr_item(const float* W, int N, int k0, int n0, bf16* WT, int K, int drow0, LAS float* scr, int lane) {
    float wv[32];
#pragma unroll
    for (int i = 0; i < 32; ++i) wv[i] = __builtin_nontemporal_load(W + (size_t)(k0 + 2 * i + (lane >> 5)) * N + n0 + (lane & 31));
#pragma unroll
    for (int i = 0; i < 32; ++i) scr[(2 * i + (lane >> 5)) * 33 + (lane & 31)] = wv[i];
    asm volatile("s_waitcnt lgkmcnt(0)" ::: "memory");
    const int c = lane & 7;
#pragma unroll
    for (int j = 0; j < 4; ++j) { const int n = (lane >> 3) + 8 * j; const LAS float* s = scr + (8 * c) * 33 + n;
        u32x4 o; o.x = pk2(s[0 * 33], s[1 * 33]); o.y = pk2(s[2 * 33], s[3 * 33]); o.z = pk2(s[4 * 33], s[5 * 33]); o.w = pk2(s[6 * 33], s[7 * 33]);
        *(u32x4*)(WT + (size_t)(drow0 + n) * K + k0 + 8 * c) = o; }
    asm volatile("s_waitcnt lgkmcnt(0)" ::: "memory");
}
DI void convert_experts(const Frame& F, const KP& p, int l) {
    LAS float* scr = (LAS float*)(F.lds + F.wave * 16384);
    const int gw = F.bid * NWAVES + F.wave, NGW = F.G * NWAVES;
    const float* wg = p.in[21] + (size_t)l * NE * D * DE; const float* wu = p.in[22] + (size_t)l * NE * D * DE; const float* wd = p.in[23] + (size_t)l * NE * DE * D;
    bf16* GU = (bf16*)(F.ws + WS_GU); bf16* DN = (bf16*)(F.ws + WS_DN);
    for (int it = gw; it < 3 * 8192; it += NGW) {
        const int which = it >> 13, r8 = it & 8191, e = r8 >> 8, r = r8 & 255;
        if (which < 2) { const int kb = r >> 4, nb = r & 15, n0 = 32 * nb;
            tr_item((which ? wu : wg) + (size_t)e * D * DE, DE, 64 * kb, n0, GU, D, e * 1024 + 256 * (n0 >> 7) + 64 * ((n0 & 127) >> 5) + (which ? 32 : 0), scr, F.lane); }
        else { const int kb = r >> 5, nb = r & 31, n0 = 32 * nb;
            tr_item(wd + (size_t)e * DE * D, D, 64 * kb, n0, DN, DE, e * 1024 + n0, scr, F.lane); }
    }
}
DI void p0_prologue(const Frame& F, const KP& p) {
    const int gw = F.bid * NWAVES + F.wave, NGW = F.G * NWAVES;
    {
        LAS float* sc = (LAS float*)(F.lds);
        LAS float* part = (LAS float*)(F.lds + 32768);
        for (int i = F.tid; i < 5 * D; i += NTHR) { const int r = i >> 10, k = i & 1023; const float v = r < 4 ? p.in[1][r * D + k] : p.in[3][k]; sc[i] = siluf(v); }
        __syncthreads();
        for (int item = F.bid; item < 192; item += F.G) {
            const int l = item / 96, n0 = (item % 96) * 64;
            const float* w = p.in[4] + (size_t)l * D * 6144 + n0 + F.lane;
            float a0 = 0.f, a1 = 0.f, a2 = 0.f, a3 = 0.f, a4 = 0.f;
            const int kb = F.wave * 128;
#pragma unroll 32
            for (int k = 0; k < 128; ++k) { const float wv = __builtin_nontemporal_load(w + (size_t)(kb + k) * 6144);
                a0 += sc[kb + k] * wv; a1 += sc[D + kb + k] * wv; a2 += sc[2 * D + kb + k] * wv; a3 += sc[3 * D + kb + k] * wv; a4 += sc[4 * D + kb + k] * wv; }
            part[(F.wave * 5 + 0) * 64 + F.lane] = a0; part[(F.wave * 5 + 1) * 64 + F.lane] = a1; part[(F.wave * 5 + 2) * 64 + F.lane] = a2;
            part[(F.wave * 5 + 3) * 64 + F.lane] = a3; part[(F.wave * 5 + 4) * 64 + F.lane] = a4;
            __syncthreads();
            if (F.tid < 320) { const int r = F.tid >> 6, n = F.tid & 63; float s = p.in[5][l * 6144 + n0 + n];
#pragma unroll
                for (int w8 = 0; w8 < 8; ++w8) s += part[(w8 * 5 + r) * 64 + n];
                ((float*)(F.ws + WS_MOD))[(size_t)(l * 5 + r) * 6144 + n0 + n] = s; }
            __syncthreads();
        }
        __syncthreads();
    }
    {
        LAS float* scr = (LAS float*)(F.lds + F.wave * 16384);
        constexpr int I_POOL = 128, I_IN = 2048 + 16, I_OUT = 512;
        for (int it = gw; it < I_POOL + I_IN + I_OUT; it += NGW) {
            int r = it;
            if (r < I_POOL) { const int g = r >> 5, q = r & 31, kb = q >> 3, nb = q & 7; tr_item(p.in[8] + (size_t)g * 65536, 256, 64 * kb, 32 * nb, (bf16*)(F.ws + WS_BTP), 256, g * 256 + 32 * nb, scr, F.lane); continue; }
            r -= I_POOL;
            if (r < I_IN) { const int kb = r < 2048 ? (r >> 7) : (r - 2048), nb = r < 2048 ? (r & 127) : 128; tr_item(p.in[11], DN_IN, 64 * kb, 32 * nb, (bf16*)(F.ws + WS_BTIN), D, 32 * nb, scr, F.lane); continue; }
            r -= I_IN;
            { const int kb = r >> 5, nb = r & 31; tr_item(p.in[16], D, 64 * kb, 32 * nb, (bf16*)(F.ws + WS_BTOUT), D, 32 * nb, scr, F.lane); }
        }
    }
    {
        const int gt = F.bid * NTHR + F.tid, NGT = F.G * NTHR;
        bf16* wr2 = (bf16*)(F.ws + WS_WR2);
        for (int i = gt; i < 2 * 48 * D; i += NGT) { const int l = i / (48 * D), r = i % (48 * D), j = r >> 10, k = r & 1023;
            const float w = j < 4 ? p.in[17][((size_t)l * D + k) * 4 + j] : (j < 36 ? p.in[19][((size_t)l * D + k) * 32 + (j - 4)] : 0.f);
            const unsigned hi = f2bf(w); const float rem = w - bf2f((unsigned short)hi);
            wr2[(size_t)(l * 2 + 0) * 48 * D + r] = (bf16)hi; wr2[(size_t)(l * 2 + 1) * 48 * D + r] = (bf16)f2bf(rem); }
        u32x4* zr = (u32x4*)((bf16*)(F.ws + WS_BTIN) + (size_t)4128 * D);
        for (int i = gt; i < 224 * D / 8; i += NGT) zr[i] = (u32x4){0u, 0u, 0u, 0u};
    }
    {
        float* rs = (float*)(F.ws + WS_RSTD);
        for (int t = gw; t < T; t += NGW) {
            const f32x4* xr = (const f32x4*)(t < TL ? p.in[0] + (size_t)t * D : p.in[2] + (size_t)(t - TL) * D) + F.lane;
            float s = 0.f;
#pragma unroll
            for (int j = 0; j < 4; ++j) { const f32x4 v = xr[64 * j]; s += (v.x * v.x + v.y * v.y) + (v.z * v.z + v.w * v.w); }
            s = wave_sum(s);
            if (F.lane == 0) rs[t] = rsqrtf(s * (1.f / D) + EPS);
        }
    }
}

DI void p1_pool_diff(const Frame& F, const KP& p) {
    const float* rs = (const float*)(F.ws + WS_RSTD);
    bf16* DD = (bf16*)(F.ws + WS_DD);
    LAS f32x4* Vs = (LAS f32x4*)(F.lds);
    const int ch4 = F.tid & 63, cg = F.tid >> 6;
    {
        const int gw = F.bid * NWAVES + F.wave;
        if (gw < 2 * 5 * 36) { const int l = gw / 180, q = gw % 180, r = q / 36, j = q % 36; const float* b2 = modp(F, l, r, 3); float s = 0.f;
            for (int i = 0; i < 16; ++i) { const int c = F.lane + 64 * i; const float w = j < 4 ? p.in[17][((size_t)l * D + c) * 4 + j] : p.in[19][((size_t)l * D + c) * 32 + (j - 4)]; s += b2[c] * w; }
            s = wave_sum(s);
            if (F.lane == 0) ((float*)(F.ws + WS_C0))[(l * 5 + r) * 48 + j] = s + (j < 4 ? p.in[18][l * 4 + j] : p.in[20][l * 32 + (j - 4)]); }
    }
    LAS float* rsl = (LAS float*)(F.lds + 65536);
    for (int it = F.bid; it < 256 + 64; it += F.G) {
        if (it < 256) {
            const int g = it & 3, bb = it >> 2, b = bb >> 4, r0 = (bb & 15) * 8, hw = 1 << g;
            const int ch = g * 256 + 4 * ch4;
            f32x4 A4 = *(const f32x4*)(p.in[6] + ch); { const f32x4 s4 = *(const f32x4*)(modp(F, 0, b, 1) + ch); A4 = A4 * (s4 + 1.f); }
            const int rlo = max(r0 - hw, 0), rhi = min(r0 + 8 + hw, 128);
            for (int i = F.tid; i < (rhi - rlo) * 64; i += NTHR) rsl[i] = rs[b * SEQ + rlo * 64 + i];
            __syncthreads();
            const float* xb = p.in[0] + (size_t)b * SEQ * D + ch + (size_t)(8 * cg) * D;
            f32x4 S[8];
#pragma unroll
            for (int cc = 0; cc < 8; ++cc) S[cc] = (f32x4){0.f, 0.f, 0.f, 0.f};
            for (int rr = rlo; rr < min(r0 + hw, 128); ++rr) {
#pragma unroll
                for (int cc = 0; cc < 8; ++cc) S[cc] += *(const f32x4*)(xb + (size_t)(rr * 64 + cc) * D) * rsl[(rr - rlo) * 64 + 8 * cg + cc]; }
            for (int r = r0; r < r0 + 8; ++r) {
                const int lo_r = max(r - hw, 0), hi_r = min(r + hw, 128);
                f32x4 xc[8], xa[8], xs_[8];
                const bool ha = (r + hw) < 128, hs = (r - hw) >= 0;
#pragma unroll
                for (int cc = 0; cc < 8; ++cc) { xc[cc] = *(const f32x4*)(xb + (size_t)(r * 64 + cc) * D);
                    xa[cc] = ha ? *(const f32x4*)(xb + (size_t)((r + hw) * 64 + cc) * D) : (f32x4){0.f, 0.f, 0.f, 0.f};
                    xs_[cc] = hs ? *(const f32x4*)(xb + (size_t)((r - hw) * 64 + cc) * D) : (f32x4){0.f, 0.f, 0.f, 0.f}; }
#pragma unroll
                for (int cc = 0; cc < 8; ++cc) Vs[(8 * cg + cc) * 64 + ch4] = S[cc];
                __syncthreads();
                f32x4 h = {0.f, 0.f, 0.f, 0.f};
                { const int c0 = 8 * cg, l0 = max(c0 - hw, 0), h0 = min(c0 + hw, 64); for (int c2 = l0; c2 < h0; ++c2) h += Vs[c2 * 64 + ch4]; }
#pragma unroll
                for (int cc = 0; cc < 8; ++cc) { const int col = 8 * cg + cc, lo_c = max(col - hw, 0), hi_c = min(col + hw, 64);
                    if (cc > 0) { if (col + hw <= 64) h += Vs[(col + hw - 1) * 64 + ch4]; if (col - hw > 0) h -= Vs[(col - hw - 1) * 64 + ch4]; }
                    const int t = b * SEQ + r * 64 + col; const float inv = 1.f / (float)((hi_r - lo_r) * (hi_c - lo_c));
                    const f32x4 xn = xc[cc] * rsl[(r - rlo) * 64 + col];
                    const f32x4 d = A4 * (h * inv - xn);
                    u32x2 o; o.x = pk2(d.x, d.y); o.y = pk2(d.z, d.w);
                    *(u32x2*)(DD + ((size_t)g * T + t) * 256 + 4 * ch4) = o; }
#pragma unroll
                for (int cc = 0; cc < 8; ++cc) { if (ha) S[cc] += xa[cc] * rsl[(r + hw - rlo) * 64 + 8 * cg + cc]; if (hs) S[cc] -= xs_[cc] * rsl[(r - hw - rlo) * 64 + 8 * cg + cc]; }
                __syncthreads();
            }
        } else {
            const int i2 = it - 256, g = i2 & 3, b = (i2 >> 2) & 3, q4 = i2 >> 4, hw = 1 << g;
            const int ch = g * 256 + 4 * ch4;
            f32x4 A4 = *(const f32x4*)(p.in[6] + ch); { const f32x4 s4 = *(const f32x4*)(modp(F, 0, 4, 1) + ch); A4 = A4 * (s4 + 1.f); }
#pragma unroll
            for (int cc = 0; cc < 8; ++cc) { const int j = 64 * q4 + 8 * cg + cc, lo = max(j - hw, 0), hi = min(j + hw, CTXL); f32x4 a = {0.f, 0.f, 0.f, 0.f};
                for (int jj = lo; jj < hi; ++jj) a += *(const f32x4*)(p.in[2] + (size_t)(b * CTXL + jj) * D + ch) * rs[TL + b * CTXL + jj];
                const int t = TL + b * CTXL + j; const float inv = 1.f / (float)(hi - lo);
                const f32x4 xn = *(const f32x4*)(p.in[2] + (size_t)(b * CTXL + j) * D + ch) * rs[t];
                const f32x4 d = A4 * (a * inv - xn);
                u32x2 o; o.x = pk2(d.x, d.y); o.y = pk2(d.z, d.w);
                *(u32x2*)(DD + ((size_t)g * T + t) * 256 + 4 * ch4) = o; }
        }
    }
}

struct PoolOrder {
    int G, c;
    DI bool next(int i, Unit& u) const { const int L = i * G + c; if (L >= 528) return false; u.pm = L; u.pn = L / 132; u.e = 0; u.rt = 0; u.nvalid = 0; return true; }
    DI unsigned row_off(const Unit&, int) const { return 0u; }
};
struct G1Order {
    int G, c;
    DI bool next(int i, Unit& u) const {
        if (G == 256) { if (i < 8) { const int x = c & 7, j = c >> 3; u.pm = (i * 8 + x) * 2 + (j >> 4); u.pn = j & 15; }
            else { const int q = (i - 8) * 256 + c; if (q >= 48 + 132) return false; if (q < 48) { u.pm = 128 + q / 12; u.pn = q % 12; } else { u.pm = q - 48; u.pn = 16; } } }
        else { const int L = i * G + c; if (L >= 2176 + 52) return false;
            if (L < 2176) { u.pm = L / 17; u.pn = L % 17; } else { const int q = L - 2176, q13 = q % 13; u.pm = 128 + q / 13; u.pn = q13 < 12 ? q13 : 16; } }
        u.e = 0; u.rt = 0; u.nvalid = 0; return true; }
    DI unsigned row_off(const Unit&, int) const { return 0u; }
};
struct G2Order {
    int G, c;
    DI bool next(int i, Unit& u) const {
        if (G == 256) { if (i >= 2) return false; const int x = c & 7, j = c >> 3; u.pm = (i * 8 + x) * 8 + (j >> 2); u.pn = j & 3; }
        else { const int L = i * G + c; if (L >= 512) return false; u.pm = L >> 2; u.pn = L & 3; }
        u.e = 0; u.rt = 0; u.nvalid = 0; return true; }
    DI unsigned row_off(const Unit&, int) const { return 0u; }
};
struct MoeOrder {
    int G, c, total; const LAS int* tb; const LAS int* cn; const Entry* ent;
    DI bool next(int i, Unit& u) const { int rtg, ct;
        if (G == 256) { const int x = c & 7, j = c >> 3; ct = j & 3; rtg = 64 * i + 8 * x + (j >> 2); if (rtg >= total) return false; }
        else { const int L = i * G + c; if (L >= 4 * total) return false; rtg = L >> 2; ct = L & 3; }
        int e = 0;
        for (int q = 1; q < NE; ++q) e += (tb[q] <= rtg) ? 1 : 0;
        u.pm = rtg; u.pn = e * 4 + ct; u.e = e; u.rt = rtg - tb[e]; u.nvalid = cn[e] - u.rt * 256; return true; }
    DI unsigned row_off(const Unit& u, int row) const { int tok = 0; if (row < u.nvalid) tok = ent[(size_t)u.e * CAP + u.rt * 256 + row].ts >> 1; return (unsigned)tok * (unsigned)(D * 2); }
};
DI void moe_tables(const Frame& F, int l, LAS int* tb, LAS int* cn) {
    if (F.tid < 64) { const unsigned* cnt = (const unsigned*)(F.ws + WS_CTL) + CW_CNT + l * 32 * CNT_STRIDE;
        const int c = F.tid < NE ? (int)__hip_atomic_load(cnt + F.tid * CNT_STRIDE, __ATOMIC_RELAXED, __HIP_MEMORY_SCOPE_AGENT) : 0;
        const int ntl = (c + 255) >> 8; int inc = ntl;
#pragma unroll
        for (int o = 1; o < 32; o <<= 1) { const int up = __shfl_up(inc, o); if (F.lane >= o) inc += up; }
        if (F.tid < NE) { cn[F.tid] = c; tb[F.tid] = inc - ntl; if (F.tid == NE - 1) tb[NE] = inc; } }
    __syncthreads();
}

struct EpiRaw {
    static constexpr bool PERM = true;
    bf16* o; int pool;
    DI void operator()(const f32x4 (&acc)[2][2][4][2], const Unit& u, int, int, int, int) const {
        int tz = threadIdx.x; asm volatile("" : "+v"(tz)); const int wr = tz >> 8, wc = (tz >> 6) & 3, fr = tz & 15, fq = (tz >> 4) & 3;
        const int rt = pool ? u.pm - 132 * u.pn : u.pm;
#pragma unroll
        for (int ai = 0; ai < 2; ++ai)
#pragma unroll
            for (int m = 0; m < 4; ++m) { bf16* dst = o + (size_t)(rt * 256 + ai * 128 + wr * 64 + m * 16 + fr) * D + u.pn * 256 + wc * 64 + 8 * fq;
#pragma unroll
                for (int bj = 0; bj < 2; ++bj) { const f32x4 v0 = acc[ai][bj][m][0], v1 = acc[ai][bj][m][1];
                    u32x4 w; w.x = pk2(v0.x, v0.y); w.y = pk2(v0.z, v0.w); w.z = pk2(v1.x, v1.y); w.w = pk2(v1.z, v1.w);
                    *(u32x4*)(dst + bj * 32) = w; } }
    }
};
struct EpiGU {
    static constexpr bool PERM = true;
    bf16* hid;
    DI void operator()(const f32x4 (&acc)[2][2][4][2], const Unit& u, int, int, int, int) const {
        int tz = threadIdx.x; asm volatile("" : "+v"(tz)); const int wr = tz >> 8, wc = (tz >> 6) & 3, fr = tz & 15, fq = (tz >> 4) & 3;
        const int ct = u.pn & 3;
#pragma unroll
        for (int ai = 0; ai < 2; ++ai)
#pragma unroll
            for (int m = 0; m < 4; ++m) { const size_t row = (size_t)u.pm * 256 + ai * 128 + wr * 64 + m * 16 + fr;
                const f32x4 g0 = acc[ai][0][m][0], g1 = acc[ai][0][m][1], u0 = acc[ai][1][m][0], u1 = acc[ai][1][m][1];
                u32x4 w; w.x = pk2(siluf(g0.x) * u0.x, siluf(g0.y) * u0.y); w.y = pk2(siluf(g0.z) * u0.z, siluf(g0.w) * u0.w);
                w.z = pk2(siluf(g1.x) * u1.x, siluf(g1.y) * u1.y); w.w = pk2(siluf(g1.z) * u1.z, siluf(g1.w) * u1.w);
                *(u32x4*)(hid + row * DE + ct * 128 + wc * 32 + 8 * fq) = w; }
    }
};
struct EpiDown {
    static constexpr bool PERM = true;
    bf16* y;
    DI void operator()(const f32x4 (&acc)[2][2][4][2], const Unit& u, int, int, int, int) const {
        int tz = threadIdx.x; asm volatile("" : "+v"(tz)); const int wr = tz >> 8, wc = (tz >> 6) & 3, fr = tz & 15, fq = (tz >> 4) & 3;
        const int ct = u.pn & 3;
#pragma unroll
        for (int ai = 0; ai < 2; ++ai)
#pragma unroll
            for (int m = 0; m < 4; ++m) { const size_t row = (size_t)u.pm * 256 + ai * 128 + wr * 64 + m * 16 + fr;
                bf16* dst = y + row * D + ct * 256 + wc * 64 + 8 * fq;
#pragma unroll
                for (int bj = 0; bj < 2; ++bj) { const f32x4 v0 = acc[ai][bj][m][0], v1 = acc[ai][bj][m][1];
                    u32x4 w; w.x = pk2(v0.x, v0.y); w.y = pk2(v0.z, v0.w); w.z = pk2(v1.x, v1.y); w.w = pk2(v1.z, v1.w);
                    *(u32x4*)(dst + bj * 32) = w; } }
    }
};
struct EpiG1 {
    static constexpr bool PERM = true;
    bf16* pqkv; bf16* z; bf16* halo; float* ab;
    DI void operator()(const f32x4 (&acc)[2][2][4][2], const Unit& u, int, int, int, int) const {
        int tz = threadIdx.x; asm volatile("" : "+v"(tz)); const int wr = tz >> 8, wc = (tz >> 6) & 3, fr = tz & 15, fq = (tz >> 4) & 3;
#pragma unroll
        for (int ai = 0; ai < 2; ++ai)
#pragma unroll
            for (int m = 0; m < 4; ++m) { const int t = u.pm * 256 + ai * 128 + wr * 64 + m * 16 + fr, rr = m * 16 + fr;
#pragma unroll
                for (int bj = 0; bj < 2; ++bj) { const f32x4 v0 = acc[ai][bj][m][0], v1 = acc[ai][bj][m][1];
                    u32x4 w; w.x = pk2(v0.x, v0.y); w.y = pk2(v0.z, v0.w); w.z = pk2(v1.x, v1.y); w.w = pk2(v1.z, v1.w);
                    const int col = u.pn * 256 + wc * 64 + bj * 32 + 8 * fq;
                    if (u.pn < 12) { *(u32x4*)(pqkv + (size_t)t * 3072 + col) = w;
                        if (rr == 0 || rr >= 62) { const int slot = rr == 0 ? 0 : rr - 61; *(u32x4*)(halo + ((size_t)(t >> 6) * 3 + slot) * 3072 + col) = w; } }
                    else if (u.pn < 16) *(u32x4*)(z + (size_t)t * D + (col - 3072)) = w;
                    else if (bj == 0 && wc == 0) { *(f32x4*)(ab + (size_t)t * 32 + 8 * fq) = v0; *(f32x4*)(ab + (size_t)t * 32 + 8 * fq + 4) = v1; } } }
    }
};
DI void p_router(const Frame& F, const KP& p, int l, int ntok) {
    LAS float* A2s = (LAS float*)(F.lds); LAS float* gBs = A2s + 1024; LAS float* gAs = (LAS float*)(F.lds + 126976);
    const bf16* DL = (const bf16*)(F.ws + (l == 0 ? WS_YP : WS_Y2));
    LAS float* part = (LAS float*)(F.lds + 8192);
    LAS float* pss = (LAS float*)(F.lds + 108544);
    LAS float* lgs = (LAS float*)(F.lds + 110592);
    LAS float* rsl = (LAS float*)(F.lds + 123136);
    LAS int* hist = (LAS int*)(F.lds + 123648);
    LAS int* basee = (LAS int*)(F.lds + 123648 + 128);
    LAS int* tiE = (LAS int*)(F.lds + 123648 + 256);
    LAS int* tiP = (LAS int*)(F.lds + 123648 + 256 + 1024);
    LAS float* tiW = (LAS float*)(F.lds + 123648 + 256 + 2048);
    const bf16* whi = (const bf16*)(F.ws + WS_WR2) + (size_t)(l * 2) * 48 * D; const bf16* wlo = whi + (size_t)48 * D;
    bf16* HX = (bf16*)(F.ws + WS_HX);
    unsigned* cnt = (unsigned*)(F.ws + WS_CTL) + CW_CNT + l * 32 * CNT_STRIDE;
    Entry* ent = (Entry*)(F.ws + WS_ENT);
    const float* nf = p.in[7] + l * D;
    const int fr = F.lane & 15, fq = F.lane >> 4, kw = 128 * F.wave;
    const int nunits = 256 + (ntok > TL ? 64 : 0);
    for (int un = F.bid; un < nunits; un += F.G) {
        const int t0 = un < 256 ? un * 128 : TL + (un - 256) * 16, nt16 = un < 256 ? 8 : 1, r = mod_row(t0);
        bf16x8 bh[4][3], bl[4][3];
        { int zo = 0; asm volatile("" : "+s"(zo));
#pragma unroll
          for (int ks = 0; ks < 4; ++ks)
#pragma unroll
            for (int n = 0; n < 3; ++n) { bh[ks][n] = *(const bf16x8*)(whi + zo + (size_t)(16 * n + fr) * D + kw + 32 * ks + 8 * fq); bl[ks][n] = *(const bf16x8*)(wlo + zo + (size_t)(16 * n + fr) * D + kw + 32 * ks + 8 * fq); } }
        for (int i = F.tid; i < D; i += NTHR) { A2s[i] = nf[i] * (modp(F, l, r, 4)[i] + 1.f); const float gm = modp(F, l, r, 2)[i];
            if (l == 0) { const float ps = p.in[10][i]; gAs[i] = gm * ps; gBs[i] = gm * p.in[9][i] * ps; } else { gAs[i] = gm; gBs[i] = 0.f; } }
        if (F.tid < 32) hist[F.tid] = 0;
        __syncthreads();
        const float* c0 = (const float*)(F.ws + WS_C0) + (l * 5 + r) * 48;
        const float* xbase = l == 0 ? (t0 < TL ? p.in[0] + (size_t)t0 * D : p.in[2] + (size_t)(t0 - TL) * D) : nullptr;
        const bf16* xb16 = (const bf16*)F.out + (size_t)t0 * D;
        for (int hh = 0; hh * 4 < nt16; ++hh) {
            const int mts = min(4, nt16 - 4 * hh);
#pragma unroll 2
            for (int mt = 0; mt < mts; ++mt) {
                const int tq = 64 * hh + 16 * mt;
                const float* xr = xbase + (size_t)(tq + fr) * D + kw + 8 * fq;
                const bf16* xr16 = xb16 + (size_t)(tq + fr) * D + kw + 8 * fq;
                const bf16* dr = DL + (size_t)(t0 + tq + fr) * D + kw + 8 * fq;
                f32x4 acc[3] = {{0.f, 0.f, 0.f, 0.f}, {0.f, 0.f, 0.f, 0.f}, {0.f, 0.f, 0.f, 0.f}}; float ssq = 0.f;
#pragma unroll
                for (int ks = 0; ks < 4; ++ks) {
                    f32x4 x0, x1;
                    if (l == 0) { x0 = *(const f32x4*)(xr + 32 * ks); x1 = *(const f32x4*)(xr + 32 * ks + 4); }
                    else { const u32x4 xq = *(const u32x4*)(xr16 + 32 * ks); x0 = (f32x4){bflo(xq.x), bfhi(xq.x), bflo(xq.y), bfhi(xq.y)}; x1 = (f32x4){bflo(xq.z), bfhi(xq.z), bflo(xq.w), bfhi(xq.w)}; }
                    { const u32x4 dv = *(const u32x4*)(dr + 32 * ks); const LAS float* ga = gAs + kw + 32 * ks + 8 * fq; const LAS float* gb = gBs + kw + 32 * ks + 8 * fq;
                      x0 += *(const LAS f32x4*)gb + *(const LAS f32x4*)ga * (f32x4){bflo(dv.x), bfhi(dv.x), bflo(dv.y), bfhi(dv.y)};
                      x1 += *(const LAS f32x4*)(gb + 4) + *(const LAS f32x4*)(ga + 4) * (f32x4){bflo(dv.z), bfhi(dv.z), bflo(dv.w), bfhi(dv.w)}; }
                    ssq += (x0.x * x0.x + x0.y * x0.y) + (x0.z * x0.z + x0.w * x0.w) + (x1.x * x1.x + x1.y * x1.y) + (x1.z * x1.z + x1.w * x1.w);
                    const f32x4 y0 = x0 * *(const LAS f32x4*)(A2s + kw + 32 * ks + 8 * fq), y1 = x1 * *(const LAS f32x4*)(A2s + kw + 32 * ks + 8 * fq + 4);
                    const float ya[8] = {y0.x, y0.y, y0.z, y0.w, y1.x, y1.y, y1.z, y1.w};
                    bf16x8 ah, al;
#pragma unroll
                    for (int e = 0; e < 8; ++e) { const unsigned hb = f2bf(ya[e]); ah[e] = (short)hb; al[e] = (short)f2bf(ya[e] - bf2f((unsigned short)hb)); }
#pragma unroll
                    for (int n = 0; n < 3; ++n) {
                        acc[n] = __builtin_amdgcn_mfma_f32_16x16x32_bf16(ah, bh[ks][n], acc[n], 0, 0, 0);
                        acc[n] = __builtin_amdgcn_mfma_f32_16x16x32_bf16(al, bh[ks][n], acc[n], 0, 0, 0);
                        acc[n] = __builtin_amdgcn_mfma_f32_16x16x32_bf16(ah, bl[ks][n], acc[n], 0, 0, 0); }
                }
                ssq += __shfl_xor(ssq, 16); ssq += __shfl_xor(ssq, 32);
                if (fq == 0) pss[F.wave * 64 + 16 * mt + fr] = ssq;
#pragma unroll
                for (int n = 0; n < 3; ++n)
#pragma unroll
                    for (int q = 0; q < 4; ++q) part[(F.wave * 64 + 16 * mt + 4 * fq + q) * 49 + 16 * n + fr] = acc[n][q];
            }
            __syncthreads();
            { const int tl = F.tid >> 3, jj = F.tid & 7;
              if (tl < 16 * mts) { float s = 0.f;
#pragma unroll
                for (int w = 0; w < 8; ++w) s += pss[w * 64 + tl];
                const float rstd = rsqrtf(s * (1.f / D) + EPS);
                if (jj == 0) rsl[64 * hh + tl] = rstd;
#pragma unroll
                for (int j = jj; j < 48; j += 8) { float g = 0.f;
#pragma unroll
                    for (int w = 0; w < 8; ++w) g += part[(w * 64 + tl) * 49 + j];
                    lgs[tl * 49 + j] = g * rstd + c0[j]; } } }
            __syncthreads();
            if (F.tid < 16 * mts) {
                const LAS float* lg = lgs + F.tid * 49;
                const float g0 = lg[0], g1 = lg[1], g2 = lg[2], g3 = lg[3];
                int gi = 0; float gm = g0; if (g1 > gm) { gm = g1; gi = 1; } if (g2 > gm) { gm = g2; gi = 2; } if (g3 > gm) { gm = g3; gi = 3; }
                const float pg = 1.f / (__expf(g0 - gm) + __expf(g1 - gm) + __expf(g2 - gm) + __expf(g3 - gm));
                float e1 = -3.0e38f, e2 = -3.0e38f; int i1 = 0, i2 = 0;
#pragma unroll
                for (int j = 0; j < 8; ++j) { const float v = lg[4 + gi * 8 + j];
                    if (v > e1) { e2 = e1; i2 = i1; e1 = v; i1 = j; } else if (v > e2) { e2 = v; i2 = j; } }
                const float w1 = pg / (1.f + __expf(e2 - e1)), w2 = pg - w1;
                const int E0 = gi * 8 + i1, E1 = gi * 8 + i2, tl = 64 * hh + F.tid;
                tiE[tl * 2] = E0; tiE[tl * 2 + 1] = E1; tiW[tl * 2] = w1; tiW[tl * 2 + 1] = w2;
                tiP[tl * 2] = atomicAdd((int*)&hist[E0], 1); tiP[tl * 2 + 1] = atomicAdd((int*)&hist[E1], 1);
            }
        }
        { const int rpw = 2 * nt16, tl0 = rpw * F.wave, tw = t0 + tl0;
          bf16* xo16 = (bf16*)(F.ws + (l == 0 ? WS_XS1 : WS_XS3)) + (size_t)tw * D;
          float* xo32 = (float*)(F.ws + WS_XC) + (size_t)(tw - TL) * D;
          for (int k = 0; k < rpw; k += 2) { f32x4 xa[2][2], xb[2][2]; u32x4 dv[2][2];
#pragma unroll
            for (int kk = 0; kk < 2; ++kk)
#pragma unroll
                for (int i = 0; i < 2; ++i) { const int c = 8 * F.lane + 512 * i;
                    if (l == 0) { xa[kk][i] = *(const f32x4*)(xbase + (size_t)(tl0 + k + kk) * D + c); xb[kk][i] = *(const f32x4*)(xbase + (size_t)(tl0 + k + kk) * D + c + 4); }
                    else unpk8(*(const u32x4*)(xb16 + (size_t)(tl0 + k + kk) * D + c), xa[kk][i], xb[kk][i]);
                    dv[kk][i] = *(const u32x4*)(DL + (size_t)(tw + k + kk) * D + c); }
#pragma unroll
            for (int kk = 0; kk < 2; ++kk) { const float rstd = rsl[tl0 + k + kk];
#pragma unroll
                for (int i = 0; i < 2; ++i) { const int c = 8 * F.lane + 512 * i; f32x4 da, db; unpk8(dv[kk][i], da, db);
                    const f32x4 sa = xa[kk][i] + *(const LAS f32x4*)(gBs + c) + *(const LAS f32x4*)(gAs + c) * da, sb = xb[kk][i] + *(const LAS f32x4*)(gBs + c + 4) + *(const LAS f32x4*)(gAs + c + 4) * db;
                    if (l == 0 && tw >= TL) { *(f32x4*)(xo32 + (size_t)(k + kk) * D + c) = sa; *(f32x4*)(xo32 + (size_t)(k + kk) * D + c + 4) = sb; }
                    else *(u32x4*)(xo16 + (size_t)(k + kk) * D + c) = pk8(sa, sb);
                    const float* b2 = modp(F, l, r, 3) + c;
                    const f32x4 va = sa * rstd * *(const LAS f32x4*)(A2s + c) + *(const f32x4*)b2, vb = sb * rstd * *(const LAS f32x4*)(A2s + c + 4) + *(const f32x4*)(b2 + 4);
                    *(u32x4*)(HX + (size_t)(tw + k + kk) * D + c) = pk8(va, vb); } } } }
        __syncthreads();
        { int tz = threadIdx.x; asm volatile("" : "+v"(tz));
          if (tz < 32) { const int hcount = hist[tz]; basee[tz] = hcount > 0 ? (int)__hip_atomic_fetch_add(cnt + tz * CNT_STRIDE, (unsigned)hcount, __ATOMIC_RELAXED, __HIP_MEMORY_SCOPE_AGENT) : 0; } }
        __syncthreads();
        if (F.tid < 32 * nt16) { const int tl = F.tid >> 1, E = tiE[F.tid], pos = basee[E] + tiP[F.tid]; Entry en; en.ts = (t0 + tl) * 2 + (F.tid & 1); en.w = tiW[F.tid];
            ent[(size_t)E * CAP + pos] = en;
            Entry ti; ti.ts = (E << 16) | pos; ti.w = en.w; ((Entry*)(F.ws + WS_TI))[(size_t)(t0 + tl) * 2 + (F.tid & 1)] = ti; }
        __syncthreads();
    }
}

DI void p6_n1(const Frame& F, const KP& p, const LAS int* tb) {
    const int gw = F.bid * NWAVES + F.wave, NGW = F.G * NWAVES;
    const bf16* Y = (const bf16*)(F.ws + WS_Y); bf16* HX = (bf16*)(F.ws + WS_HX); const Entry* TI = (const Entry*)(F.ws + WS_TI);
    for (int t = gw; t < T; t += NGW) {
        const int r = mod_row(t); const bool lat = t < TL;
        float* xr = (float*)(F.ws + WS_XC) + (size_t)(t - TL) * D;
        const bf16* xi16 = (const bf16*)(F.ws + WS_XS1) + (size_t)t * D; bf16* xo16 = (bf16*)F.out + (size_t)t * D;
        const Entry ta = TI[(size_t)2 * t], tbb = TI[(size_t)2 * t + 1]; const float w0 = ta.w, w1 = tbb.w;
        const size_t r0 = ((size_t)tb[ta.ts >> 16] * 256 + (ta.ts & 0xffff)) * D, r1 = ((size_t)tb[tbb.ts >> 16] * 256 + (tbb.ts & 0xffff)) * D;
        f32x4 va[2], vb[2]; u32x4 y0[2], y1[2]; float s = 0.f;
#pragma unroll
        for (int i = 0; i < 2; ++i) { const int c = 8 * F.lane + 512 * i;
            if (lat) unpk8(*(const u32x4*)(xi16 + c), va[i], vb[i]); else { va[i] = *(const f32x4*)(xr + c); vb[i] = *(const f32x4*)(xr + c + 4); }
            y0[i] = *(const u32x4*)(Y + r0 + c); y1[i] = *(const u32x4*)(Y + r1 + c); }
#pragma unroll
        for (int i = 0; i < 2; ++i) { const int c = 8 * F.lane + 512 * i; f32x4 a0, b0, a1, b1; unpk8(y0[i], a0, b0); unpk8(y1[i], a1, b1);
            const float* gp = modp(F, 0, r, 5) + c;
            va[i] = va[i] + *(const f32x4*)gp * (a0 * w0 + a1 * w1); vb[i] = vb[i] + *(const f32x4*)(gp + 4) * (b0 * w0 + b1 * w1);
            if (lat) *(u32x4*)(xo16 + c) = pk8(va[i], vb[i]); else { *(f32x4*)(xr + c) = va[i]; *(f32x4*)(xr + c + 4) = vb[i]; }
            s += (va[i].x * va[i].x + va[i].y * va[i].y) + (va[i].z * va[i].z + va[i].w * va[i].w) + (vb[i].x * vb[i].x + vb[i].y * vb[i].y) + (vb[i].z * vb[i].z + vb[i].w * vb[i].w); }
        const float rstd = rsqrtf(wave_sum(s) * (1.f / D) + EPS);
#pragma unroll
        for (int i = 0; i < 2; ++i) { const int c = 8 * F.lane + 512 * i; const float* nm = p.in[6] + D + c; const float* sc = modp(F, 1, r, 1) + c; const float* sh = modp(F, 1, r, 0) + c;
            const f32x4 oa = va[i] * rstd * (*(const f32x4*)nm * (*(const f32x4*)sc + 1.f)) + *(const f32x4*)sh, ob = vb[i] * rstd * (*(const f32x4*)(nm + 4) * (*(const f32x4*)(sc + 4) + 1.f)) + *(const f32x4*)(sh + 4);
            *(u32x4*)(HX + (size_t)t * D + c) = pk8(oa, ob); }
    }
}

DI bf16x8 lds_frag(LAS unsigned char* base, int byteoff) { return *(const LAS bf16x8*)(base + byteoff); }
DI void p8_c1a(const Frame& F, const KP& p) {
    bf16* PQ = (bf16*)(F.ws + WS_PQKV); const bf16* HALO = (const bf16*)(F.ws + WS_HALO); const float* AB = (const float*)(F.ws + WS_AB);
    float* LM = (float*)(F.ws + WS_LM); bf16* PM = (bf16*)(F.ws + WS_PM); float* GCB = (float*)(F.ws + WS_GCB);
    constexpr int RS = 272;
    LAS unsigned char* qs = F.lds; LAS unsigned char* ks = F.lds + 64 * RS;
    LAS float* KKs = (LAS float*)(F.lds + 53248);
    LAS float* QKs = (LAS float*)(F.lds + 53248 + 17408);
    LAS float* gcs = (LAS float*)(F.lds + 53248 + 2 * 17408);
    LAS float* bes = gcs + 128;
    const int fr = F.lane & 15, fq = F.lane >> 4;
    const int grp = F.tid >> 4, l16 = F.tid & 15, which = grp >> 3, ro = grp & 7;
    u32x4 raw[11]; float abA = 0.f, abB = 0.f;
#define C1_LOAD(unit_) do { const int cid_ = (unit_) >> 3, h_ = (unit_) & 7, tok0_ = cid_ * 64, col_ = which * 1024 + h_ * 128 + 8 * l16; \
        const bool first_ = cid_ < 512 ? ((cid_ & 127) == 0) : (((cid_ - 512) & 3) == 0), last_ = cid_ < 512 ? ((cid_ & 127) == 127) : (((cid_ - 512) & 3) == 3); \
        if (F.wave < 6) { _Pragma("unroll") for (int q = 0; q < 11; ++q) { const int rr = 8 * ro + q - 2; u32x4 v = {0u, 0u, 0u, 0u}; \
                if (rr < 0) { if (!first_) v = *(const u32x4*)(HALO + ((size_t)(cid_ - 1) * 3 + (rr + 3)) * 3072 + col_); } \
                else if (rr > 63) { if (!last_) v = *(const u32x4*)(HALO + ((size_t)(cid_ + 1) * 3 + 0) * 3072 + col_); } \
                else v = *(const u32x4*)(PQ + (size_t)(tok0_ + rr) * 3072 + col_); \
                raw[q] = v; } } \
        else { const int d_ = F.wave - 6, jj_ = d_ ? 63 - F.lane : F.lane; const float* ab_ = AB + (size_t)(tok0_ + jj_) * 32; abA = ab_[(2 * d_) * 8 + h_]; abB = ab_[(2 * d_ + 1) * 8 + h_]; } } while (0)
    if (F.bid < NCID * NH) C1_LOAD(F.bid);
    for (int unit = F.bid; unit < NCID * NH; unit += F.G) {
        const int cid = unit >> 3, h = unit & 7;
        const int tok0 = cid * 64;
        u32x4 res[8];
        const int col = which * 1024 + h * 128 + 8 * l16;
        if (F.wave < 6) {
            f32x4 w0[4], w1[4];
#pragma unroll
            for (int k = 0; k < 4; ++k) { w0[k] = *(const f32x4*)(p.in[12] + k * 3072 + col); w1[k] = *(const f32x4*)(p.in[12] + k * 3072 + col + 4); }
#pragma unroll
            for (int j = 0; j < 8; ++j) { float o[8];
#pragma unroll
                for (int e = 0; e < 8; ++e) o[e] = 0.f;
#pragma unroll
                for (int k = 0; k < 4; ++k) { const u32x4 rw = raw[j + k];
                    o[0] += bflo(rw.x) * w0[k].x; o[1] += bfhi(rw.x) * w0[k].y; o[2] += bflo(rw.y) * w0[k].z; o[3] += bfhi(rw.y) * w0[k].w;
                    o[4] += bflo(rw.z) * w1[k].x; o[5] += bfhi(rw.z) * w1[k].y; o[6] += bflo(rw.w) * w1[k].z; o[7] += bfhi(rw.w) * w1[k].w; }
                float ss = 0.f;
#pragma unroll
                for (int e = 0; e < 8; ++e) { o[e] = siluf(o[e]); ss += o[e] * o[e]; }
                ss += __shfl_xor(ss, 1); ss += __shfl_xor(ss, 2); ss += __shfl_xor(ss, 4); ss += __shfl_xor(ss, 8);
                float sc = 1.f;
                if (which == 0) sc = rsqrtf(ss + EPS) * 0.08838834764831845f; else if (which == 1) sc = rsqrtf(ss + EPS);
                u32x4 w; w.x = pk2(o[0] * sc, o[1] * sc); w.y = pk2(o[2] * sc, o[3] * sc); w.z = pk2(o[4] * sc, o[5] * sc); w.w = pk2(o[6] * sc, o[7] * sc);
                res[j] = w;
                if (which < 2) *(LAS u32x4*)((which == 0 ? qs : ks) + (8 * ro + j) * RS + l16 * 16) = w; }
        } else { const int d = F.wave - 6;
            const float a = abA, bb = abB;
            const float g = -__expf(p.in[13][d * 8 + h]) * softplusf_(a + p.in[14][d * 8 + h]); const float be = sigmoidf_(bb);
            float gc = g;
#pragma unroll
            for (int o = 1; o < 64; o <<= 1) { const float up = __shfl_up(gc, o); if (F.lane >= o) gc += up; }
            gcs[d * 64 + F.lane] = gc; bes[d * 64 + F.lane] = be;
            const float eg = __expf(gc), glast = __shfl(gc, 63);
            float* gp = GCB + ((size_t)unit * 2 + d) * 256; gp[F.lane] = be; gp[64 + F.lane] = be * eg; gp[128 + F.lane] = eg; gp[192 + F.lane] = __expf(glast - gc); }
        __syncthreads();
        if (unit + F.G < NCID * NH) C1_LOAD(unit + F.G);
        if (F.wave < 6) {
#pragma unroll
            for (int j = 0; j < 8; ++j) *(u32x4*)(PQ + (size_t)(tok0 + 8 * ro + j) * 3072 + col) = res[j]; }
#pragma unroll
        for (int tt = 0; tt < 2; ++tt) { const int ti = 2 * F.wave + tt, mt = ti >> 2, nt = ti & 3;
            f32x4 ak = {0.f, 0.f, 0.f, 0.f}, aq = {0.f, 0.f, 0.f, 0.f};
#pragma unroll
            for (int kk = 0; kk < 4; ++kk) { const int ko = (32 * kk + 8 * fq) * 2;
                const bf16x8 bfr = lds_frag(ks, (16 * nt + fr) * RS + ko), akf = lds_frag(ks, (16 * mt + fr) * RS + ko), aqf = lds_frag(qs, (16 * mt + fr) * RS + ko);
                ak = __builtin_amdgcn_mfma_f32_16x16x32_bf16(akf, bfr, ak, 0, 0, 0); aq = __builtin_amdgcn_mfma_f32_16x16x32_bf16(aqf, bfr, aq, 0, 0, 0); }
#pragma unroll
            for (int r = 0; r < 4; ++r) { KKs[(16 * mt + 4 * fq + r) * 68 + 16 * nt + fr] = ak[r]; QKs[(16 * mt + 4 * fq + r) * 68 + 16 * nt + fr] = aq[r]; } }
        __syncthreads();
#pragma unroll
        for (int itr = 0; itr < 2; ++itr) { const int idx = (F.tid + NTHR * itr) * 4, i1 = idx >> 6, i2b = idx & 63; f32x4 v;
#pragma unroll
            for (int e = 0; e < 4; ++e) { const int i2 = i2b + e; float x = 0.f;
                if (i2 < i1) x = bes[i1] * KKs[i1 * 68 + i2] * __expf(gcs[i1] - gcs[i2]);
                else if (i2 > i1) { const int j1 = 63 - i1, j2 = 63 - i2; x = bes[64 + j1] * KKs[i1 * 68 + i2] * __expf(gcs[64 + j1] - gcs[64 + j2]); }
                v[e] = x; }
            *(f32x4*)(LM + (size_t)unit * 4096 + idx) = v; }
#pragma unroll
        for (int itr = 0; itr < 2; ++itr) { const int idx = (F.tid + NTHR * itr) * 8, d = idx >> 12, j1 = (idx >> 6) & 63, jb = idx & 63;
            const int t1 = d ? 63 - j1 : j1; float x[8];
#pragma unroll
            for (int e = 0; e < 8; ++e) { const int j2 = jb + e; x[e] = 0.f;
                if (j2 <= j1) { const int t2 = d ? 63 - j2 : j2; x[e] = QKs[t1 * 68 + t2] * __expf(gcs[d * 64 + j1] - gcs[d * 64 + j2]); } }
            u32x4 w; w.x = pk2(x[0], x[1]); w.y = pk2(x[2], x[3]); w.z = pk2(x[4], x[5]); w.w = pk2(x[6], x[7]);
            *(u32x4*)(PM + ((size_t)unit * 2 + d) * 4096 + j1 * 64 + jb) = w; }
        __syncthreads();
    }
#undef C1_LOAD
}

DI void p9_c1b(const Frame& F) {
    const float* LM = (const float*)(F.ws + WS_LM); bf16* TM = (bf16*)(F.ws + WS_TM);
    LAS float* Ls = (LAS float*)(F.lds);
    for (int k0 = 0; F.bid + k0 * F.G < NCID * NH; k0 += 4) {
        {
            f32x4 lv[8];
#pragma unroll
            for (int itr = 0; itr < 8; ++itr) { const int uqs = itr >> 1, un = F.bid + (k0 + uqs) * F.G;
                lv[itr] = un < NCID * NH ? *(const f32x4*)(LM + (size_t)un * 4096 + (size_t)(F.tid + NTHR * (itr & 1)) * 4) : (f32x4){0.f, 0.f, 0.f, 0.f}; }
#pragma unroll
            for (int itr = 0; itr < 8; ++itr) { const int uq = itr >> 1, e0 = (F.tid + NTHR * (itr & 1)) * 4, i1 = e0 >> 6;
#pragma unroll
                for (int e = 0; e < 4; ++e) { const int i2 = (e0 & 63) + e; const float v = lv[itr][e];
                    if (i2 < i1) Ls[((uq * 2 + 0) * 64 + i1) * 64 + i2] = v; else if (i2 > i1) Ls[((uq * 2 + 1) * 64 + (63 - i1)) * 64 + (63 - i2)] = v; } }
        }
        __syncthreads();
        {
            const int uq = F.wave >> 1, d = F.wave & 1, c = F.lane;
            LAS float* L = Ls + (uq * 2 + d) * 4096;
            float Tc[64];
            Tc[0] = (c == 0) ? 1.f : 0.f;
#pragma unroll
            for (int i = 1; i < 64; ++i) {
                f32x4 lr[16];
#pragma unroll
                for (int q = 0; q < (i + 3) / 4; ++q) lr[q] = *(const LAS f32x4*)(L + i * 64 + 4 * q);
                float a0 = (c == i) ? 1.f : 0.f, a1 = 0.f, a2 = 0.f, a3 = 0.f;
#pragma unroll
                for (int q = 0; q < (i + 3) / 4; ++q) { const f32x4 l4 = lr[q]; const int j4 = 4 * q;
                    a0 -= l4.x * Tc[j4];
                    if (j4 + 1 < i) a1 -= l4.y * Tc[j4 + 1];
                    if (j4 + 2 < i) a2 -= l4.z * Tc[j4 + 2];
                    if (j4 + 3 < i) a3 -= l4.w * Tc[j4 + 3]; }
                Tc[i] = (a0 + a1) + (a2 + a3);
            }
            LAS unsigned short* Tl = (LAS unsigned short*)L;
#pragma unroll
            for (int i = 0; i < 64; ++i) Tl[i * 64 + c] = (unsigned short)f2bf(Tc[i]);
            asm volatile("s_waitcnt lgkmcnt(0)" ::: "memory");
            const int un = F.bid + (k0 + uq) * F.G;
            if (un < NCID * NH) { bf16* dst = TM + ((size_t)un * 2 + d) * 4096;
#pragma unroll
                for (int q = 0; q < 8; ++q) *(u32x4*)(dst + (size_t)(q * 64 + c) * 8) = *(const LAS u32x4*)(Tl + (q * 64 + c) * 8); }
        }
        __syncthreads();
    }
}

typedef short s16x4 __attribute__((ext_vector_type(4)));
constexpr int SB_K = 0, SB_Q = 16384, SB_T = 32768, SB_P = 40960, SB_V = 49152, SB_G = 53248, SB_SIZE = 54272;
constexpr int SW_SBT = 2 * SB_SIZE, SW_XT = SW_SBT + 8704, SW_VNT = SW_XT + 4608, SW_VDT = SW_VNT + 4608;
static_assert(SW_VDT + 4608 <= LDS_MISC, "scan LDS map");
DI unsigned offb(unsigned row, unsigned ch) { return 256u * row + 16u * (ch ^ (((row & 3u) << 2) | ((row >> 2) & 3u))); }
DI unsigned offt(unsigned row, unsigned ch) { return 128u * row + 16u * (ch ^ ((row >> 1) & 7u)); }
#define SC_GLDS(src, ldsoff) __builtin_amdgcn_global_load_lds((const unsigned*)(src), (LAS unsigned*)(F.lds + (ldsoff)), 16, 0, 0)
#define SC_LBAR() do { asm volatile("s_waitcnt lgkmcnt(0)" ::: "memory"); __builtin_amdgcn_s_barrier(); asm volatile("" ::: "memory"); } while (0)
DI void scan_chunk(int s, int b, int d, int& cid, int& outp) {
    if (s < 4) { const int cc = d ? 3 - s : s; cid = 512 + b * 4 + cc; outp = 0; } else { const int c2 = s - 4, cc = d ? 127 - c2 : c2; cid = b * 128 + cc; outp = 1; }
}
DI void scan_issue(const Frame& F, int buf, int s, int b, int h, int d, int v0) {
    const unsigned char* PQ = F.ws + WS_PQKV; const float* GCB = (const float*)(F.ws + WS_GCB);
    int cid, outp; scan_chunk(s, b, d, cid, outp);
    const int tok0 = cid * 64, w = F.wave, L = F.lane, bo = buf * SB_SIZE;
    const size_t mb = ((size_t)(cid * 8 + h) * 2 + d);
    const unsigned char* TMb = F.ws + WS_TM + mb * 8192; const unsigned char* PMb = F.ws + WS_PM + mb * 8192;
#pragma unroll
    for (int ii = 0; ii < 2; ++ii) { const int i = 2 * w + ii, row = 4 * i + (L >> 4), slot = L & 15, ch = slot ^ (((row & 3) << 2) | ((row >> 2) & 3)), tok = tok0 + (d ? 63 - row : row);
        const unsigned off = (unsigned)tok * 6144u + (unsigned)(h * 256 + ch * 16);
        SC_GLDS(PQ + 2048 + off, bo + SB_K + i * 1024); if (outp) SC_GLDS(PQ + off, bo + SB_Q + i * 1024); }
    { const int row = 8 * w + (L >> 3), slot = L & 7, ch = slot ^ ((row >> 1) & 7); const unsigned off = (unsigned)(row * 128 + ch * 16);
        SC_GLDS(TMb + off, bo + SB_T + w * 1024); if (outp) SC_GLDS(PMb + off, bo + SB_P + w * 1024); }
    if (w < 4) { const int row = 16 * w + (L >> 2), c = L & 3, tok = tok0 + (d ? 63 - row : row);
        SC_GLDS(PQ + 4096 + ((unsigned)tok * 6144u + (unsigned)(h * 256 + v0 * 2 + 16 * c)), bo + SB_V + w * 1024); }
    else if (w == 4) SC_GLDS(GCB + mb * 256 + L * 4, bo + SB_G);
}
DI void scan_step(const Frame& F, int buf, int s, int b, int h, int d, int v0, f32x4 (&Sacc)[2], int mt, int nt, int fr, int fq) {
    LAS unsigned char* L = F.lds; LAS unsigned char* B = F.lds + buf * SB_SIZE;
    bf16* OD = (bf16*)(F.ws + WS_O) + (size_t)d * TL * D;
    int cid, outp; scan_chunk(s, b, d, cid, outp);
    const int tok0 = cid * 64;
    f32x4 aX = {0.f, 0.f, 0.f, 0.f}, aO = {0.f, 0.f, 0.f, 0.f};
#pragma unroll
    for (int ks = 0; ks < 4; ++ks) { const bf16x8 sb = *(const LAS bf16x8*)(L + SW_SBT + (16 * nt + fr) * 272 + (32 * ks + 8 * fq) * 2);
        const bf16x8 kA = *(const LAS bf16x8*)(B + SB_K + offb(16 * mt + fr, 4 * ks + fq));
        aX = __builtin_amdgcn_mfma_f32_16x16x32_bf16(kA, sb, aX, 0, 0, 0);
        if (outp) { const bf16x8 qA = *(const LAS bf16x8*)(B + SB_Q + offb(16 * mt + fr, 4 * ks + fq)); aO = __builtin_amdgcn_mfma_f32_16x16x32_bf16(qA, sb, aO, 0, 0, 0); } }
    const LAS unsigned char* Gr = B + SB_G + (16 * mt + 4 * fq) * 4;
    const f32x4 be = *(const LAS f32x4*)Gr, s1 = *(const LAS f32x4*)(Gr + 256), eg = *(const LAS f32x4*)(Gr + 512), dr = *(const LAS f32x4*)(Gr + 768);
    float x[4];
#pragma unroll
    for (int r = 0; r < 4; ++r) { const float vv = bf2f(*(const LAS unsigned short*)(B + SB_V + (16 * mt + 4 * fq + r) * 64 + (16 * nt + fr) * 2));
        x[r] = vv * be[r] - s1[r] * aX[r]; aO[r] *= eg[r]; }
    { u32x2 w; w.x = pk2(x[0], x[1]); w.y = pk2(x[2], x[3]); *(LAS u32x2*)(L + SW_XT + (16 * nt + fr) * 144 + (16 * mt + 4 * fq) * 2) = w; }
    SC_LBAR();
    f32x4 aV = {0.f, 0.f, 0.f, 0.f};
#pragma unroll
    for (int ks = 0; ks < 2; ++ks) { const bf16x8 xb = *(const LAS bf16x8*)(L + SW_XT + (16 * nt + fr) * 144 + (32 * ks + 8 * fq) * 2);
        const bf16x8 tA = *(const LAS bf16x8*)(B + SB_T + offt(16 * mt + fr, 4 * ks + fq));
        aV = __builtin_amdgcn_mfma_f32_16x16x32_bf16(tA, xb, aV, 0, 0, 0); }
    { u32x2 w; w.x = pk2(aV[0], aV[1]); w.y = pk2(aV[2], aV[3]); *(LAS u32x2*)(L + SW_VNT + (16 * nt + fr) * 144 + (16 * mt + 4 * fq) * 2) = w;
      w.x = pk2(aV[0] * dr[0], aV[1] * dr[1]); w.y = pk2(aV[2] * dr[2], aV[3] * dr[3]); *(LAS u32x2*)(L + SW_VDT + (16 * nt + fr) * 144 + (16 * mt + 4 * fq) * 2) = w; }
    SC_LBAR();
    const float decay = *(const LAS float*)(B + SB_G + 512 + 63 * 4);
    const int w8 = 2 * mt + nt;
    bf16x8 kt[2];
    { const unsigned q4 = (unsigned)fr >> 2, p4 = (unsigned)fr & 3u, kb = (unsigned)(size_t)(B + SB_K) + 8u * (p4 & 1u);
      const unsigned a00 = kb + offb(8 * fq + 0 + q4, 2 * w8 + (p4 >> 1)), a01 = kb + offb(8 * fq + 4 + q4, 2 * w8 + (p4 >> 1));
      const unsigned a10 = kb + offb(32 + 8 * fq + 0 + q4, 2 * w8 + (p4 >> 1)), a11 = kb + offb(32 + 8 * fq + 4 + q4, 2 * w8 + (p4 >> 1));
      s16x4 t00, t01, t10, t11;
      asm volatile("ds_read_b64_tr_b16 %0, %4\n\tds_read_b64_tr_b16 %1, %5\n\tds_read_b64_tr_b16 %2, %6\n\tds_read_b64_tr_b16 %3, %7\n\ts_waitcnt lgkmcnt(0)"
                   : "=&v"(t00), "=&v"(t01), "=&v"(t10), "=&v"(t11) : "v"(a00), "v"(a01), "v"(a10), "v"(a11) : "memory");
      kt[0] = (bf16x8){t00[0], t00[1], t00[2], t00[3], t01[0], t01[1], t01[2], t01[3]};
      kt[1] = (bf16x8){t10[0], t10[1], t10[2], t10[3], t11[0], t11[1], t11[2], t11[3]}; }
#pragma unroll
    for (int n = 0; n < 2; ++n) { Sacc[n] = Sacc[n] * decay;
#pragma unroll
        for (int ks = 0; ks < 2; ++ks) { const bf16x8 vd = *(const LAS bf16x8*)(L + SW_VDT + (16 * n + fr) * 144 + (32 * ks + 8 * fq) * 2);
            Sacc[n] = __builtin_amdgcn_mfma_f32_16x16x32_bf16(kt[ks], vd, Sacc[n], 0, 0, 0); } }
    if (outp) {
#pragma unroll
        for (int ks = 0; ks < 2; ++ks) { const bf16x8 vn = *(const LAS bf16x8*)(L + SW_VNT + (16 * nt + fr) * 144 + (32 * ks + 8 * fq) * 2);
            const bf16x8 pA = *(const LAS bf16x8*)(B + SB_P + offt(16 * mt + fr, 4 * ks + fq));
            aO = __builtin_amdgcn_mfma_f32_16x16x32_bf16(pA, vn, aO, 0, 0, 0); }
    }
#pragma unroll
    for (int n = 0; n < 2; ++n) { u32x2 w; w.x = pk2(Sacc[n][0], Sacc[n][1]); w.y = pk2(Sacc[n][2], Sacc[n][3]);
        *(LAS u32x2*)(L + SW_SBT + (16 * n + fr) * 272 + (16 * w8 + 4 * fq) * 2) = w; }
    if (outp) {
#pragma unroll
        for (int r = 0; r < 4; ++r) { const int jc = 16 * mt + 4 * fq + r, tc = tok0 + (d ? 63 - jc : jc);
            OD[(size_t)tc * D + h * 128 + v0 + 16 * nt + fr] = (bf16)f2bf(aO[r]); }
        asm volatile("s_waitcnt vmcnt(4)" ::: "memory");
    } else asm volatile("s_waitcnt vmcnt(0)" ::: "memory");
    SC_LBAR();
}
DI void p10_scan(const Frame& F) {
    const int mt = F.wave >> 1, nt = F.wave & 1, fr = F.lane & 15, fq = F.lane >> 4;
    for (int u0 = F.bid; u0 < 256; u0 += F.G) {
        const int xcd = u0 & 7, qq = u0 >> 3, sl = qq & 3, chain = xcd + 8 * (qq >> 2);
        const int d = chain & 1, h = (chain >> 1) & 7, b = chain >> 4, v0 = sl * 32;
        for (int i = F.tid; i < 8704 / 4; i += NTHR) ((LAS unsigned*)(F.lds + SW_SBT))[i] = 0u;
        f32x4 Sacc[2] = {{0.f, 0.f, 0.f, 0.f}, {0.f, 0.f, 0.f, 0.f}};
        scan_issue(F, 0, 0, b, h, d, v0);
        asm volatile("s_waitcnt vmcnt(0)" ::: "memory");
        SC_LBAR();
        for (int s = 0; s < 132; ++s) {
            if (s + 1 < 132) scan_issue(F, (s + 1) & 1, s + 1, b, h, d, v0);
            scan_step(F, s & 1, s, b, h, d, v0, Sacc, mt, nt, fr, fq);
        }
    }
}

DI void p11_onorm(const Frame& F, const KP& p) {
    const int gw = F.bid * NWAVES + F.wave, NGW = F.G * NWAVES;
    const bf16* O0 = (const bf16*)(F.ws + WS_O); const bf16* O1 = O0 + (size_t)TL * D; const bf16* Z = (const bf16*)(F.ws + WS_Z); bf16* HX = (bf16*)(F.ws + WS_HX);
    for (int t = gw; t < TL; t += NGW) {
        const int c = 16 * F.lane;
        float o[16], zz[16]; float ss = 0.f;
#pragma unroll
        for (int q = 0; q < 2; ++q) { const u32x4 a = *(const u32x4*)(O0 + (size_t)t * D + c + 8 * q), bq = *(const u32x4*)(O1 + (size_t)t * D + c + 8 * q), zq = *(const u32x4*)(Z + (size_t)t * D + c + 8 * q);
            o[8 * q + 0] = bflo(a.x) + bflo(bq.x); o[8 * q + 1] = bfhi(a.x) + bfhi(bq.x); o[8 * q + 2] = bflo(a.y) + bflo(bq.y); o[8 * q + 3] = bfhi(a.y) + bfhi(bq.y);
            o[8 * q + 4] = bflo(a.z) + bflo(bq.z); o[8 * q + 5] = bfhi(a.z) + bfhi(bq.z); o[8 * q + 6] = bflo(a.w) + bflo(bq.w); o[8 * q + 7] = bfhi(a.w) + bfhi(bq.w);
            zz[8 * q + 0] = bflo(zq.x); zz[8 * q + 1] = bfhi(zq.x); zz[8 * q + 2] = bflo(zq.y); zz[8 * q + 3] = bfhi(zq.y); zz[8 * q + 4] = bflo(zq.z); zz[8 * q + 5] = bfhi(zq.z); zz[8 * q + 6] = bflo(zq.w); zz[8 * q + 7] = bfhi(zq.w); }
#pragma unroll
        for (int e = 0; e < 16; ++e) ss += o[e] * o[e];
        ss += __shfl_xor(ss, 1); ss += __shfl_xor(ss, 2); ss += __shfl_xor(ss, 4);
        const float rs = rsqrtf(ss * (1.f / 128.f) + EPS);
        const float* nw = p.in[15] + (c & 127);
        unsigned w[8];
#pragma unroll
        for (int e = 0; e < 8; ++e) w[e] = pk2(o[2 * e] * rs * nw[2 * e] * siluf(zz[2 * e]), o[2 * e + 1] * rs * nw[2 * e + 1] * siluf(zz[2 * e + 1]));
        *(u32x4*)(HX + (size_t)t * D + c) = (u32x4){w[0], w[1], w[2], w[3]}; *(u32x4*)(HX + (size_t)t * D + c + 8) = (u32x4){w[4], w[5], w[6], w[7]};
    }
}

DI void p16_final(const Frame& F, const KP& p, const LAS int* tb) {
    const int gw = F.bid * NWAVES + F.wave, NGW = F.G * NWAVES;
    const bf16* Y = (const bf16*)(F.ws + WS_Y); const Entry* TI = (const Entry*)(F.ws + WS_TI);
    for (int t = gw; t < TL; t += NGW) {
        const int r = t >> 13; float* xr = F.out + (size_t)t * D; const bf16* xi16 = (const bf16*)(F.ws + WS_XS3) + (size_t)t * D;
        const Entry ta = TI[(size_t)2 * t], tbb = TI[(size_t)2 * t + 1]; const float w0 = ta.w, w1 = tbb.w;
        const size_t r0 = ((size_t)tb[ta.ts >> 16] * 256 + (ta.ts & 0xffff)) * D, r1 = ((size_t)tb[tbb.ts >> 16] * 256 + (tbb.ts & 0xffff)) * D;
        f32x4 va[2], vb[2]; u32x4 y0[2], y1[2]; float s = 0.f;
#pragma unroll
        for (int i = 0; i < 2; ++i) { const int c = 8 * F.lane + 512 * i; unpk8(*(const u32x4*)(xi16 + c), va[i], vb[i]); y0[i] = *(const u32x4*)(Y + r0 + c); y1[i] = *(const u32x4*)(Y + r1 + c); }
#pragma unroll
        for (int i = 0; i < 2; ++i) { const int c = 8 * F.lane + 512 * i; f32x4 a0, b0, a1, b1; unpk8(y0[i], a0, b0); unpk8(y1[i], a1, b1);
            const float* gp = modp(F, 1, r, 5) + c;
            va[i] = va[i] + *(const f32x4*)gp * (a0 * w0 + a1 * w1); vb[i] = vb[i] + *(const f32x4*)(gp + 4) * (b0 * w0 + b1 * w1);
            s += (va[i].x * va[i].x + va[i].y * va[i].y) + (va[i].z * va[i].z + va[i].w * va[i].w) + (vb[i].x * vb[i].x + vb[i].y * vb[i].y) + (vb[i].z * vb[i].z + vb[i].w * vb[i].w); }
        const float rstd = rsqrtf(wave_sum(s) * (1.f / D) + EPS);
#pragma unroll
        for (int i = 0; i < 2; ++i) { const int c = 8 * F.lane + 512 * i; *(f32x4*)(xr + c) = va[i] * rstd * *(const f32x4*)(p.in[24] + c); *(f32x4*)(xr + c + 4) = vb[i] * rstd * *(const f32x4*)(p.in[24] + c + 4); }
    }
}

__global__ void __launch_bounds__(NTHR, 2) fwd_kernel(KP kp) {
    extern __shared__ __attribute__((aligned(16))) unsigned char lds_raw[];
    Frame F;
    F.lds = (LAS unsigned char*)lds_raw; F.tid = threadIdx.x; F.lane = F.tid & 63; F.wave = __builtin_amdgcn_readfirstlane(F.tid >> 6);
    F.bid = blockIdx.x; F.G = gridDim.x; F.ws = kp.ws; F.out = kp.out;
    volatile LAS unsigned* misc = (volatile LAS unsigned*)(F.lds + LDS_MISC);
    if (F.tid < 4) misc[F.tid] = 0u;
    __syncthreads();
    const int lo = kp.ph_lo, hi = kp.ph_hi;
    XcdBarrier bar; bar.bar = (unsigned*)(F.ws + WS_CTL) + CW_BAR; bar.x = 0; bar.st = misc;
    if (hi - lo > 1) bar = xcd_barrier_post((unsigned*)(F.ws + WS_CTL) + CW_BAR, misc);
#ifndef PHSEL
#define PHSEL 0x1FFFF
#endif
#define IN(k) (((PHSEL >> (k)) & 1) && lo <= (k) && (k) < hi)
#define SEAM(k) do { if (IN(k) && IN((k) + 1)) xcd_barrier(bar); } while (0)
    LAS int* tb = (LAS int*)(F.lds + LDS_MISC + 64); LAS int* cn = (LAS int*)(F.lds + LDS_MISC + 64 + 256);
    const float* MOD = (const float*)(F.ws + WS_MOD);

    if (IN(0)) { p0_prologue(F, kp); } SEAM(0);
    if (IN(1)) { p1_pool_diff(F, kp); __syncthreads(); convert_experts(F, kp, 0); } SEAM(1);
    if (IN(2)) { pg8::Gemm g{(const bf16*)(F.ws + WS_DD), (const bf16*)(F.ws + WS_BTP), 256}; PoolOrder S{F.G, F.bid};
        EpiRaw E{(bf16*)(F.ws + WS_YP), 1};
        pg8::gemm_phase<EpiRaw, PoolOrder, false>(F.lds, g, S, E); } SEAM(2);
    if (IN(3)) { p_router(F, kp, 0, T); } SEAM(3);
    if (IN(4)) { moe_tables(F, 0, tb, cn);
        pg8::Gemm g{(const bf16*)(F.ws + WS_HX), (const bf16*)(F.ws + WS_GU), 1024}; MoeOrder S{F.G, F.bid, tb[NE], tb, cn, (const Entry*)(F.ws + WS_ENT)};
        EpiGU E{(bf16*)(F.ws + WS_HID)};
        pg8::gemm_phase<EpiGU, MoeOrder, true>(F.lds, g, S, E); } SEAM(4);
    if (IN(5)) { moe_tables(F, 0, tb, cn);
        pg8::Gemm g{(const bf16*)(F.ws + WS_HID), (const bf16*)(F.ws + WS_DN), 512}; MoeOrder S{F.G, F.bid, tb[NE], tb, cn, (const Entry*)(F.ws + WS_ENT)};
        EpiDown E{(bf16*)(F.ws + WS_Y)};
        pg8::gemm_phase<EpiDown, MoeOrder, false>(F.lds, g, S, E); } SEAM(5);
    if (IN(6)) { moe_tables(F, 0, tb, cn); p6_n1(F, kp, tb); } SEAM(6);
    if (IN(7)) { pg8::Gemm g{(const bf16*)(F.ws + WS_HX), (const bf16*)(F.ws + WS_BTIN), 1024}; G1Order S{F.G, F.bid};
        EpiG1 E{(bf16*)(F.ws + WS_PQKV), (bf16*)(F.ws + WS_Z), (bf16*)(F.ws + WS_HALO), (float*)(F.ws + WS_AB)};
        pg8::gemm_phase<EpiG1, G1Order, false>(F.lds, g, S, E); } SEAM(7);
    if (IN(8)) { p8_c1a(F, kp); asm volatile("s_waitcnt vmcnt(0)" ::: "memory"); __syncthreads(); }
#ifdef PROBE_K
    SEAM(8);
#endif
    if (IN(9)) { p9_c1b(F); } SEAM(9);
    if (IN(10)) { p10_scan(F); } SEAM(10);
    if (IN(11)) { p11_onorm(F, kp); convert_experts(F, kp, 1); } SEAM(11);
    if (IN(12)) { pg8::Gemm g{(const bf16*)(F.ws + WS_HX), (const bf16*)(F.ws + WS_BTOUT), 1024}; G2Order S{F.G, F.bid};
        EpiRaw E{(bf16*)(F.ws + WS_Y2), 0};
        pg8::gemm_phase<EpiRaw, G2Order, false>(F.lds, g, S, E); } SEAM(12);
    if (IN(13)) { p_router(F, kp, 1, TL); } SEAM(13);
    if (IN(14)) { moe_tables(F, 1, tb, cn);
        pg8::Gemm g{(const bf16*)(F.ws + WS_HX), (const bf16*)(F.ws + WS_GU), 1024}; MoeOrder S{F.G, F.bid, tb[NE], tb, cn, (const Entry*)(F.ws + WS_ENT)};
        EpiGU E{(bf16*)(F.ws + WS_HID)};
        pg8::gemm_phase<EpiGU, MoeOrder, true>(F.lds, g, S, E); } SEAM(14);
    if (IN(15)) { moe_tables(F, 1, tb, cn);
        pg8::Gemm g{(const bf16*)(F.ws + WS_HID), (const bf16*)(F.ws + WS_DN), 512}; MoeOrder S{F.G, F.bid, tb[NE], tb, cn, (const Entry*)(F.ws + WS_ENT)};
        EpiDown E{(bf16*)(F.ws + WS_Y)};
        pg8::gemm_phase<EpiDown, MoeOrder, false>(F.lds, g, S, E); } SEAM(15);
    if (IN(16)) { moe_tables(F, 1, tb, cn); p16_final(F, kp, tb); }
#undef IN
#undef SEAM
}

extern "C" void kernel_launch(void* const* d_in, const int* in_sizes, int n_in, void* d_out, int out_size, void* d_ws, size_t ws_size, hipStream_t stream) {
    static int grid = 0;
    if (grid == 0) {
        if (n_in != 25 || out_size != TL * D || ws_size < WS_END) { fprintf(stderr, "kernel_launch: unexpected shapes (n_in %d, out %d, ws %zu < %zu)\n", n_in, out_size, ws_size, (size_t)WS_END); grid = -1; return; }
        int dev = 0, cus = 0, per_cu = 0;
        if (hipGetDevice(&dev) != hipSuccess || hipDeviceGetAttribute(&cus, hipDeviceAttributeMultiprocessorCount, dev) != hipSuccess) { grid = -1; return; }
        if (hipFuncSetAttribute((const void*)fwd_kernel, hipFuncAttributeMaxDynamicSharedMemorySize, LDS_BYTES) != hipSuccess) { fprintf(stderr, "kernel_launch: hipFuncSetAttribute failed\n"); grid = -1; return; }
        if (hipOccupancyMaxActiveBlocksPerMultiprocessor(&per_cu, (const void*)fwd_kernel, NTHR, LDS_BYTES) != hipSuccess || per_cu < 1) fprintf(stderr, "kernel_launch: occupancy query says %d\n", per_cu);
        (void)hipGetLastError();
        grid = cus;
    }
    if (grid < 0) return;
    (void)hipMemsetAsync((char*)d_ws + WS_CTL, 0, CTL_BYTES, stream);
    KP kp{};
    for (int i = 0; i < 25; ++i) kp.in[i] = (const float*)d_in[i];
    kp.out = (float*)d_out; kp.ws = (unsigned char*)d_ws;
#if MK_ONE_LAUNCH
    kp.ph_lo = 0; kp.ph_hi = PH_N;
    hipLaunchKernelGGL(fwd_kernel, dim3(grid), dim3(NTHR), LDS_BYTES, stream, kp);
#else
    for (int ph = 0; ph < PH_N; ++ph) { kp.ph_lo = ph; kp.ph_hi = ph + 1; hipLaunchKernelGGL(fwd_kernel, dim3(grid), dim3(NTHR), LDS_BYTES, stream, kp); }
#endif
}
```

```cpp
#include <hip/hip_runtime.h>
#include <cstdio>
#include <cstdint>

#ifndef MK_ONE_LAUNCH
#define MK_ONE_LAUNCH 1
#endif

#define GAS __attribute__((address_space(1)))
#define LAS __attribute__((address_space(3)))
typedef unsigned short bf16;
typedef short bf16x8 __attribute__((ext_vector_type(8)));
typedef short bf16x4 __attribute__((ext_vector_type(4)));
typedef float f32x4 __attribute__((ext_vector_type(4)));
typedef float f32x2 __attribute__((ext_vector_type(2)));
typedef unsigned u32x4 __attribute__((ext_vector_type(4)));
typedef unsigned u32x2 __attribute__((ext_vector_type(2)));
#define DI __device__ __forceinline__

constexpr int D = 1024, NB = 4, SEQ = 8192, CTXL = 256;
constexpr int TL = NB * SEQ;
constexpr int TC = NB * CTXL;
constexpr int T = TL + TC;
constexpr int NE = 32, DE = 512, NH = 8;
constexpr int NCID = 528;
constexpr int DN_IN = 4128;
constexpr float EPS = 1e-6f;
constexpr int CAP = T;
constexpr int NWAVES = 8, NTHR = 512;

constexpr size_t MiB = 1u << 20;
constexpr size_t WS_CTL = 0, CTL_BYTES = 1 * MiB;
constexpr size_t WS_BTP = 1 * MiB;
constexpr size_t WS_BTOUT = 1 * MiB + 512 * 1024;
constexpr size_t WS_BTIN = 3 * MiB + 512 * 1024;
constexpr size_t WS_MOD = 12 * MiB;
constexpr size_t WS_WRT = 12 * MiB + 256 * 1024;
constexpr size_t WS_WAB = 12 * MiB + 576 * 1024;
constexpr size_t WS_RSTD = 12 * MiB + 704 * 1024;
constexpr size_t WS_WR2 = 13 * MiB;
constexpr size_t WS_C0 = 13 * MiB + 512 * 1024;
constexpr size_t WS_XC = 14 * MiB;
constexpr size_t WS_TI = 18 * MiB;
constexpr size_t WS_GU = 20 * MiB;
constexpr size_t WS_DN = 84 * MiB;
constexpr size_t WS_TM = 20 * MiB;
constexpr size_t WS_AB = 86 * MiB;
constexpr size_t WS_HALO = 91 * MiB;
constexpr size_t WS_GCB = 101 * MiB;
constexpr size_t WS_HX = 116 * MiB;
constexpr size_t WS_PM = 116 * MiB;
constexpr size_t WS_XS1 = 182 * MiB;
constexpr size_t WS_XS3 = 472 * MiB;
constexpr size_t WS_DD = 182 * MiB;
constexpr size_t WS_YP = 248 * MiB;
constexpr size_t WS_Y2 = 380 * MiB;
constexpr size_t WS_HID = 248 * MiB;
constexpr size_t WS_Y = 322 * MiB;
constexpr size_t WS_PQKV = 182 * MiB;
constexpr size_t WS_Z = 380 * MiB;
constexpr size_t WS_LM = 444 * MiB;
constexpr size_t WS_O = 444 * MiB;
constexpr size_t WS_ENT = 572 * MiB;
constexpr size_t WS_END = 572 * MiB + (size_t)NE * CAP * 8;
static_assert(WS_END <= 581 * MiB, "ws map");
constexpr int CW_BAR = 4096;
constexpr int CW_CNT = 16384, CNT_STRIDE = 1024;
constexpr int LDS_BYTES = 147456;
constexpr int LDS_MISC = 139264;
constexpr int PH_N = 17;

struct Entry { int ts; float w; };
struct KP { const float* in[25]; float* out; unsigned char* ws; int ph_lo, ph_hi; };

typedef __bf16 hwbf2 __attribute__((ext_vector_type(2)));
DI unsigned f2bf(float f) { const __bf16 h = (__bf16)f; return (unsigned)__builtin_bit_cast(unsigned short, h); }
DI unsigned pk2(float lo, float hi) { const f32x2 v = {lo, hi}; const hwbf2 r = __builtin_convertvector(v, hwbf2); return __builtin_bit_cast(unsigned, r); }
DI float bflo(unsigned w) { return __builtin_bit_cast(float, w << 16); }
DI float bfhi(unsigned w) { return __builtin_bit_cast(float, w & 0xffff0000u); }
DI float bf2f(unsigned short b) { return __builtin_bit_cast(float, ((unsigned)b) << 16); }
DI void unpk8(const u32x4 q, f32x4& a, f32x4& b) { a = (f32x4){bflo(q.x), bfhi(q.x), bflo(q.y), bfhi(q.y)}; b = (f32x4){bflo(q.z), bfhi(q.z), bflo(q.w), bfhi(q.w)}; }
DI u32x4 pk8(const f32x4 a, const f32x4 b) { u32x4 q; q.x = pk2(a.x, a.y); q.y = pk2(a.z, a.w); q.z = pk2(b.x, b.y); q.w = pk2(b.z, b.w); return q; }
DI float wave_sum(float v) {
#pragma unroll
    for (int o = 1; o < 64; o <<= 1) v += __shfl_xor(v, o);
    return v;
}
DI float siluf(float x) { return x / (1.f + __expf(-x)); }
DI float sigmoidf_(float x) { return 1.f / (1.f + __expf(-x)); }
DI float softplusf_(float x) { return fmaxf(x, 0.f) + log1pf(__expf(-fabsf(x))); }

#define XB_TMO      128
#define XB_XCNT(j)  (256  + 64 * (j))
#define XB_XSUB(j)  (1280 + 64 * (j))
#define XB_XGEN(j)  (2304 + 64 * (j))
#define XB_TOP      3328
#define XB_TOPGEN   3392
#define XCD_BAR_WORDS 3456
#define XB_SPIN_CAP (1u << 18)
__device__ __forceinline__ unsigned xb_ld(unsigned* p)              { return __hip_atomic_load(p, __ATOMIC_RELAXED, __HIP_MEMORY_SCOPE_AGENT); }
__device__ __forceinline__ unsigned xb_add(unsigned* p, unsigned v) { return __hip_atomic_fetch_add(p, v, __ATOMIC_RELAXED, __HIP_MEMORY_SCOPE_AGENT); }
__device__ __forceinline__ unsigned xb_xcc_id() { return (unsigned)__builtin_amdgcn_s_getreg((3 << 11) | 20) & 0xFu; }
#define XB_SPIN(cond, bar) do { unsigned _sp = 0; while (cond) { __builtin_amdgcn_s_sleep(1); \
    if ((++_sp & 255u) == 0u) { if (xb_ld(&(bar)[XB_TMO])) break; if (_sp > XB_SPIN_CAP) { atomicAdd(&(bar)[XB_TMO], 1u); break; } } } } while (0)
struct XcdBarrier { unsigned* bar; unsigned x; volatile LAS unsigned* st; };
__device__ __forceinline__ XcdBarrier xcd_barrier_post(unsigned* bar, volatile LAS unsigned* st) {
    XcdBarrier b; b.bar = bar; b.x = xb_xcc_id(); b.st = st;
    if (threadIdx.x == 0) (void)xb_add(&bar[XB_XCNT(b.x)], 1u);
    return b;
}
__device__ __forceinline__ void xcd_barrier_complete(unsigned* bar, unsigned x, unsigned& nloc, unsigned& nx) {
    const unsigned G = gridDim.x * gridDim.y * gridDim.z;
    unsigned sum, cnt, mine, sp = 0u;
    for (;;) {
        sum = 0u; cnt = 0u; mine = 0u;
#pragma unroll
        for (unsigned j = 0; j < 16; ++j) { const unsigned c = xb_ld(&bar[XB_XCNT(j)]); sum += c; cnt += (c > 0u) ? 1u : 0u; mine = (j == x) ? c : mine; }
        if (sum == G) break;
        __builtin_amdgcn_s_sleep(1);
        if ((++sp & 255u) == 0u) { if (xb_ld(&bar[XB_TMO])) break; if (sp > XB_SPIN_CAP) { atomicAdd(&bar[XB_TMO], 1u); break; } }
    }
    nloc = mine > 0u ? mine : 1u; nx = cnt > 0u ? cnt : 1u;
}
__device__ __forceinline__ void xcd_barrier(const XcdBarrier& b) {
    asm volatile("s_waitcnt vmcnt(0)" ::: "memory");
    __syncthreads();
    if (threadIdx.x == 0) {
        unsigned* bar = b.bar;
        __builtin_amdgcn_s_waitcnt(0);
        unsigned nloc = b.st[0], nx = b.st[1];
        if (nloc == 0u) { xcd_barrier_complete(bar, b.x, nloc, nx); b.st[0] = nloc; b.st[1] = nx; }
        const unsigned old = xb_add(&bar[XB_XSUB(b.x)], 1u);
        const unsigned gen = old / nloc;
        if (old + 1u == (gen + 1u) * nloc) {
            __builtin_amdgcn_fence(__ATOMIC_RELEASE, "agent");
            asm volatile("s_waitcnt vmcnt(0)" ::: "memory");
            const unsigned og = xb_add(&bar[XB_TOP], 1u);
            const unsigned tg = og / nx;
            if (og + 1u == (tg + 1u) * nx) xb_add(&bar[XB_TOPGEN], 1u);
            else XB_SPIN(xb_ld(&bar[XB_TOPGEN]) == tg, bar);
            __builtin_amdgcn_fence(__ATOMIC_ACQUIRE, "agent");
            xb_add(&bar[XB_XGEN(b.x)], 1u);
            asm volatile("s_waitcnt vmcnt(0)" ::: "memory");
        } else {
            XB_SPIN(xb_ld(&bar[XB_XGEN(b.x)]) == gen, bar);
            __builtin_amdgcn_fence(__ATOMIC_ACQUIRE, "agent");
            asm volatile("s_waitcnt vmcnt(0)" ::: "memory");
        }
    }
    __syncthreads();
}

namespace pg8 {
constexpr int BM = 256, BK = 64, HALF = 128, HTB = HALF * BK * 2, STAGE_BYTES = 8 * HTB;
DI int lds_byte(int r, int c) { const int st = (r >> 4) * 2 + (c >> 5), rr = r & 15, cc = c & 31, ob = rr * 64 + cc * 2; return st * 1024 + (ob ^ (((ob >> 9) & 1) << 5)); }
DI void stage_rc(int b, int& R, int& C) { const int st = b / 1024, sb = b % 1024, swz = sb ^ (((sb >> 9) & 1) << 5); R = (st >> 1) * 16 + swz / 64; C = (st & 1) * 32 + (swz % 64) / 2; }
DI int perm32(int rho) { const int n = rho >> 4, i = rho & 15; return 8 * (i >> 2) + 4 * n + (i & 3); }
struct Unit { int pm, pn, e, rt, nvalid; };
struct Gemm { const bf16* A; const bf16* Bt; int K; };

template <class Epi, class Sched, bool GATHER>
DI void gemm_phase(LAS unsigned char* lds, const Gemm g, const Sched& S, const Epi& E) {
    const int tid = threadIdx.x, wid = __builtin_amdgcn_readfirstlane(tid >> 6), lane = tid & 63, wr = wid >> 2, wc = wid & 3, fr = lane & 15, fq = lane >> 4;
    const int K = g.K, nt = K / BK;
    unsigned voffA[2], voffB[2]; int Rr[2], Cc[2];
#pragma unroll
    for (int i = 0; i < 2; ++i) { int R, C; stage_rc(tid * 16 + i * 8192, R, C); const int Rb = Epi::PERM ? ((R & ~31) + perm32(R & 31)) : R;
        voffA[i] = (unsigned)(R * K + C) * 2u; voffB[i] = (unsigned)((Epi::PERM ? (64 * (R >> 5) + perm32(R & 31)) : Rb) * K + C) * 2u; Rr[i] = R; Cc[i] = C; }
    const size_t kstep = (size_t)(BK * 2);
    const size_t hstep = (size_t)HALF * K * 2;
    const size_t tstep = 2 * hstep;
    const size_t hstepB = Epi::PERM ? (size_t)32 * K * 2 : hstep;
    const unsigned ldsw = (unsigned)wid * 1024u;
    const int aoff = lds_byte(wr * 64 + fr, fq * 8), boff = lds_byte(wc * 32 + fr, fq * 8);
#define PG8_SA(b, h) (((b) * 2 + (h)) * HTB)
#define PG8_SB(b, h) ((4 + (b) * 2 + (h)) * HTB)
#define PG8_STAGE(bufoff, gbase, voff) do { _Pragma("unroll") for (int _i = 0; _i < 2; ++_i) \
        __builtin_amdgcn_global_load_lds((const unsigned*)((const char*)(gbase) + (voff)[_i]), (LAS unsigned*)(lds + (bufoff) + ldsw + _i * 8192), 16, 0, 0); } while (0)
#define PG8_STAGE_A(bufoff, ptr, offs, h, kb) do { _Pragma("unroll") for (int _i = 0; _i < 2; ++_i) { \
        const char* _src = GATHER ? ((const char*)g.A + (offs)[(h) * 2 + _i] + (kb)) : ((const char*)(ptr) + voffA[_i]); \
        __builtin_amdgcn_global_load_lds((const unsigned*)_src, (LAS unsigned*)(lds + (bufoff) + ldsw + _i * 8192), 16, 0, 0); } } while (0)
#define PG8_LDA(dst, b, h) do { _Pragma("unroll") for (int m = 0; m < 4; ++m) _Pragma("unroll") for (int k = 0; k < 2; ++k) dst[m][k] = *(const LAS bf16x8*)(lds + PG8_SA(b, h) + aoff + m * 2048 + k * 1024); } while (0)
#define PG8_LDB(dst, b, h) do { _Pragma("unroll") for (int n = 0; n < 2; ++n) _Pragma("unroll") for (int k = 0; k < 2; ++k) dst[n][k] = *(const LAS bf16x8*)(lds + PG8_SB(b, h) + boff + n * 2048 + k * 1024); } while (0)
#define PG8_MMA(ai, bj, At, Bt) do { __builtin_amdgcn_s_setprio(1); _Pragma("unroll") for (int m = 0; m < 4; ++m) _Pragma("unroll") for (int n = 0; n < 2; ++n) _Pragma("unroll") for (int k = 0; k < 2; ++k) \
        acc[ai][bj][m][n] = __builtin_amdgcn_mfma_f32_16x16x32_bf16(Bt[n][k], At[m][k], acc[ai][bj][m][n], 0, 0, 0); __builtin_amdgcn_s_setprio(0); } while (0)
#define PG8_WAIT_V(n) asm volatile("s_waitcnt vmcnt(" #n ")" ::: "memory")
#define PG8_WAIT_L(n) asm volatile("s_waitcnt lgkmcnt(" #n ")" ::: "memory")
#define PG8_BAR __builtin_amdgcn_s_barrier()
#define PG8_SCHED __builtin_amdgcn_sched_barrier(0)
#define PG8_OFFS(u, o) do { _Pragma("unroll") for (int _h = 0; _h < 2; ++_h) _Pragma("unroll") for (int _i = 0; _i < 2; ++_i) (o)[_h * 2 + _i] = S.row_off((u), _h * HALF + Rr[_i]) + (unsigned)Cc[_i] * 2u; } while (0)
    Unit cur, nxt; int ui = 0;
    if (!S.next(0, cur)) return;
    f32x4 acc[2][2][4][2];
#pragma unroll
    for (int a = 0; a < 2; ++a)
#pragma unroll
        for (int b = 0; b < 2; ++b)
#pragma unroll
            for (int m = 0; m < 4; ++m)
#pragma unroll
                for (int n = 0; n < 2; ++n) acc[a][b][m][n] = (f32x4){0.f, 0.f, 0.f, 0.f};
    bf16x8 At[4][2], B0[2][2], B1[2][2];
    unsigned oc[4] = {0u, 0u, 0u, 0u}, on[4] = {0u, 0u, 0u, 0u};
    const char* cA = GATHER ? (const char*)g.A : (const char*)g.A + (size_t)cur.pm * tstep; const char* cB = (const char*)g.Bt + (size_t)cur.pn * tstep;
    if (GATHER) PG8_OFFS(cur, oc);
    PG8_STAGE(PG8_SB(0, 0), cB, voffB); PG8_STAGE_A(PG8_SA(0, 0), cA, oc, 0, 0); PG8_STAGE(PG8_SB(0, 1), cB + hstepB, voffB); PG8_STAGE_A(PG8_SA(0, 1), cA + hstep, oc, 1, 0);
    if (wr == 1) PG8_BAR;
    PG8_WAIT_V(4); PG8_BAR;
    PG8_STAGE(PG8_SB(1, 0), cB + kstep, voffB); PG8_STAGE_A(PG8_SA(1, 0), cA + kstep, oc, 0, kstep); PG8_STAGE(PG8_SB(1, 1), cB + hstepB + kstep, voffB);
    PG8_WAIT_V(6); PG8_BAR;
    for (;;) {
        const bool has_next = S.next(ui + 1, nxt);
        const char* nA = GATHER ? cA : (has_next ? (const char*)g.A + (size_t)nxt.pm * tstep : cA); const char* nB = has_next ? (const char*)g.Bt + (size_t)nxt.pn * tstep : cB;
        if (GATHER) { if (has_next) PG8_OFFS(nxt, on); else {
#pragma unroll
            for (int q = 0; q < 4; ++q) on[q] = oc[q]; } }
        for (int t = 0; t < nt; t += 2) {
            const bool last = (t == nt - 2);
            const char* a1 = cA + (size_t)(t + 1) * kstep;
            const char* a2 = last ? nA : cA + (size_t)(t + 2) * kstep; const char* b2 = last ? nB : cB + (size_t)(t + 2) * kstep;
            const char* a3 = a2 + kstep; const char* b3 = b2 + kstep;
            const size_t k1 = (size_t)(t + 1) * kstep, k2 = last ? (size_t)0 : (size_t)(t + 2) * kstep, k3 = k2 + kstep;
            unsigned o2[4];
#pragma unroll
            for (int q = 0; q < 4; ++q) o2[q] = last ? on[q] : oc[q];
            PG8_LDB(B0, 0, 0); PG8_SCHED; PG8_LDA(At, 0, 0); PG8_STAGE_A(PG8_SA(1, 1), a1 + hstep, oc, 1, k1);
            PG8_WAIT_L(8); PG8_BAR; PG8_WAIT_L(0); PG8_MMA(0, 0, At, B0); PG8_BAR; PG8_SCHED;
            PG8_LDB(B1, 0, 1); PG8_STAGE(PG8_SB(0, 0), b2, voffB);
            PG8_BAR; PG8_WAIT_L(0); PG8_MMA(0, 1, At, B1); PG8_BAR;
            PG8_LDA(At, 0, 1); PG8_STAGE_A(PG8_SA(0, 0), a2, o2, 0, k2);
            PG8_BAR; PG8_WAIT_L(0); PG8_MMA(1, 0, At, B0); PG8_BAR; PG8_SCHED;
            PG8_STAGE(PG8_SB(0, 1), b2 + hstepB, voffB);
            PG8_WAIT_V(6); PG8_BAR; PG8_MMA(1, 1, At, B1); PG8_BAR;
            PG8_LDB(B0, 1, 0); PG8_SCHED; PG8_LDA(At, 1, 0); PG8_STAGE_A(PG8_SA(0, 1), a2 + hstep, o2, 1, k2);
            PG8_WAIT_L(8); PG8_BAR; PG8_WAIT_L(0); PG8_MMA(0, 0, At, B0); PG8_BAR; PG8_SCHED;
            PG8_LDB(B1, 1, 1); PG8_STAGE(PG8_SB(1, 0), b3, voffB);
            PG8_BAR; PG8_WAIT_L(0); PG8_MMA(0, 1, At, B1); PG8_BAR;
            PG8_LDA(At, 1, 1); PG8_STAGE_A(PG8_SA(1, 0), a3, o2, 0, k3);
            PG8_BAR; PG8_WAIT_L(0); PG8_MMA(1, 0, At, B0); PG8_BAR; PG8_SCHED;
            PG8_STAGE(PG8_SB(1, 1), b3 + hstepB, voffB);
            PG8_WAIT_V(6); PG8_BAR; PG8_MMA(1, 1, At, B1); PG8_BAR;
        }
        E(acc, cur, wr, wc, fr, fq);
        if (!has_next) break;
#pragma unroll
        for (int a = 0; a < 2; ++a)
#pragma unroll
            for (int b = 0; b < 2; ++b)
#pragma unroll
                for (int m = 0; m < 4; ++m)
#pragma unroll
                    for (int n = 0; n < 2; ++n) acc[a][b][m][n] = (f32x4){0.f, 0.f, 0.f, 0.f};
        cur = nxt; cA = nA; cB = nB; ++ui;
#pragma unroll
        for (int q = 0; q < 4; ++q) oc[q] = on[q];
    }
    PG8_WAIT_V(0);
    if (wr == 0) PG8_BAR;
    PG8_BAR;
#undef PG8_SA
#undef PG8_SB
#undef PG8_STAGE
#undef PG8_STAGE_A
#undef PG8_LDA
#undef PG8_LDB
#undef PG8_MMA
#undef PG8_WAIT_V
#undef PG8_WAIT_L
#undef PG8_BAR
#undef PG8_SCHED
#undef PG8_OFFS
}
}
using pg8::Unit;

struct Frame {
    LAS unsigned char* lds;
    int tid, lane, wave, bid, G;
    unsigned char* ws; float* out;
};
DI float* xs_row(const Frame& F, int t) { return t < TL ? F.out + (size_t)t * D : (float*)(F.ws + WS_XC) + (size_t)(t - TL) * D; }
DI int mod_row(int t) { return t < TL ? (t >> 13) : 4; }
DI const float* modp(const Frame& F, int l, int r, int chunk) { return (const float*)(F.ws + WS_MOD) + ((size_t)(l * 5 + r) * 6 + chunk) * D; }

DI void tr_item(const float* W, int N, int k0, int n0, bf16* WT, int K, int drow0, LAS float* scr, int lane) {
    float wv[32];
#pragma unroll
    for (int i = 0; i < 32; ++i) wv[i] = __builtin_nontemporal_load(W + (size_t)(k0 + 2 * i + (lane >> 5)) * N + n0 + (lane & 31));
#pragma unroll
    for (int i = 0; i < 32; ++i) scr[(2 * i + (lane >> 5)) * 33 + (lane & 31)] = wv[i];
    asm volatile("s_waitcnt lgkmcnt(0)" ::: "memory");
    const int c = lane & 7;
#pragma unroll
    for (int j = 0; j < 4; ++j) { const int n = (lane >> 3) + 8 * j; const LAS float* s = scr + (8 * c) * 33 + n;
        u32x4 o; o.x = pk2(s[0 * 33], s[1 * 33]); o.y = pk2(s[2 * 33], s[3 * 33]); o.z = pk2(s[4 * 33], s[5 * 33]); o.w = pk2(s[6 * 33], s[7 * 33]);
        *(u32x4*)(WT + (size_t)(drow0 + n) * K + k0 + 8 * c) = o; }
    asm volatile("s_waitcnt lgkmcnt(0)" ::: "memory");
}
DI void convert_experts(const Frame& F, const KP& p, int l) {
    LAS float* scr = (LAS float*)(F.lds + F.wave * 16384);
    const int gw = F.bid * NWAVES + F.wave, NGW = F.G * NWAVES;
    const float* wg = p.in[21] + (size_t)l * NE * D * DE; const float* wu = p.in[22] + (size_t)l * NE * D * DE; const float* wd = p.in[23] + (size_t)l * NE * DE * D;
    bf16* GU = (bf16*)(F.ws + WS_GU); bf16* DN = (bf16*)(F.ws + WS_DN);
    for (int it = gw; it < 3 * 8192; it += NGW) {
        const int which = it >> 13, r8 = it & 8191, e = r8 >> 8, r = r8 & 255;
        if (which < 2) { const int kb = r >> 4, nb = r & 15, n0 = 32 * nb;
            tr_item((which ? wu : wg) + (size_t)e * D * DE, DE, 64 * kb, n0, GU, D, e * 1024 + 256 * (n0 >> 7) + 64 * ((n0 & 127) >> 5) + (which ? 32 : 0), scr, F.lane); }
        else { const int kb = r >> 5, nb = r & 31, n0 = 32 * nb;
            tr_item(wd + (size_t)e * DE * D, D, 64 * kb, n0, DN, DE, e * 1024 + n0, scr, F.lane); }
    }
}
DI void p0_prologue(const Frame& F, const KP& p) {
    const int gw = F.bid * NWAVES + F.wave, NGW = F.G * NWAVES;
    {
        LAS float* sc = (LAS float*)(F.lds);
        LAS float* part = (LAS float*)(F.lds + 32768);
        for (int i = F.tid; i < 5 * D; i += NTHR) { const int r = i >> 10, k = i & 1023; const float v = r < 4 ? p.in[1][r * D + k] : p.in[3][k]; sc[i] = siluf(v); }
        __syncthreads();
        for (int item = F.bid; item < 192; item += F.G) {
            const int l = item / 96, n0 = (item % 96) * 64;
            const float* w = p.in[4] + (size_t)l * D * 6144 + n0 + F.lane;
            float a0 = 0.f, a1 = 0.f, a2 = 0.f, a3 = 0.f, a4 = 0.f;
            const int kb = F.wave * 128;
#pragma unroll 32
            for (int k = 0; k < 128; ++k) { const float wv = __builtin_nontemporal_load(w + (size_t)(kb + k) * 6144);
                a0 += sc[kb + k] * wv; a1 += sc[D + kb + k] * wv; a2 += sc[2 * D + kb + k] * wv; a3 += sc[3 * D + kb + k] * wv; a4 += sc[4 * D + kb + k] * wv; }
            part[(F.wave * 5 + 0) * 64 + F.lane] = a0; part[(F.wave * 5 + 1) * 64 + F.lane] = a1; part[(F.wave * 5 + 2) * 64 + F.lane] = a2;
            part[(F.wave * 5 + 3) * 64 + F.lane] = a3; part[(F.wave * 5 + 4) * 64 + F.lane] = a4;
            __syncthreads();
            if (F.tid < 320) { const int r = F.tid >> 6, n = F.tid & 63; float s = p.in[5][l * 6144 + n0 + n];
#pragma unroll
                for (int w8 = 0; w8 < 8; ++w8) s += part[(w8 * 5 + r) * 64 + n];
                ((float*)(F.ws + WS_MOD))[(size_t)(l * 5 + r) * 6144 + n0 + n] = s; }
            __syncthreads();
        }
        __syncthreads();
    }
    {
        LAS float* scr = (LAS float*)(F.lds + F.wave * 16384);
        constexpr int I_POOL = 128, I_IN = 2048 + 16, I_OUT = 512;
        for (int it = gw; it < I_POOL + I_IN + I_OUT; it += NGW) {
            int r = it;
            if (r < I_POOL) { const int g = r >> 5, q = r & 31, kb = q >> 3, nb = q & 7; tr_item(p.in[8] + (size_t)g * 65536, 256, 64 * kb, 32 * nb, (bf16*)(F.ws + WS_BTP), 256, g * 256 + 32 * nb, scr, F.lane); continue; }
            r -= I_POOL;
            if (r < I_IN) { const int kb = r < 2048 ? (r >> 7) : (r - 2048), nb = r < 2048 ? (r & 127) : 128; tr_item(p.in[11], DN_IN, 64 * kb, 32 * nb, (bf16*)(F.ws + WS_BTIN), D, 32 * nb, scr, F.lane); continue; }
            r -= I_IN;
            { const int kb = r >> 5, nb = r & 31; tr_item(p.in[16], D, 64 * kb, 32 * nb, (bf16*)(F.ws + WS_BTOUT), D, 32 * nb, scr, F.lane); }
        }
    }
    {
        const int gt = F.bid * NTHR + F.tid, NGT = F.G * NTHR;
        bf16* wr2 = (bf16*)(F.ws + WS_WR2);
        for (int i = gt; i < 2 * 48 * D; i += NGT) { const int l = i / (48 * D), r = i % (48 * D), j = r >> 10, k = r & 1023;
            const float w = j < 4 ? p.in[17][((size_t)l * D + k) * 4 + j] : (j < 36 ? p.in[19][((size_t)l * D + k) * 32 + (j - 4)] : 0.f);
            const unsigned hi = f2bf(w); const float rem = w - bf2f((unsigned short)hi);
            wr2[(size_t)(l * 2 + 0) * 48 * D + r] = (bf16)hi; wr2[(size_t)(l * 2 + 1) * 48 * D + r] = (bf16)f2bf(rem); }
        u32x4* zr = (u32x4*)((bf16*)(F.ws + WS_BTIN) + (size_t)4128 * D);
        for (int i = gt; i < 224 * D / 8; i += NGT) zr[i] = (u32x4){0u, 0u, 0u, 0u};
    }
    {
        float* rs = (float*)(F.ws + WS_RSTD);
        for (int t = gw; t < T; t += NGW) {
            const f32x4* xr = (const f32x4*)(t < TL ? p.in[0] + (size_t)t * D : p.in[2] + (size_t)(t - TL) * D) + F.lane;
            float s = 0.f;
#pragma unroll
            for (int j = 0; j < 4; ++j) { const f32x4 v = xr[64 * j]; s += (v.x * v.x + v.y * v.y) + (v.z * v.z + v.w * v.w); }
            s = wave_sum(s);
            if (F.lane == 0) rs[t] = rsqrtf(s * (1.f / D) + EPS);
        }
    }
}

DI void p1_pool_diff(const Frame& F, const KP& p) {
    const float* rs = (const float*)(F.ws + WS_RSTD);
    bf16* DD = (bf16*)(F.ws + WS_DD);
    LAS f32x4* Vs = (LAS f32x4*)(F.lds);
    const int ch4 = F.tid & 63, cg = F.tid >> 6;
    {
        const int gw = F.bid * NWAVES + F.wave;
        if (gw < 2 * 5 * 36) { const int l = gw / 180, q = gw % 180, r = q / 36, j = q % 36; const float* b2 = modp(F, l, r, 3); float s = 0.f;
            for (int i = 0; i < 16; ++i) { const int c = F.lane + 64 * i; const float w = j < 4 ? p.in[17][((size_t)l * D + c) * 4 + j] : p.in[19][((size_t)l * D + c) * 32 + (j - 4)]; s += b2[c] * w; }
            s = wave_sum(s);
            if (F.lane == 0) ((float*)(F.ws + WS_C0))[(l * 5 + r) * 48 + j] = s + (j < 4 ? p.in[18][l * 4 + j] : p.in[20][l * 32 + (j - 4)]); }
    }
    LAS float* rsl = (LAS float*)(F.lds + 65536);
    for (int it = F.bid; it < 256 + 64; it += F.G) {
        if (it < 256) {
            const int g = it & 3, bb = it >> 2, b = bb >> 4, r0 = (bb & 15) * 8, hw = 1 << g;
            const int ch = g * 256 + 4 * ch4;
            f32x4 A4 = *(const f32x4*)(p.in[6] + ch); { const f32x4 s4 = *(const f32x4*)(modp(F, 0, b, 1) + ch); A4 = A4 * (s4 + 1.f); }
            const int rlo = max(r0 - hw, 0), rhi = min(r0 + 8 + hw, 128);
            for (int i = F.tid; i < (rhi - rlo) * 64; i += NTHR) rsl[i] = rs[b * SEQ + rlo * 64 + i];
            __syncthreads();
            const float* xb = p.in[0] + (size_t)b * SEQ * D + ch + (size_t)(8 * cg) * D;
            f32x4 S[8];
#pragma unroll
            for (int cc = 0; cc < 8; ++cc) S[cc] = (f32x4){0.f, 0.f, 0.f, 0.f};
            for (int rr = rlo; rr < min(r0 + hw, 128); ++rr) {
#pragma unroll
                for (int cc = 0; cc < 8; ++cc) S[cc] += *(const f32x4*)(xb + (size_t)(rr * 64 + cc) * D) * rsl[(rr - rlo) * 64 + 8 * cg + cc]; }
            for (int r = r0; r < r0 + 8; ++r) {
                const int lo_r = max(r - hw, 0), hi_r = min(r + hw, 128);
                f32x4 xc[8], xa[8], xs_[8];
                const bool ha = (r + hw) < 128, hs = (r - hw) >= 0;
#pragma unroll
                for (int cc = 0; cc < 8; ++cc) { xc[cc] = *(const f32x4*)(xb + (size_t)(r * 64 + cc) * D);
                    xa[cc] = ha ? *(const f32x4*)(xb + (size_t)((r + hw) * 64 + cc) * D) : (f32x4){0.f, 0.f, 0.f, 0.f};
                    xs_[cc] = hs ? *(const f32x4*)(xb + (size_t)((r - hw) * 64 + cc) * D) : (f32x4){0.f, 0.f, 0.f, 0.f}; }
#pragma unroll
                for (int cc = 0; cc < 8; ++cc) Vs[(8 * cg + cc) * 64 + ch4] = S[cc];
                __syncthreads();
                f32x4 h = {0.f, 0.f, 0.f, 0.f};
                { const int c0 = 8 * cg, l0 = max(c0 - hw, 0), h0 = min(c0 + hw, 64); for (int c2 = l0; c2 < h0; ++c2) h += Vs[c2 * 64 + ch4]; }
#pragma unroll
                for (int cc = 0; cc < 8; ++cc) { const int col = 8 * cg + cc, lo_c = max(col - hw, 0), hi_c = min(col + hw, 64);
                    if (cc > 0) { if (col + hw <= 64) h += Vs[(col + hw - 1) * 64 + ch4]; if (col - hw > 0) h -= Vs[(col - hw - 1) * 64 + ch4]; }
                    const int t = b * SEQ + r * 64 + col; const float inv = 1.f / (float)((hi_r - lo_r) * (hi_c - lo_c));
                    const f32x4 xn = xc[cc] * rsl[(r - rlo) * 64 + col];
                    const f32x4 d = A4 * (h * inv - xn);
                    u32x2 o; o.x = pk2(d.x, d.y); o.y = pk2(d.z, d.w);
                    *(u32x2*)(DD + ((size_t)g * T + t) * 256 + 4 * ch4) = o; }
#pragma unroll
                for (int cc = 0; cc < 8; ++cc) { if (ha) S[cc] += xa[cc] * rsl[(r + hw - rlo) * 64 + 8 * cg + cc]; if (hs) S[cc] -= xs_[cc] * rsl[(r - hw - rlo) * 64 + 8 * cg + cc]; }
                __syncthreads();
            }
        } else {
            const int i2 = it - 256, g = i2 & 3, b = (i2 >> 2) & 3, q4 = i2 >> 4, hw = 1 << g;
            const int ch = g * 256 + 4 * ch4;
            f32x4 A4 = *(const f32x4*)(p.in[6] + ch); { const f32x4 s4 = *(const f32x4*)(modp(F, 0, 4, 1) + ch); A4 = A4 * (s4 + 1.f); }
#pragma unroll
            for (int cc = 0; cc < 8; ++cc) { const int j = 64 * q4 + 8 * cg + cc, lo = max(j - hw, 0), hi = min(j + hw, CTXL); f32x4 a = {0.f, 0.f, 0.f, 0.f};
                for (int jj = lo; jj < hi; ++jj) a += *(const f32x4*)(p.in[2] + (size_t)(b * CTXL + jj) * D + ch) * rs[TL + b * CTXL + jj];
                const int t = TL + b * CTXL + j; const float inv = 1.f / (float)(hi - lo);
                const f32x4 xn = *(const f32x4*)(p.in[2] + (size_t)(b * CTXL + j) * D + ch) * rs[t];
                const f32x4 d = A4 * (a * inv - xn);
                u32x2 o; o.x = pk2(d.x, d.y); o.y = pk2(d.z, d.w);
                *(u32x2*)(DD + ((size_t)g * T + t) * 256 + 4 * ch4) = o; }
        }
    }
}

struct PoolOrder {
    int G, c;
    DI bool next(int i, Unit& u) const { const int L = i * G + c; if (L >= 528) return false; u.pm = L; u.pn = L / 132; u.e = 0; u.rt = 0; u.nvalid = 0; return true; }
    DI unsigned row_off(const Unit&, int) const { return 0u; }
};
struct G1Order {
    int G, c;
    DI bool next(int i, Unit& u) const {
        if (G == 256) { if (i < 8) { const int x = c & 7, j = c >> 3; u.pm = (i * 8 + x) * 2 + (j >> 4); u.pn = j & 15; }
            else { const int q = (i - 8) * 256 + c; if (q >= 48 + 132) return false; if (q < 48) { u.pm = 128 + q / 12; u.pn = q % 12; } else { u.pm = q - 48; u.pn = 16; } } }
        else { const int L = i * G + c; if (L >= 2176 + 52) return false;
            if (L < 2176) { u.pm = L / 17; u.pn = L % 17; } else { const int q = L - 2176, q13 = q % 13; u.pm = 128 + q / 13; u.pn = q13 < 12 ? q13 : 16; } }
        u.e = 0; u.rt = 0; u.nvalid = 0; return true; }
    DI unsigned row_off(const Unit&, int) const { return 0u; }
};
struct G2Order {
    int G, c;
    DI bool next(int i, Unit& u) const {
        if (G == 256) { if (i >= 2) return false; const int x = c & 7, j = c >> 3; u.pm = (i * 8 + x) * 8 + (j >> 2); u.pn = j & 3; }
        else { const int L = i * G + c; if (L >= 512) return false; u.pm = L >> 2; u.pn = L & 3; }
        u.e = 0; u.rt = 0; u.nvalid = 0; return true; }
    DI unsigned row_off(const Unit&, int) const { return 0u; }
};
struct MoeOrder {
    int G, c, total; const LAS int* tb; const LAS int* cn; const Entry* ent;
    DI bool next(int i, Unit& u) const { int rtg, ct;
        if (G == 256) { const int x = c & 7, j = c >> 3; ct = j & 3; rtg = 64 * i + 8 * x + (j >> 2); if (rtg >= total) return false; }
        else { const int L = i * G + c; if (L >= 4 * total) return false; rtg = L >> 2; ct = L & 3; }
        int e = 0;
        for (int q = 1; q < NE; ++q) e += (tb[q] <= rtg) ? 1 : 0;
        u.pm = rtg; u.pn = e * 4 + ct; u.e = e; u.rt = rtg - tb[e]; u.nvalid = cn[e] - u.rt * 256; return true; }
    DI unsigned row_off(const Unit& u, int row) const { int tok = 0; if (row < u.nvalid) tok = ent[(size_t)u.e * CAP + u.rt * 256 + row].ts >> 1; return (unsigned)tok * (unsigned)(D * 2); }
};
DI void moe_tables(const Frame& F, int l, LAS int* tb, LAS int* cn) {
    if (F.tid < 64) { const unsigned* cnt = (const unsigned*)(F.ws + WS_CTL) + CW_CNT + l * 32 * CNT_STRIDE;
        const int c = F.tid < NE ? (int)__hip_atomic_load(cnt + F.tid * CNT_STRIDE, __ATOMIC_RELAXED, __HIP_MEMORY_SCOPE_AGENT) : 0;
        const int ntl = (c + 255) >> 8; int inc = ntl;
#pragma unroll
        for (int o = 1; o < 32; o <<= 1) { const int up = __shfl_up(inc, o); if (F.lane >= o) inc += up; }
        if (F.tid < NE) { cn[F.tid] = c; tb[F.tid] = inc - ntl; if (F.tid == NE - 1) tb[NE] = inc; } }
    __syncthreads();
}

struct EpiRaw {
    static constexpr bool PERM = true;
    bf16* o; int pool;
    DI void operator()(const f32x4 (&acc)[2][2][4][2], const Unit& u, int, int, int, int) const {
        int tz = threadIdx.x; asm volatile("" : "+v"(tz)); const int wr = tz >> 8, wc = (tz >> 6) & 3, fr = tz & 15, fq = (tz >> 4) & 3;
        const int rt = pool ? u.pm - 132 * u.pn : u.pm;
#pragma unroll
        for (int ai = 0; ai < 2; ++ai)
#pragma unroll
            for (int m = 0; m < 4; ++m) { bf16* dst = o + (size_t)(rt * 256 + ai * 128 + wr * 64 + m * 16 + fr) * D + u.pn * 256 + wc * 64 + 8 * fq;
#pragma unroll
                for (int bj = 0; bj < 2; ++bj) { const f32x4 v0 = acc[ai][bj][m][0], v1 = acc[ai][bj][m][1];
                    u32x4 w; w.x = pk2(v0.x, v0.y); w.y = pk2(v0.z, v0.w); w.z = pk2(v1.x, v1.y); w.w = pk2(v1.z, v1.w);
                    *(u32x4*)(dst + bj * 32) = w; } }
    }
};
struct EpiGU {
    static constexpr bool PERM = true;
    bf16* hid;
    DI void operator()(const f32x4 (&acc)[2][2][4][2], const Unit& u, int, int, int, int) const {
        int tz = threadIdx.x; asm volatile("" : "+v"(tz)); const int wr = tz >> 8, wc = (tz >> 6) & 3, fr = tz & 15, fq = (tz >> 4) & 3;
        const int ct = u.pn & 3;
#pragma unroll
        for (int ai = 0; ai < 2; ++ai)
#pragma unroll
            for (int m = 0; m < 4; ++m) { const size_t row = (size_t)u.pm * 256 + ai * 128 + wr * 64 + m * 16 + fr;
                const f32x4 g0 = acc[ai][0][m][0], g1 = acc[ai][0][m][1], u0 = acc[ai][1][m][0], u1 = acc[ai][1][m][1];
                u32x4 w; w.x = pk2(siluf(g0.x) * u0.x, siluf(g0.y) * u0.y); w.y = pk2(siluf(g0.z) * u0.z, siluf(g0.w) * u0.w);
                w.z = pk2(siluf(g1.x) * u1.x, siluf(g1.y) * u1.y); w.w = pk2(siluf(g1.z) * u1.z, siluf(g1.w) * u1.w);
                *(u32x4*)(hid + row * DE + ct * 128 + wc * 32 + 8 * fq) = w; }
    }
};
struct EpiDown {
    static constexpr bool PERM = true;
    bf16* y;
    DI void operator()(const f32x4 (&acc)[2][2][4][2], const Unit& u, int, int, int, int) const {
        int tz = threadIdx.x; asm volatile("" : "+v"(tz)); const int wr = tz >> 8, wc = (tz >> 6) & 3, fr = tz & 15, fq = (tz >> 4) & 3;
        const int ct = u.pn & 3;
#pragma unroll
        for (int ai = 0; ai < 2; ++ai)
#pragma unroll
            for (int m = 0; m < 4; ++m) { const size_t row = (size_t)u.pm * 256 + ai * 128 + wr * 64 + m * 16 + fr;
                bf16* dst = y + row * D + ct * 256 + wc * 64 + 8 * fq;
#pragma unroll
                for (int bj = 0; bj < 2; ++bj) { const f32x4 v0 = acc[ai][bj][m][0], v1 = acc[ai][bj][m][1];
                    u32x4 w; w.x = pk2(v0.x, v0.y); w.y = pk2(v0.z, v0.w); w.z = pk2(v1.x, v1.y); w.w = pk2(v1.z, v1.w);
                    *(u32x4*)(dst + bj * 32) = w; } }
    }
};
struct EpiG1 {
    static constexpr bool PERM = true;
    bf16* pqkv; bf16* z; bf16* halo; float* ab;
    DI void operator()(const f32x4 (&acc)[2][2][4][2], const Unit& u, int, int, int, int) const {
        int tz = threadIdx.x; asm volatile("" : "+v"(tz)); const int wr = tz >> 8, wc = (tz >> 6) & 3, fr = tz & 15, fq = (tz >> 4) & 3;
#pragma unroll
        for (int ai = 0; ai < 2; ++ai)
#pragma unroll
            for (int m = 0; m < 4; ++m) { const int t = u.pm * 256 + ai * 128 + wr * 64 + m * 16 + fr, rr = m * 16 + fr;
#pragma unroll
                for (int bj = 0; bj < 2; ++bj) { const f32x4 v0 = acc[ai][bj][m][0], v1 = acc[ai][bj][m][1];
                    u32x4 w; w.x = pk2(v0.x, v0.y); w.y = pk2(v0.z, v0.w); w.z = pk2(v1.x, v1.y); w.w = pk2(v1.z, v1.w);
                    const int col = u.pn * 256 + wc * 64 + bj * 32 + 8 * fq;
                    if (u.pn < 12) { *(u32x4*)(pqkv + (size_t)t * 3072 + col) = w;
                        if (rr == 0 || rr >= 62) { const int slot = rr == 0 ? 0 : rr - 61; *(u32x4*)(halo + ((size_t)(t >> 6) * 3 + slot) * 3072 + col) = w; } }
                    else if (u.pn < 16) *(u32x4*)(z + (size_t)t * D + (col - 3072)) = w;
                    else if (bj == 0 && wc == 0) { *(f32x4*)(ab + (size_t)t * 32 + 8 * fq) = v0; *(f32x4*)(ab + (size_t)t * 32 + 8 * fq + 4) = v1; } } }
    }
};
DI void p_router(const Frame& F, const KP& p, int l, int ntok) {
    LAS float* A2s = (LAS float*)(F.lds); LAS float* gBs = A2s + 1024; LAS float* gAs = A2s + 2048;
    constexpr int YT_OFF = 12288, YT_ROW = 2064, YT_SIZE = 16 * YT_ROW;
    constexpr int PT_OFF = YT_OFF + 2 * YT_SIZE, PT_SIZE = 8 * 16 * 49 * 4;
    constexpr int PS_OFF = PT_OFF + 2 * PT_SIZE;
    constexpr int LG_OFF = PS_OFF + 1024, RS_OFF = LG_OFF + 16 * 49 * 4, HI_OFF = RS_OFF + 64;
    static_assert(HI_OFF + 256 + 3072 <= LDS_MISC, "router LDS map");
    LAS float* lgs = (LAS float*)(F.lds + LG_OFF);
    LAS float* rsl = (LAS float*)(F.lds + RS_OFF);
    LAS int* hist = (LAS int*)(F.lds + HI_OFF);
    LAS int* basee = (LAS int*)(F.lds + HI_OFF + 128);
    LAS int* tiE = (LAS int*)(F.lds + HI_OFF + 256);
    LAS int* tiP = (LAS int*)(F.lds + HI_OFF + 256 + 1024);
    LAS float* tiW = (LAS float*)(F.lds + HI_OFF + 256 + 2048);
    const bf16* DL = (const bf16*)(F.ws + (l == 0 ? WS_YP : WS_Y2));
    const bf16* whi = (const bf16*)(F.ws + WS_WR2) + (size_t)(l * 2) * 48 * D; bf16* HX = (bf16*)(F.ws + WS_HX);
    unsigned* cnt = (unsigned*)(F.ws + WS_CTL) + CW_CNT + l * 32 * CNT_STRIDE;
    Entry* ent = (Entry*)(F.ws + WS_ENT);
    const float* nf = p.in[7] + l * D;
    const int fr = F.lane & 15, fq = F.lane >> 4, kw = 128 * F.wave;
    const int nunits = 256 + (ntok > TL ? 64 : 0);
    for (int un = F.bid; un < nunits; un += F.G) {
        const int t0 = un < 256 ? un * 128 : TL + (un - 256) * 16, nt16 = un < 256 ? 8 : 1, r = mod_row(t0);
        const bool ctxu = (l == 0 && t0 >= TL);
        bf16x8 bh[4][3];
        { int zo = 0; asm volatile("" : "+s"(zo));
#pragma unroll
          for (int ks = 0; ks < 4; ++ks)
#pragma unroll
            for (int n = 0; n < 3; ++n) { bh[ks][n] = *(const bf16x8*)(whi + zo + (size_t)(16 * n + fr) * D + kw + 32 * ks + 8 * fq); } }
        for (int i = F.tid; i < D; i += NTHR) { A2s[i] = nf[i] * (modp(F, l, r, 4)[i] + 1.f); const float gm = modp(F, l, r, 2)[i];
            if (l == 0) { const float ps = p.in[10][i]; gAs[i] = gm * ps; gBs[i] = gm * p.in[9][i] * ps; } else { gAs[i] = gm; gBs[i] = 0.f; } }
        if (F.tid < 32) hist[F.tid] = 0;
        __syncthreads();
        const float* c0 = (const float*)(F.ws + WS_C0) + (l * 5 + r) * 48;
        const float* xbase = l == 0 ? (t0 < TL ? p.in[0] + (size_t)t0 * D : p.in[2] + (size_t)(t0 - TL) * D) : nullptr;
        const bf16* xb16 = (const bf16*)F.out + (size_t)t0 * D;
        bf16* xo16 = (bf16*)(F.ws + (l == 0 ? WS_XS1 : WS_XS3)) + (size_t)t0 * D;
        float* xo32 = (float*)(F.ws + WS_XC) + (size_t)(t0 - TL) * D;
        f32x4 xa[4], xb[4]; u32x4 xq[4], dq[4];
#define RT_LOAD(mt_) do { const size_t ro_ = (size_t)(16 * (mt_) + fr) * D + kw + 8 * fq; _Pragma("unroll") for (int ks = 0; ks < 4; ++ks) { \
            if (l == 0) { xa[ks] = *(const f32x4*)(xbase + ro_ + 32 * ks); xb[ks] = *(const f32x4*)(xbase + ro_ + 32 * ks + 4); } else xq[ks] = *(const u32x4*)(xb16 + ro_ + 32 * ks); \
            dq[ks] = *(const u32x4*)(DL + (size_t)t0 * D + ro_ + 32 * ks); } } while (0)
        RT_LOAD(0);
        for (int mt = 0; mt < nt16; ++mt) {
            const int bf = mt & 1;
            LAS unsigned char* yt = F.lds + YT_OFF + bf * YT_SIZE; LAS float* part = (LAS float*)(F.lds + PT_OFF + bf * PT_SIZE); LAS float* pss = (LAS float*)(F.lds + PS_OFF + bf * 512);
            { f32x4 acc[3] = {{0.f, 0.f, 0.f, 0.f}, {0.f, 0.f, 0.f, 0.f}, {0.f, 0.f, 0.f, 0.f}}; float ssq = 0.f;
              const size_t ro = (size_t)(16 * mt + fr) * D + kw + 8 * fq;
#pragma unroll
              for (int ks = 0; ks < 4; ++ks) {
                f32x4 x0, x1; if (l == 0) { x0 = xa[ks]; x1 = xb[ks]; } else unpk8(xq[ks], x0, x1);
                { f32x4 da, db; unpk8(dq[ks], da, db); const LAS float* ga = gAs + kw + 32 * ks + 8 * fq; const LAS float* gb = gBs + kw + 32 * ks + 8 * fq;
                  x0 += *(const LAS f32x4*)gb + *(const LAS f32x4*)ga * da; x1 += *(const LAS f32x4*)(gb + 4) + *(const LAS f32x4*)(ga + 4) * db; }
                if (ctxu) { *(f32x4*)(xo32 + ro + 32 * ks) = x0; *(f32x4*)(xo32 + ro + 32 * ks + 4) = x1; } else *(u32x4*)(xo16 + ro + 32 * ks) = pk8(x0, x1);
                ssq += (x0.x * x0.x + x0.y * x0.y) + (x0.z * x0.z + x0.w * x0.w) + (x1.x * x1.x + x1.y * x1.y) + (x1.z * x1.z + x1.w * x1.w);
                const f32x4 y0 = x0 * *(const LAS f32x4*)(A2s + kw + 32 * ks + 8 * fq), y1 = x1 * *(const LAS f32x4*)(A2s + kw + 32 * ks + 8 * fq + 4);
                const u32x4 hq = pk8(y0, y1); f32x4 h0, h1; unpk8(hq, h0, h1);
                const bf16x8 ah = __builtin_bit_cast(bf16x8, hq), al = __builtin_bit_cast(bf16x8, pk8(y0 - h0, y1 - h1));
                *(LAS bf16x8*)(yt + fr * YT_ROW + (kw + 32 * ks + 8 * fq) * 2) = ah;
#pragma unroll
                for (int n = 0; n < 3; ++n) {
                    acc[n] = __builtin_amdgcn_mfma_f32_16x16x32_bf16(ah, bh[ks][n], acc[n], 0, 0, 0);
                    acc[n] = __builtin_amdgcn_mfma_f32_16x16x32_bf16(al, bh[ks][n], acc[n], 0, 0, 0); }
              }
              if (mt + 1 < nt16) RT_LOAD(mt + 1);
              ssq += __shfl_xor(ssq, 16); ssq += __shfl_xor(ssq, 32);
              if (fq == 0) pss[F.wave * 16 + fr] = ssq;
#pragma unroll
              for (int n = 0; n < 3; ++n)
#pragma unroll
                for (int q = 0; q < 4; ++q) part[(F.wave * 16 + 4 * fq + q) * 49 + 16 * n + fr] = acc[n][q]; }
            __syncthreads();
            if (F.tid < 256) { const int tl = F.tid >> 4, jj = F.tid & 15; float s = 0.f;
#pragma unroll
                for (int w = 0; w < 8; ++w) s += pss[w * 16 + tl];
                const float rstd = rsqrtf(s * (1.f / D) + EPS);
                if (jj == 0) rsl[tl] = rstd;
#pragma unroll
                for (int j = jj; j < 48; j += 16) { float g = 0.f;
#pragma unroll
                    for (int w = 0; w < 8; ++w) g += part[(w * 16 + tl) * 49 + j];
                    lgs[tl * 49 + j] = g * rstd + c0[j]; } }
            __syncthreads();
            if (F.tid < 16) {
                const LAS float* lg = lgs + F.tid * 49;
                const float g0 = lg[0], g1 = lg[1], g2 = lg[2], g3 = lg[3];
                int gi = 0; float gm = g0; if (g1 > gm) { gm = g1; gi = 1; } if (g2 > gm) { gm = g2; gi = 2; } if (g3 > gm) { gm = g3; gi = 3; }
                const float pg = 1.f / (__expf(g0 - gm) + __expf(g1 - gm) + __expf(g2 - gm) + __expf(g3 - gm));
                float e1 = -3.0e38f, e2 = -3.0e38f; int i1 = 0, i2 = 0;
#pragma unroll
                for (int j = 0; j < 8; ++j) { const float v = lg[4 + gi * 8 + j];
                    if (v > e1) { e2 = e1; i2 = i1; e1 = v; i1 = j; } else if (v > e2) { e2 = v; i2 = j; } }
                const float w1 = pg / (1.f + __expf(e2 - e1)), w2 = pg - w1;
                const int E0 = gi * 8 + i1, E1 = gi * 8 + i2, tl = 16 * mt + F.tid;
                tiE[tl * 2] = E0; tiE[tl * 2 + 1] = E1; tiW[tl * 2] = w1; tiW[tl * 2 + 1] = w2;
                tiP[tl * 2] = atomicAdd((int*)&hist[E0], 1); tiP[tl * 2 + 1] = atomicAdd((int*)&hist[E1], 1);
            }
#pragma unroll 1
            for (int kk = 0; kk < 2; ++kk) { const int tk = 2 * F.wave + kk; const float rstd = rsl[tk];
#pragma unroll
                for (int i = 0; i < 2; ++i) { const int c = 8 * F.lane + 512 * i; f32x4 ya, yb; unpk8(*(const LAS u32x4*)(yt + tk * YT_ROW + c * 2), ya, yb);
                    const float* b2 = modp(F, l, r, 3) + c;
                    *(u32x4*)(HX + (size_t)(t0 + 16 * mt + tk) * D + c) = pk8(ya * rstd + *(const f32x4*)b2, yb * rstd + *(const f32x4*)(b2 + 4)); } }
        }
#undef RT_LOAD
        __syncthreads();
        { int tz = threadIdx.x; asm volatile("" : "+v"(tz));
          if (tz < 32) { const int hcount = hist[tz]; basee[tz] = hcount > 0 ? (int)__hip_atomic_fetch_add(cnt + tz * CNT_STRIDE, (unsigned)hcount, __ATOMIC_RELAXED, __HIP_MEMORY_SCOPE_AGENT) : 0; } }
        __syncthreads();
        if (F.tid < 32 * nt16) { const int tl = F.tid >> 1, E = tiE[F.tid], pos = basee[E] + tiP[F.tid]; Entry en; en.ts = (t0 + tl) * 2 + (F.tid & 1); en.w = tiW[F.tid];
            ent[(size_t)E * CAP + pos] = en;
            Entry ti; ti.ts = (E << 16) | pos; ti.w = en.w; ((Entry*)(F.ws + WS_TI))[(size_t)(t0 + tl) * 2 + (F.tid & 1)] = ti; }
        __syncthreads();
    }
}

DI void p6_n1(const Frame& F, const KP& p, const LAS int* tb) {
    const int gw = F.bid * NWAVES + F.wave, NGW = F.G * NWAVES;
    const bf16* Y = (const bf16*)(F.ws + WS_Y); bf16* HX = (bf16*)(F.ws + WS_HX); const Entry* TI = (const Entry*)(F.ws + WS_TI);
    for (int t = gw; t < T; t += NGW) {
        const int r = mod_row(t); const bool lat = t < TL;
        float* xr = (float*)(F.ws + WS_XC) + (size_t)(t - TL) * D;
        const bf16* xi16 = (const bf16*)(F.ws + WS_XS1) + (size_t)t * D; bf16* xo16 = (bf16*)F.out + (size_t)t * D;
        const Entry ta = TI[(size_t)2 * t], tbb = TI[(size_t)2 * t + 1]; const float w0 = ta.w, w1 = tbb.w;
        const size_t r0 = ((size_t)tb[ta.ts >> 16] * 256 + (ta.ts & 0xffff)) * D, r1 = ((size_t)tb[tbb.ts >> 16] * 256 + (tbb.ts & 0xffff)) * D;
        f32x4 va[2], vb[2]; u32x4 y0[2], y1[2]; float s = 0.f;
#pragma unroll
        for (int i = 0; i < 2; ++i) { const int c = 8 * F.lane + 512 * i;
            if (lat) unpk8(*(const u32x4*)(xi16 + c), va[i], vb[i]); else { va[i] = *(const f32x4*)(xr + c); vb[i] = *(const f32x4*)(xr + c + 4); }
            y0[i] = *(const u32x4*)(Y + r0 + c); y1[i] = *(const u32x4*)(Y + r1 + c); }
#pragma unroll
        for (int i = 0; i < 2; ++i) { const int c = 8 * F.lane + 512 * i; f32x4 a0, b0, a1, b1; unpk8(y0[i], a0, b0); unpk8(y1[i], a1, b1);
            const float* gp = modp(F, 0, r, 5) + c;
            va[i] = va[i] + *(const f32x4*)gp * (a0 * w0 + a1 * w1); vb[i] = vb[i] + *(const f32x4*)(gp + 4) * (b0 * w0 + b1 * w1);
            if (lat) *(u32x4*)(xo16 + c) = pk8(va[i], vb[i]); else { *(f32x4*)(xr + c) = va[i]; *(f32x4*)(xr + c + 4) = vb[i]; }
            s += (va[i].x * va[i].x + va[i].y * va[i].y) + (va[i].z * va[i].z + va[i].w * va[i].w) + (vb[i].x * vb[i].x + vb[i].y * vb[i].y) + (vb[i].z * vb[i].z + vb[i].w * vb[i].w); }
        const float rstd = rsqrtf(wave_sum(s) * (1.f / D) + EPS);
#pragma unroll
        for (int i = 0; i < 2; ++i) { const int c = 8 * F.lane + 512 * i; const float* nm = p.in[6] + D + c; const float* sc = modp(F, 1, r, 1) + c; const float* sh = modp(F, 1, r, 0) + c;
            const f32x4 oa = va[i] * rstd * (*(const f32x4*)nm * (*(const f32x4*)sc + 1.f)) + *(const f32x4*)sh, ob = vb[i] * rstd * (*(const f32x4*)(nm + 4) * (*(const f32x4*)(sc + 4) + 1.f)) + *(const f32x4*)(sh + 4);
            *(u32x4*)(HX + (size_t)t * D + c) = pk8(oa, ob); }
    }
}

DI bf16x8 lds_frag(LAS unsigned char* base, int byteoff) { return *(const LAS bf16x8*)(base + byteoff); }
DI void p8_c1a(const Frame& F, const KP& p) {
    bf16* PQ = (bf16*)(F.ws + WS_PQKV); const bf16* HALO = (const bf16*)(F.ws + WS_HALO); const float* AB = (const float*)(F.ws + WS_AB);
    float* LM = (float*)(F.ws + WS_LM); bf16* PM = (bf16*)(F.ws + WS_PM); float* GCB = (float*)(F.ws + WS_GCB);
    constexpr int RS = 272;
    LAS unsigned char* qs = F.lds; LAS unsigned char* ks = F.lds + 64 * RS;
    LAS float* KKs = (LAS float*)(F.lds + 53248);
    LAS float* QKs = (LAS float*)(F.lds + 53248 + 17408);
    LAS float* gcs = (LAS float*)(F.lds + 53248 + 2 * 17408);
    LAS float* bes = gcs + 128;
    const int fr = F.lane & 15, fq = F.lane >> 4;
    const int grp = F.tid >> 4, l16 = F.tid & 15, which = grp >> 3, ro = grp & 7;
    u32x4 raw[11]; float abA = 0.f, abB = 0.f;
#define C1_LOAD(unit_) do { const int cid_ = (unit_) >> 3, h_ = (unit_) & 7, tok0_ = cid_ * 64, col_ = which * 1024 + h_ * 128 + 8 * l16; \
        const bool first_ = cid_ < 512 ? ((cid_ & 127) == 0) : (((cid_ - 512) & 3) == 0), last_ = cid_ < 512 ? ((cid_ & 127) == 127) : (((cid_ - 512) & 3) == 3); \
        if (F.wave < 6) { _Pragma("unroll") for (int q = 0; q < 11; ++q) { const int rr = 8 * ro + q - 2; u32x4 v = {0u, 0u, 0u, 0u}; \
                if (rr < 0) { if (!first_) v = *(const u32x4*)(HALO + ((size_t)(cid_ - 1) * 3 + (rr + 3)) * 3072 + col_); } \
                else if (rr > 63) { if (!last_) v = *(const u32x4*)(HALO + ((size_t)(cid_ + 1) * 3 + 0) * 3072 + col_); } \
                else v = *(const u32x4*)(PQ + (size_t)(tok0_ + rr) * 3072 + col_); \
                raw[q] = v; } } \
        else { const int d_ = F.wave - 6, jj_ = d_ ? 63 - F.lane : F.lane; const float* ab_ = AB + (size_t)(tok0_ + jj_) * 32; abA = ab_[(2 * d_) * 8 + h_]; abB = ab_[(2 * d_ + 1) * 8 + h_]; } } while (0)
    if (F.bid < NCID * NH) C1_LOAD(F.bid);
    for (int unit = F.bid; unit < NCID * NH; unit += F.G) {
        const int cid = unit >> 3, h = unit & 7;
        const int tok0 = cid * 64;
        u32x4 res[8];
        const int col = which * 1024 + h * 128 + 8 * l16;
        if (F.wave < 6) {
            f32x4 w0[4], w1[4];
#pragma unroll
            for (int k = 0; k < 4; ++k) { w0[k] = *(const f32x4*)(p.in[12] + k * 3072 + col); w1[k] = *(const f32x4*)(p.in[12] + k * 3072 + col + 4); }
#pragma unroll
            for (int j = 0; j < 8; ++j) { float o[8];
#pragma unroll
                for (int e = 0; e < 8; ++e) o[e] = 0.f;
#pragma unroll
                for (int k = 0; k < 4; ++k) { const u32x4 rw = raw[j + k];
                    o[0] += bflo(rw.x) * w0[k].x; o[1] += bfhi(rw.x) * w0[k].y; o[2] += bflo(rw.y) * w0[k].z; o[3] += bfhi(rw.y) * w0[k].w;
                    o[4] += bflo(rw.z) * w1[k].x; o[5] += bfhi(rw.z) * w1[k].y; o[6] += bflo(rw.w) * w1[k].z; o[7] += bfhi(rw.w) * w1[k].w; }
                float ss = 0.f;
#pragma unroll
                for (int e = 0; e < 8; ++e) { o[e] = siluf(o[e]); ss += o[e] * o[e]; }
                ss += __shfl_xor(ss, 1); ss += __shfl_xor(ss, 2); ss += __shfl_xor(ss, 4); ss += __shfl_xor(ss, 8);
                float sc = 1.f;
                if (which == 0) sc = rsqrtf(ss + EPS) * 0.08838834764831845f; else if (which == 1) sc = rsqrtf(ss + EPS);
                u32x4 w; w.x = pk2(o[0] * sc, o[1] * sc); w.y = pk2(o[2] * sc, o[3] * sc); w.z = pk2(o[4] * sc, o[5] * sc); w.w = pk2(o[6] * sc, o[7] * sc);
                res[j] = w;
                if (which < 2) *(LAS u32x4*)((which == 0 ? qs : ks) + (8 * ro + j) * RS + l16 * 16) = w; }
        } else { const int d = F.wave - 6;
            const float a = abA, bb = abB;
            const float g = -__expf(p.in[13][d * 8 + h]) * softplusf_(a + p.in[14][d * 8 + h]); const float be = sigmoidf_(bb);
            float gc = g;
#pragma unroll
            for (int o = 1; o < 64; o <<= 1) { const float up = __shfl_up(gc, o); if (F.lane >= o) gc += up; }
            gcs[d * 64 + F.lane] = gc; bes[d * 64 + F.lane] = be;
            const float eg = __expf(gc), glast = __shfl(gc, 63);
            float* gp = GCB + ((size_t)unit * 2 + d) * 256; gp[F.lane] = be; gp[64 + F.lane] = be * eg; gp[128 + F.lane] = eg; gp[192 + F.lane] = __expf(glast - gc); }
        __syncthreads();
        if (unit + F.G < NCID * NH) C1_LOAD(unit + F.G);
        if (F.wave < 6) {
#pragma unroll
            for (int j = 0; j < 8; ++j) *(u32x4*)(PQ + (size_t)(tok0 + 8 * ro + j) * 3072 + col) = res[j]; }
#pragma unroll
        for (int tt = 0; tt < 2; ++tt) { const int ti = 2 * F.wave + tt, mt = ti >> 2, nt = ti & 3;
            f32x4 ak = {0.f, 0.f, 0.f, 0.f}, aq = {0.f, 0.f, 0.f, 0.f};
#pragma unroll
            for (int kk = 0; kk < 4; ++kk) { const int ko = (32 * kk + 8 * fq) * 2;
                const bf16x8 bfr = lds_frag(ks, (16 * nt + fr) * RS + ko), akf = lds_frag(ks, (16 * mt + fr) * RS + ko), aqf = lds_frag(qs, (16 * mt + fr) * RS + ko);
                ak = __builtin_amdgcn_mfma_f32_16x16x32_bf16(akf, bfr, ak, 0, 0, 0); aq = __builtin_amdgcn_mfma_f32_16x16x32_bf16(aqf, bfr, aq, 0, 0, 0); }
#pragma unroll
            for (int r = 0; r < 4; ++r) { KKs[(16 * mt + 4 * fq + r) * 68 + 16 * nt + fr] = ak[r]; QKs[(16 * mt + 4 * fq + r) * 68 + 16 * nt + fr] = aq[r]; } }
        __syncthreads();
#pragma unroll
        for (int itr = 0; itr < 2; ++itr) { const int idx = (F.tid + NTHR * itr) * 4, i1 = idx >> 6, i2b = idx & 63; f32x4 v;
#pragma unroll
            for (int e = 0; e < 4; ++e) { const int i2 = i2b + e; float x = 0.f;
                if (i2 < i1) x = bes[i1] * KKs[i1 * 68 + i2] * __expf(gcs[i1] - gcs[i2]);
                else if (i2 > i1) { const int j1 = 63 - i1, j2 = 63 - i2; x = bes[64 + j1] * KKs[i1 * 68 + i2] * __expf(gcs[64 + j1] - gcs[64 + j2]); }
                v[e] = x; }
            *(f32x4*)(LM + (size_t)unit * 4096 + idx) = v; }
#pragma unroll
        for (int itr = 0; itr < 2; ++itr) { const int idx = (F.tid + NTHR * itr) * 8, d = idx >> 12, j1 = (idx >> 6) & 63, jb = idx & 63;
            const int t1 = d ? 63 - j1 : j1; float x[8];
#pragma unroll
            for (int e = 0; e < 8; ++e) { const int j2 = jb + e; x[e] = 0.f;
                if (j2 <= j1) { const int t2 = d ? 63 - j2 : j2; x[e] = QKs[t1 * 68 + t2] * __expf(gcs[d * 64 + j1] - gcs[d * 64 + j2]); } }
            u32x4 w; w.x = pk2(x[0], x[1]); w.y = pk2(x[2], x[3]); w.z = pk2(x[4], x[5]); w.w = pk2(x[6], x[7]);
            *(u32x4*)(PM + ((size_t)unit * 2 + d) * 4096 + j1 * 64 + jb) = w; }
        __syncthreads();
    }
#undef C1_LOAD
}

DI void p9_c1b(const Frame& F) {
    const float* LM = (const float*)(F.ws + WS_LM); bf16* TM = (bf16*)(F.ws + WS_TM);
    LAS float* Ls = (LAS float*)(F.lds);
    for (int k0 = 0; F.bid + k0 * F.G < NCID * NH; k0 += 4) {
        {
            f32x4 lv[8];
#pragma unroll
            for (int itr = 0; itr < 8; ++itr) { const int uqs = itr >> 1, un = F.bid + (k0 + uqs) * F.G;
                lv[itr] = un < NCID * NH ? *(const f32x4*)(LM + (size_t)un * 4096 + (size_t)(F.tid + NTHR * (itr & 1)) * 4) : (f32x4){0.f, 0.f, 0.f, 0.f}; }
#pragma unroll
            for (int itr = 0; itr < 8; ++itr) { const int uq = itr >> 1, e0 = (F.tid + NTHR * (itr & 1)) * 4, i1 = e0 >> 6;
#pragma unroll
                for (int e = 0; e < 4; ++e) { const int i2 = (e0 & 63) + e; const float v = lv[itr][e];
                    if (i2 < i1) Ls[((uq * 2 + 0) * 64 + i1) * 64 + i2] = v; else if (i2 > i1) Ls[((uq * 2 + 1) * 64 + (63 - i1)) * 64 + (63 - i2)] = v; } }
        }
        __syncthreads();
        {
            const int uq = F.wave >> 1, d = F.wave & 1, c = F.lane;
            LAS float* L = Ls + (uq * 2 + d) * 4096;
            float Tc[64];
            Tc[0] = (c == 0) ? 1.f : 0.f;
#pragma unroll
            for (int i = 1; i < 64; ++i) {
                f32x4 lr[16];
#pragma unroll
                for (int q = 0; q < (i + 3) / 4; ++q) lr[q] = *(const LAS f32x4*)(L + i * 64 + 4 * q);
                float a0 = (c == i) ? 1.f : 0.f, a1 = 0.f, a2 = 0.f, a3 = 0.f;
#pragma unroll
                for (int q = 0; q < (i + 3) / 4; ++q) { const f32x4 l4 = lr[q]; const int j4 = 4 * q;
                    a0 -= l4.x * Tc[j4];
                    if (j4 + 1 < i) a1 -= l4.y * Tc[j4 + 1];
                    if (j4 + 2 < i) a2 -= l4.z * Tc[j4 + 2];
                    if (j4 + 3 < i) a3 -= l4.w * Tc[j4 + 3]; }
                Tc[i] = (a0 + a1) + (a2 + a3);
            }
            LAS unsigned short* Tl = (LAS unsigned short*)L;
#pragma unroll
            for (int i = 0; i < 64; ++i) Tl[i * 64 + c] = (unsigned short)f2bf(Tc[i]);
            asm volatile("s_waitcnt lgkmcnt(0)" ::: "memory");
            const int un = F.bid + (k0 + uq) * F.G;
            if (un < NCID * NH) { bf16* dst = TM + ((size_t)un * 2 + d) * 4096;
#pragma unroll
                for (int q = 0; q < 8; ++q) *(u32x4*)(dst + (size_t)(q * 64 + c) * 8) = *(const LAS u32x4*)(Tl + (q * 64 + c) * 8); }
        }
        __syncthreads();
    }
}

typedef short s16x4 __attribute__((ext_vector_type(4)));
constexpr int SB_K = 0, SB_Q = 16384, SB_T = 32768, SB_P = 40960, SB_V = 49152, SB_G = 53248, SB_SIZE = 54272;
constexpr int SW_SBT = 2 * SB_SIZE, SW_XT = SW_SBT + 8704, SW_VNT = SW_XT + 4608, SW_VDT = SW_VNT + 4608;
static_assert(SW_VDT + 4608 <= LDS_MISC, "scan LDS map");
DI unsigned offb(unsigned row, unsigned ch) { return 256u * row + 16u * (ch ^ (((row & 3u) << 2) | ((row >> 2) & 3u))); }
DI unsigned offt(unsigned row, unsigned ch) { return 128u * row + 16u * (ch ^ ((row >> 1) & 7u)); }
#define SC_GLDS(src, ldsoff) __builtin_amdgcn_global_load_lds((const unsigned*)(src), (LAS unsigned*)(F.lds + (ldsoff)), 16, 0, 0)
#define SC_LBAR() do { asm volatile("s_waitcnt lgkmcnt(0)" ::: "memory"); __builtin_amdgcn_s_barrier(); asm volatile("" ::: "memory"); } while (0)
DI void scan_chunk(int s, int b, int d, int& cid, int& outp) {
    if (s < 4) { const int cc = d ? 3 - s : s; cid = 512 + b * 4 + cc; outp = 0; } else { const int c2 = s - 4, cc = d ? 127 - c2 : c2; cid = b * 128 + cc; outp = 1; }
}
DI void scan_issue(const Frame& F, int buf, int s, int b, int h, int d, int v0) {
    const unsigned char* PQ = F.ws + WS_PQKV; const float* GCB = (const float*)(F.ws + WS_GCB);
    int cid, outp; scan_chunk(s, b, d, cid, outp);
    const int tok0 = cid * 64, w = F.wave, L = F.lane, bo = buf * SB_SIZE;
    const size_t mb = ((size_t)(cid * 8 + h) * 2 + d);
    const unsigned char* TMb = F.ws + WS_TM + mb * 8192; const unsigned char* PMb = F.ws + WS_PM + mb * 8192;
#pragma unroll
    for (int ii = 0; ii < 2; ++ii) { const int i = 2 * w + ii, row = 4 * i + (L >> 4), slot = L & 15, ch = slot ^ (((row & 3) << 2) | ((row >> 2) & 3)), tok = tok0 + (d ? 63 - row : row);
        const unsigned off = (unsigned)tok * 6144u + (unsigned)(h * 256 + ch * 16);
        SC_GLDS(PQ + 2048 + off, bo + SB_K + i * 1024); if (outp) SC_GLDS(PQ + off, bo + SB_Q + i * 1024); }
    { const int row = 8 * w + (L >> 3), slot = L & 7, ch = slot ^ ((row >> 1) & 7); const unsigned off = (unsigned)(row * 128 + ch * 16);
        SC_GLDS(TMb + off, bo + SB_T + w * 1024); if (outp) SC_GLDS(PMb + off, bo + SB_P + w * 1024); }
    if (w < 4) { const int row = 16 * w + (L >> 2), c = L & 3, tok = tok0 + (d ? 63 - row : row);
        SC_GLDS(PQ + 4096 + ((unsigned)tok * 6144u + (unsigned)(h * 256 + v0 * 2 + 16 * c)), bo + SB_V + w * 1024); }
    else if (w == 4) SC_GLDS(GCB + mb * 256 + L * 4, bo + SB_G);
}
DI void scan_step(const Frame& F, int buf, int s, int b, int h, int d, int v0, f32x4 (&Sacc)[2], int mt, int nt, int fr, int fq) {
    LAS unsigned char* L = F.lds; LAS unsigned char* B = F.lds + buf * SB_SIZE;
    bf16* OD = (bf16*)(F.ws + WS_O) + (size_t)d * TL * D;
    int cid, outp; scan_chunk(s, b, d, cid, outp);
    const int tok0 = cid * 64;
    f32x4 aX = {0.f, 0.f, 0.f, 0.f}, aO = {0.f, 0.f, 0.f, 0.f};
#pragma unroll
    for (int ks = 0; ks < 4; ++ks) { const bf16x8 sb = *(const LAS bf16x8*)(L + SW_SBT + (16 * nt + fr) * 272 + (32 * ks + 8 * fq) * 2);
        const bf16x8 kA = *(const LAS bf16x8*)(B + SB_K + offb(16 * mt + fr, 4 * ks + fq));
        aX = __builtin_amdgcn_mfma_f32_16x16x32_bf16(kA, sb, aX, 0, 0, 0);
        if (outp) { const bf16x8 qA = *(const LAS bf16x8*)(B + SB_Q + offb(16 * mt + fr, 4 * ks + fq)); aO = __builtin_amdgcn_mfma_f32_16x16x32_bf16(qA, sb, aO, 0, 0, 0); } }
    const LAS unsigned char* Gr = B + SB_G + (16 * mt + 4 * fq) * 4;
    const f32x4 be = *(const LAS f32x4*)Gr, s1 = *(const LAS f32x4*)(Gr + 256), eg = *(const LAS f32x4*)(Gr + 512), dr = *(const LAS f32x4*)(Gr + 768);
    float x[4];
#pragma unroll
    for (int r = 0; r < 4; ++r) { const float vv = bf2f(*(const LAS unsigned short*)(B + SB_V + (16 * mt + 4 * fq + r) * 64 + (16 * nt + fr) * 2));
        x[r] = vv * be[r] - s1[r] * aX[r]; aO[r] *= eg[r]; }
    { u32x2 w; w.x = pk2(x[0], x[1]); w.y = pk2(x[2], x[3]); *(LAS u32x2*)(L + SW_XT + (16 * nt + fr) * 144 + (16 * mt + 4 * fq) * 2) = w; }
    SC_LBAR();
    f32x4 aV = {0.f, 0.f, 0.f, 0.f};
#pragma unroll
    for (int ks = 0; ks < 2; ++ks) { const bf16x8 xb = *(const LAS bf16x8*)(L + SW_XT + (16 * nt + fr) * 144 + (32 * ks + 8 * fq) * 2);
        const bf16x8 tA = *(const LAS bf16x8*)(B + SB_T + offt(16 * mt + fr, 4 * ks + fq));
        aV = __builtin_amdgcn_mfma_f32_16x16x32_bf16(tA, xb, aV, 0, 0, 0); }
    { u32x2 w; w.x = pk2(aV[0], aV[1]); w.y = pk2(aV[2], aV[3]); *(LAS u32x2*)(L + SW_VNT + (16 * nt + fr) * 144 + (16 * mt + 4 * fq) * 2) = w;
      w.x = pk2(aV[0] * dr[0], aV[1] * dr[1]); w.y = pk2(aV[2] * dr[2], aV[3] * dr[3]); *(LAS u32x2*)(L + SW_VDT + (16 * nt + fr) * 144 + (16 * mt + 4 * fq) * 2) = w; }
    SC_LBAR();
    const float decay = *(const LAS float*)(B + SB_G + 512 + 63 * 4);
    const int w8 = 2 * mt + nt;
    bf16x8 kt[2];
    { const unsigned q4 = (unsigned)fr >> 2, p4 = (unsigned)fr & 3u, kb = (unsigned)(size_t)(B + SB_K) + 8u * (p4 & 1u);
      const unsigned a00 = kb + offb(8 * fq + 0 + q4, 2 * w8 + (p4 >> 1)), a01 = kb + offb(8 * fq + 4 + q4, 2 * w8 + (p4 >> 1));
      const unsigned a10 = kb + offb(32 + 8 * fq + 0 + q4, 2 * w8 + (p4 >> 1)), a11 = kb + offb(32 + 8 * fq + 4 + q4, 2 * w8 + (p4 >> 1));
      s16x4 t00, t01, t10, t11;
      asm volatile("ds_read_b64_tr_b16 %0, %4\n\tds_read_b64_tr_b16 %1, %5\n\tds_read_b64_tr_b16 %2, %6\n\tds_read_b64_tr_b16 %3, %7\n\ts_waitcnt lgkmcnt(0)"
                   : "=&v"(t00), "=&v"(t01), "=&v"(t10), "=&v"(t11) : "v"(a00), "v"(a01), "v"(a10), "v"(a11) : "memory");
      kt[0] = (bf16x8){t00[0], t00[1], t00[2], t00[3], t01[0], t01[1], t01[2], t01[3]};
      kt[1] = (bf16x8){t10[0], t10[1], t10[2], t10[3], t11[0], t11[1], t11[2], t11[3]}; }
#pragma unroll
    for (int n = 0; n < 2; ++n) { Sacc[n] = Sacc[n] * decay;
#pragma unroll
        for (int ks = 0; ks < 2; ++ks) { const bf16x8 vd = *(const LAS bf16x8*)(L + SW_VDT + (16 * n + fr) * 144 + (32 * ks + 8 * fq) * 2);
            Sacc[n] = __builtin_amdgcn_mfma_f32_16x16x32_bf16(kt[ks], vd, Sacc[n], 0, 0, 0); } }
    if (outp) {
#pragma unroll
        for (int ks = 0; ks < 2; ++ks) { const bf16x8 vn = *(const LAS bf16x8*)(L + SW_VNT + (16 * nt + fr) * 144 + (32 * ks + 8 * fq) * 2);
            const bf16x8 pA = *(const LAS bf16x8*)(B + SB_P + offt(16 * mt + fr, 4 * ks + fq));
            aO = __builtin_amdgcn_mfma_f32_16x16x32_bf16(pA, vn, aO, 0, 0, 0); }
    }
#pragma unroll
    for (int n = 0; n < 2; ++n) { u32x2 w; w.x = pk2(Sacc[n][0], Sacc[n][1]); w.y = pk2(Sacc[n][2], Sacc[n][3]);
        *(LAS u32x2*)(L + SW_SBT + (16 * n + fr) * 272 + (16 * w8 + 4 * fq) * 2) = w; }
    if (outp) {
#pragma unroll
        for (int r = 0; r < 4; ++r) { const int jc = 16 * mt + 4 * fq + r, tc = tok0 + (d ? 63 - jc : jc);
            OD[(size_t)tc * D + h * 128 + v0 + 16 * nt + fr] = (bf16)f2bf(aO[r]); }
        asm volatile("s_waitcnt vmcnt(4)" ::: "memory");
    } else asm volatile("s_waitcnt vmcnt(0)" ::: "memory");
    SC_LBAR();
}
DI void p10_scan(const Frame& F) {
    const int mt = F.wave >> 1, nt = F.wave & 1, fr = F.lane & 15, fq = F.lane >> 4;
    for (int u0 = F.bid; u0 < 256; u0 += F.G) {
        const int xcd = u0 & 7, qq = u0 >> 3, sl = qq & 3, chain = xcd + 8 * (qq >> 2);
        const int d = chain & 1, h = (chain >> 1) & 7, b = chain >> 4, v0 = sl * 32;
        for (int i = F.tid; i < 8704 / 4; i += NTHR) ((LAS unsigned*)(F.lds + SW_SBT))[i] = 0u;
        f32x4 Sacc[2] = {{0.f, 0.f, 0.f, 0.f}, {0.f, 0.f, 0.f, 0.f}};
        scan_issue(F, 0, 0, b, h, d, v0);
        asm volatile("s_waitcnt vmcnt(0)" ::: "memory");
        SC_LBAR();
        for (int s = 0; s < 132; ++s) {
            if (s + 1 < 132) scan_issue(F, (s + 1) & 1, s + 1, b, h, d, v0);
            scan_step(F, s & 1, s, b, h, d, v0, Sacc, mt, nt, fr, fq);
        }
    }
}

DI void p11_onorm(const Frame& F, const KP& p) {
    const int gw = F.bid * NWAVES + F.wave, NGW = F.G * NWAVES;
    const bf16* O0 = (const bf16*)(F.ws + WS_O); const bf16* O1 = O0 + (size_t)TL * D; const bf16* Z = (const bf16*)(F.ws + WS_Z); bf16* HX = (bf16*)(F.ws + WS_HX);
    for (int t = gw; t < TL; t += NGW) {
        const int c = 16 * F.lane;
        float o[16], zz[16]; float ss = 0.f;
#pragma unroll
        for (int q = 0; q < 2; ++q) { const u32x4 a = *(const u32x4*)(O0 + (size_t)t * D + c + 8 * q), bq = *(const u32x4*)(O1 + (size_t)t * D + c + 8 * q), zq = *(const u32x4*)(Z + (size_t)t * D + c + 8 * q);
            o[8 * q + 0] = bflo(a.x) + bflo(bq.x); o[8 * q + 1] = bfhi(a.x) + bfhi(bq.x); o[8 * q + 2] = bflo(a.y) + bflo(bq.y); o[8 * q + 3] = bfhi(a.y) + bfhi(bq.y);
            o[8 * q + 4] = bflo(a.z) + bflo(bq.z); o[8 * q + 5] = bfhi(a.z) + bfhi(bq.z); o[8 * q + 6] = bflo(a.w) + bflo(bq.w); o[8 * q + 7] = bfhi(a.w) + bfhi(bq.w);
            zz[8 * q + 0] = bflo(zq.x); zz[8 * q + 1] = bfhi(zq.x); zz[8 * q + 2] = bflo(zq.y); zz[8 * q + 3] = bfhi(zq.y); zz[8 * q + 4] = bflo(zq.z); zz[8 * q + 5] = bfhi(zq.z); zz[8 * q + 6] = bflo(zq.w); zz[8 * q + 7] = bfhi(zq.w); }
#pragma unroll
        for (int e = 0; e < 16; ++e) ss += o[e] * o[e];
        ss += __shfl_xor(ss, 1); ss += __shfl_xor(ss, 2); ss += __shfl_xor(ss, 4);
        const float rs = rsqrtf(ss * (1.f / 128.f) + EPS);
        const float* nw = p.in[15] + (c & 127);
        unsigned w[8];
#pragma unroll
        for (int e = 0; e < 8; ++e) w[e] = pk2(o[2 * e] * rs * nw[2 * e] * siluf(zz[2 * e]), o[2 * e + 1] * rs * nw[2 * e + 1] * siluf(zz[2 * e + 1]));
        *(u32x4*)(HX + (size_t)t * D + c) = (u32x4){w[0], w[1], w[2], w[3]}; *(u32x4*)(HX + (size_t)t * D + c + 8) = (u32x4){w[4], w[5], w[6], w[7]};
    }
}

DI void p16_final(const Frame& F, const KP& p, const LAS int* tb) {
    const int gw = F.bid * NWAVES + F.wave, NGW = F.G * NWAVES;
    const bf16* Y = (const bf16*)(F.ws + WS_Y); const Entry* TI = (const Entry*)(F.ws + WS_TI);
    for (int t = gw; t < TL; t += NGW) {
        const int r = t >> 13; float* xr = F.out + (size_t)t * D; const bf16* xi16 = (const bf16*)(F.ws + WS_XS3) + (size_t)t * D;
        const Entry ta = TI[(size_t)2 * t], tbb = TI[(size_t)2 * t + 1]; const float w0 = ta.w, w1 = tbb.w;
        const size_t r0 = ((size_t)tb[ta.ts >> 16] * 256 + (ta.ts & 0xffff)) * D, r1 = ((size_t)tb[tbb.ts >> 16] * 256 + (tbb.ts & 0xffff)) * D;
        f32x4 va[2], vb[2]; u32x4 y0[2], y1[2]; float s = 0.f;
#pragma unroll
        for (int i = 0; i < 2; ++i) { const int c = 8 * F.lane + 512 * i; unpk8(*(const u32x4*)(xi16 + c), va[i], vb[i]); y0[i] = *(const u32x4*)(Y + r0 + c); y1[i] = *(const u32x4*)(Y + r1 + c); }
#pragma unroll
        for (int i = 0; i < 2; ++i) { const int c = 8 * F.lane + 512 * i; f32x4 a0, b0, a1, b1; unpk8(y0[i], a0, b0); unpk8(y1[i], a1, b1);
            const float* gp = modp(F, 1, r, 5) + c;
            va[i] = va[i] + *(const f32x4*)gp * (a0 * w0 + a1 * w1); vb[i] = vb[i] + *(const f32x4*)(gp + 4) * (b0 * w0 + b1 * w1);
            s += (va[i].x * va[i].x + va[i].y * va[i].y) + (va[i].z * va[i].z + va[i].w * va[i].w) + (vb[i].x * vb[i].x + vb[i].y * vb[i].y) + (vb[i].z * vb[i].z + vb[i].w * vb[i].w); }
        const float rstd = rsqrtf(wave_sum(s) * (1.f / D) + EPS);
#pragma unroll
        for (int i = 0; i < 2; ++i) { const int c = 8 * F.lane + 512 * i; *(f32x4*)(xr + c) = va[i] * rstd * *(const f32x4*)(p.in[24] + c); *(f32x4*)(xr + c + 4) = vb[i] * rstd * *(const f32x4*)(p.in[24] + c + 4); }
    }
}

__global__ void __launch_bounds__(NTHR, 2) fwd_kernel(KP kp) {
    extern __shared__ __attribute__((aligned(16))) unsigned char lds_raw[];
    Frame F;
    F.lds = (LAS unsigned char*)lds_raw; F.tid = threadIdx.x; F.lane = F.tid & 63; F.wave = __builtin_amdgcn_readfirstlane(F.tid >> 6);
    F.bid = blockIdx.x; F.G = gridDim.x; F.ws = kp.ws; F.out = kp.out;
    volatile LAS unsigned* misc = (volatile LAS unsigned*)(F.lds + LDS_MISC);
    if (F.tid < 4) misc[F.tid] = 0u;
    __syncthreads();
    const int lo = kp.ph_lo, hi = kp.ph_hi;
    XcdBarrier bar; bar.bar = (unsigned*)(F.ws + WS_CTL) + CW_BAR; bar.x = 0; bar.st = misc;
    if (hi - lo > 1) bar = xcd_barrier_post((unsigned*)(F.ws + WS_CTL) + CW_BAR, misc);
#ifndef PHSEL
#define PHSEL 0x1FFFF
#endif
#define IN(k) (((PHSEL >> (k)) & 1) && lo <= (k) && (k) < hi)
#define SEAM(k) do { if (IN(k) && IN((k) + 1)) xcd_barrier(bar); } while (0)
    LAS int* tb = (LAS int*)(F.lds + LDS_MISC + 64); LAS int* cn = (LAS int*)(F.lds + LDS_MISC + 64 + 256);
    const float* MOD = (const float*)(F.ws + WS_MOD);

    if (IN(0)) { p0_prologue(F, kp); } SEAM(0);
    if (IN(1)) { p1_pool_diff(F, kp); __syncthreads(); convert_experts(F, kp, 0); } SEAM(1);
    if (IN(2)) { pg8::Gemm g{(const bf16*)(F.ws + WS_DD), (const bf16*)(F.ws + WS_BTP), 256}; PoolOrder S{F.G, F.bid};
        EpiRaw E{(bf16*)(F.ws + WS_YP), 1};
        pg8::gemm_phase<EpiRaw, PoolOrder, false>(F.lds, g, S, E); } SEAM(2);
    if (IN(3)) { p_router(F, kp, 0, T); } SEAM(3);
    if (IN(4)) { moe_tables(F, 0, tb, cn);
        pg8::Gemm g{(const bf16*)(F.ws + WS_HX), (const bf16*)(F.ws + WS_GU), 1024}; MoeOrder S{F.G, F.bid, tb[NE], tb, cn, (const Entry*)(F.ws + WS_ENT)};
        EpiGU E{(bf16*)(F.ws + WS_HID)};
        pg8::gemm_phase<EpiGU, MoeOrder, true>(F.lds, g, S, E); } SEAM(4);
    if (IN(5)) { moe_tables(F, 0, tb, cn);
        pg8::Gemm g{(const bf16*)(F.ws + WS_HID), (const bf16*)(F.ws + WS_DN), 512}; MoeOrder S{F.G, F.bid, tb[NE], tb, cn, (const Entry*)(F.ws + WS_ENT)};
        EpiDown E{(bf16*)(F.ws + WS_Y)};
        pg8::gemm_phase<EpiDown, MoeOrder, false>(F.lds, g, S, E); } SEAM(5);
    if (IN(6)) { moe_tables(F, 0, tb, cn); p6_n1(F, kp, tb); } SEAM(6);
    if (IN(7)) { pg8::Gemm g{(const bf16*)(F.ws + WS_HX), (const bf16*)(F.ws + WS_BTIN), 1024}; G1Order S{F.G, F.bid};
        EpiG1 E{(bf16*)(F.ws + WS_PQKV), (bf16*)(F.ws + WS_Z), (bf16*)(F.ws + WS_HALO), (float*)(F.ws + WS_AB)};
        pg8::gemm_phase<EpiG1, G1Order, false>(F.lds, g, S, E); } SEAM(7);
    if (IN(8)) { p8_c1a(F, kp); asm volatile("s_waitcnt vmcnt(0)" ::: "memory"); __syncthreads(); }
#ifdef PROBE_K
    SEAM(8);
#endif
    if (IN(9)) { p9_c1b(F); } SEAM(9);
    if (IN(10)) { p10_scan(F); } SEAM(10);
    if (IN(11)) { p11_onorm(F, kp); convert_experts(F, kp, 1); } SEAM(11);
    if (IN(12)) { pg8::Gemm g{(const bf16*)(F.ws + WS_HX), (const bf16*)(F.ws + WS_BTOUT), 1024}; G2Order S{F.G, F.bid};
        EpiRaw E{(bf16*)(F.ws + WS_Y2), 0};
        pg8::gemm_phase<EpiRaw, G2Order, false>(F.lds, g, S, E); } SEAM(12);
    if (IN(13)) { p_router(F, kp, 1, TL); } SEAM(13);
    if (IN(14)) { moe_tables(F, 1, tb, cn);
        pg8::Gemm g{(const bf16*)(F.ws + WS_HX), (const bf16*)(F.ws + WS_GU), 1024}; MoeOrder S{F.G, F.bid, tb[NE], tb, cn, (const Entry*)(F.ws + WS_ENT)};
        EpiGU E{(bf16*)(F.ws + WS_HID)};
        pg8::gemm_phase<EpiGU, MoeOrder, true>(F.lds, g, S, E); } SEAM(14);
    if (IN(15)) { moe_tables(F, 1, tb, cn);
        pg8::Gemm g{(const bf16*)(F.ws + WS_HID), (const bf16*)(F.ws + WS_DN), 512}; MoeOrder S{F.G, F.bid, tb[NE], tb, cn, (const Entry*)(F.ws + WS_ENT)};
        EpiDown E{(bf16*)(F.ws + WS_Y)};
        pg8::gemm_phase<EpiDown, MoeOrder, false>(F.lds, g, S, E); } SEAM(15);
    if (IN(16)) { moe_tables(F, 1, tb, cn); p16_final(F, kp, tb); }
#undef IN
#undef SEAM
}

extern "C" void kernel_launch(void* const* d_in, const int* in_sizes, int n_in, void* d_out, int out_size, void* d_ws, size_t ws_size, hipStream_t stream) {
    static int grid = 0;
    if (grid == 0) {
        if (n_in != 25 || out_size != TL * D || ws_size < WS_END) { fprintf(stderr, "kernel_launch: unexpected shapes (n_in %d, out %d, ws %zu < %zu)\n", n_in, out_size, ws_size, (size_t)WS_END); grid = -1; return; }
        int dev = 0, cus = 0, per_cu = 0;
        if (hipGetDevice(&dev) != hipSuccess || hipDeviceGetAttribute(&cus, hipDeviceAttributeMultiprocessorCount, dev) != hipSuccess) { grid = -1; return; }
        if (hipFuncSetAttribute((const void*)fwd_kernel, hipFuncAttributeMaxDynamicSharedMemorySize, LDS_BYTES) != hipSuccess) { fprintf(stderr, "kernel_launch: hipFuncSetAttribute failed\n"); grid = -1; return; }
        if (hipOccupancyMaxActiveBlocksPerMultiprocessor(&per_cu, (const void*)fwd_kernel, NTHR, LDS_BYTES) != hipSuccess || per_cu < 1) fprintf(stderr, "kernel_launch: occupancy query says %d\n", per_cu);
        (void)hipGetLastError();
        grid = cus;
    }
    if (grid < 0) return;
    (void)hipMemsetAsync((char*)d_ws + WS_CTL, 0, CTL_BYTES, stream);
    KP kp{};
    for (int i = 0; i < 25; ++i) kp.in[i] = (const float*)d_in[i];
    kp.out = (float*)d_out; kp.ws = (unsigned char*)d_ws;
#if MK_ONE_LAUNCH
    kp.ph_lo = 0; kp.ph_hi = PH_N;
    hipLaunchKernelGGL(fwd_kernel, dim3(grid), dim3(NTHR), LDS_BYTES, stream, kp);
#else
    for (int ph = 0; ph < PH_N; ++ph) { kp.ph_lo = ph; kp.ph_hi = ph + 1; hipLaunchKernelGGL(fwd_kernel, dim3(grid), dim3(NTHR), LDS_BYTES, stream, kp); }
#endif
}
```

```cpp
#include <hip/hip_runtime.h>
#include <cstdio>
#include <cstdint>

#ifndef MK_ONE_LAUNCH
#define MK_ONE_LAUNCH 1
#endif

#define GAS __attribute__((address_space(1)))
#define LAS __attribute__((address_space(3)))
typedef unsigned short bf16;
typedef short bf16x8 __attribute__((ext_vector_type(8)));
typedef short bf16x4 __attribute__((ext_vector_type(4)));
typedef float f32x4 __attribute__((ext_vector_type(4)));
typedef float f32x2 __attribute__((ext_vector_type(2)));
typedef unsigned u32x4 __attribute__((ext_vector_type(4)));
typedef unsigned u32x2 __attribute__((ext_vector_type(2)));
#define DI __device__ __forceinline__

constexpr int D = 1024, NB = 4, SEQ = 8192, CTXL = 256;
constexpr int TL = NB * SEQ;
constexpr int TC = NB * CTXL;
constexpr int T = TL + TC;
constexpr int NE = 32, DE = 512, NH = 8;
constexpr int NCID = 528;
constexpr int DN_IN = 4128;
constexpr float EPS = 1e-6f;
constexpr int CAP = T;
constexpr int NWAVES = 8, NTHR = 512;

constexpr size_t MiB = 1u << 20;
constexpr size_t WS_CTL = 0, CTL_BYTES = 1 * MiB;
constexpr size_t WS_BTP = 1 * MiB;
constexpr size_t WS_BTOUT = 1 * MiB + 512 * 1024;
constexpr size_t WS_BTIN = 3 * MiB + 512 * 1024;
constexpr size_t WS_MOD = 12 * MiB;
constexpr size_t WS_WRT = 12 * MiB + 256 * 1024;
constexpr size_t WS_WAB = 12 * MiB + 576 * 1024;
constexpr size_t WS_RSTD = 12 * MiB + 704 * 1024;
constexpr size_t WS_WR2 = 13 * MiB;
constexpr size_t WS_C0 = 13 * MiB + 512 * 1024;
constexpr size_t WS_XC = 14 * MiB;
constexpr size_t WS_TI = 18 * MiB;
constexpr size_t WS_GU = 20 * MiB;
constexpr size_t WS_DN = 84 * MiB;
constexpr size_t WS_TM = 20 * MiB;
constexpr size_t WS_AB = 86 * MiB;
constexpr size_t WS_HALO = 91 * MiB;
constexpr size_t WS_GCB = 101 * MiB;
constexpr size_t WS_HX = 116 * MiB;
constexpr size_t WS_PM = 116 * MiB;
constexpr size_t WS_XS1 = 182 * MiB;
constexpr size_t WS_XS3 = 472 * MiB;
constexpr size_t WS_DD = 182 * MiB;
constexpr size_t WS_YP = 248 * MiB;
constexpr size_t WS_Y2 = 380 * MiB;
constexpr size_t WS_HID = 248 * MiB;
constexpr size_t WS_Y = 322 * MiB;
constexpr size_t WS_PQKV = 182 * MiB;
constexpr size_t WS_Z = 380 * MiB;
constexpr size_t WS_LM = 444 * MiB;
constexpr size_t WS_O = 444 * MiB;
constexpr size_t WS_ENT = 572 * MiB;
constexpr size_t WS_END = 572 * MiB + (size_t)NE * CAP * 8;
static_assert(WS_END <= 581 * MiB, "ws map");
constexpr int CW_BAR = 4096;
constexpr int CW_CNT = 16384, CNT_STRIDE = 1024;
constexpr int LDS_BYTES = 147456;
constexpr int LDS_MISC = 139264;
constexpr int PH_N = 17;

struct Entry { int ts; float w; };
struct KP { const float* in[25]; float* out; unsigned char* ws; int ph_lo, ph_hi; };

typedef __bf16 hwbf2 __attribute__((ext_vector_type(2)));
DI unsigned f2bf(float f) { const __bf16 h = (__bf16)f; return (unsigned)__builtin_bit_cast(unsigned short, h); }
DI unsigned pk2(float lo, float hi) { const f32x2 v = {lo, hi}; const hwbf2 r = __builtin_convertvector(v, hwbf2); return __builtin_bit_cast(unsigned, r); }
DI float bflo(unsigned w) { return __builtin_bit_cast(float, w << 16); }
DI float bfhi(unsigned w) { return __builtin_bit_cast(float, w & 0xffff0000u); }
DI float bf2f(unsigned short b) { return __builtin_bit_cast(float, ((unsigned)b) << 16); }
DI void unpk8(const u32x4 q, f32x4& a, f32x4& b) { a = (f32x4){bflo(q.x), bfhi(q.x), bflo(q.y), bfhi(q.y)}; b = (f32x4){bflo(q.z), bfhi(q.z), bflo(q.w), bfhi(q.w)}; }
DI u32x4 pk8(const f32x4 a, const f32x4 b) { u32x4 q; q.x = pk2(a.x, a.y); q.y = pk2(a.z, a.w); q.z = pk2(b.x, b.y); q.w = pk2(b.z, b.w); return q; }
DI float wave_sum(float v) {
#pragma unroll
    for (int o = 1; o < 64; o <<= 1) v += __shfl_xor(v, o);
    return v;
}
DI float siluf(float x) { return x / (1.f + __expf(-x)); }
DI float sigmoidf_(float x) { return 1.f / (1.f + __expf(-x)); }
DI float softplusf_(float x) { return fmaxf(x, 0.f) + log1pf(__expf(-fabsf(x))); }

#define XB_TMO      128
#define XB_XCNT(j)  (256  + 64 * (j))
#define XB_XSUB(j)  (1280 + 64 * (j))
#define XB_XGEN(j)  (2304 + 64 * (j))
#define XB_TOP      3328
#define XB_TOPGEN   3392
#define XCD_BAR_WORDS 3456
#define XB_SPIN_CAP (1u << 18)
__device__ __forceinline__ unsigned xb_ld(unsigned* p)              { return __hip_atomic_load(p, __ATOMIC_RELAXED, __HIP_MEMORY_SCOPE_AGENT); }
__device__ __forceinline__ unsigned xb_add(unsigned* p, unsigned v) { return __hip_atomic_fetch_add(p, v, __ATOMIC_RELAXED, __HIP_MEMORY_SCOPE_AGENT); }
__device__ __forceinline__ unsigned xb_xcc_id() { return (unsigned)__builtin_amdgcn_s_getreg((3 << 11) | 20) & 0xFu; }
#define XB_SPIN(cond, bar) do { unsigned _sp = 0; while (cond) { __builtin_amdgcn_s_sleep(1); \
    if ((++_sp & 255u) == 0u) { if (xb_ld(&(bar)[XB_TMO])) break; if (_sp > XB_SPIN_CAP) { atomicAdd(&(bar)[XB_TMO], 1u); break; } } } } while (0)
struct XcdBarrier { unsigned* bar; unsigned x; volatile LAS unsigned* st; };
__device__ __forceinline__ XcdBarrier xcd_barrier_post(unsigned* bar, volatile LAS unsigned* st) {
    XcdBarrier b; b.bar = bar; b.x = xb_xcc_id(); b.st = st;
    if (threadIdx.x == 0) (void)xb_add(&bar[XB_XCNT(b.x)], 1u);
    return b;
}
__device__ __forceinline__ void xcd_barrier_complete(unsigned* bar, unsigned x, unsigned& nloc, unsigned& nx) {
    const unsigned G = gridDim.x * gridDim.y * gridDim.z;
    unsigned sum, cnt, mine, sp = 0u;
    for (;;) {
        sum = 0u; cnt = 0u; mine = 0u;
#pragma unroll
        for (unsigned j = 0; j < 16; ++j) { const unsigned c = xb_ld(&bar[XB_XCNT(j)]); sum += c; cnt += (c > 0u) ? 1u : 0u; mine = (j == x) ? c : mine; }
        if (sum == G) break;
        __builtin_amdgcn_s_sleep(1);
        if ((++sp & 255u) == 0u) { if (xb_ld(&bar[XB_TMO])) break; if (sp > XB_SPIN_CAP) { atomicAdd(&bar[XB_TMO], 1u); break; } }
    }
    nloc = mine > 0u ? mine : 1u; nx = cnt > 0u ? cnt : 1u;
}
__device__ __forceinline__ void xcd_barrier(const XcdBarrier& b) {
    asm volatile("s_waitcnt vmcnt(0)" ::: "memory");
    __syncthreads();
    if (threadIdx.x == 0) {
        unsigned* bar = b.bar;
        __builtin_amdgcn_s_waitcnt(0);
        unsigned nloc = b.st[0], nx = b.st[1];
        if (nloc == 0u) { xcd_barrier_complete(bar, b.x, nloc, nx); b.st[0] = nloc; b.st[1] = nx; }
        const unsigned old = xb_add(&bar[XB_XSUB(b.x)], 1u);
        const unsigned gen = old / nloc;
        if (old + 1u == (gen + 1u) * nloc) {
            __builtin_amdgcn_fence(__ATOMIC_RELEASE, "agent");
            asm volatile("s_waitcnt vmcnt(0)" ::: "memory");
            const unsigned og = xb_add(&bar[XB_TOP], 1u);
            const unsigned tg = og / nx;
            if (og + 1u == (tg + 1u) * nx) xb_add(&bar[XB_TOPGEN], 1u);
            else XB_SPIN(xb_ld(&bar[XB_TOPGEN]) == tg, bar);
            __builtin_amdgcn_fence(__ATOMIC_ACQUIRE, "agent");
            xb_add(&bar[XB_XGEN(b.x)], 1u);
            asm volatile("s_waitcnt vmcnt(0)" ::: "memory");
        } else {
            XB_SPIN(xb_ld(&bar[XB_XGEN(b.x)]) == gen, bar);
            __builtin_amdgcn_fence(__ATOMIC_ACQUIRE, "agent");
            asm volatile("s_waitcnt vmcnt(0)" ::: "memory");
        }
    }
    __syncthreads();
}

namespace pg8 {
constexpr int BM = 256, BK = 64, HALF = 128, HTB = HALF * BK * 2, STAGE_BYTES = 8 * HTB;
DI int lds_byte(int r, int c) { const int st = (r >> 4) * 2 + (c >> 5), rr = r & 15, cc = c & 31, ob = rr * 64 + cc * 2; return st * 1024 + (ob ^ (((ob >> 9) & 1) << 5)); }
DI void stage_rc(int b, int& R, int& C) { const int st = b / 1024, sb = b % 1024, swz = sb ^ (((sb >> 9) & 1) << 5); R = (st >> 1) * 16 + swz / 64; C = (st & 1) * 32 + (swz % 64) / 2; }
DI int perm32(int rho) { const int n = rho >> 4, i = rho & 15; return 8 * (i >> 2) + 4 * n + (i & 3); }
struct Unit { int pm, pn, e, rt, nvalid; };
struct Gemm { const bf16* A; const bf16* Bt; int K; };

template <class Epi, class Sched, bool GATHER>
DI void gemm_phase(LAS unsigned char* lds, const Gemm g, const Sched& S, const Epi& E) {
    const int tid = threadIdx.x, wid = __builtin_amdgcn_readfirstlane(tid >> 6), lane = tid & 63, wr = wid >> 2, wc = wid & 3, fr = lane & 15, fq = lane >> 4;
    const int K = g.K, nt = K / BK;
    unsigned voffA[2], voffB[2]; int Rr[2], Cc[2];
#pragma unroll
    for (int i = 0; i < 2; ++i) { int R, C; stage_rc(tid * 16 + i * 8192, R, C); const int Rb = Epi::PERM ? ((R & ~31) + perm32(R & 31)) : R;
        voffA[i] = (unsigned)(R * K + C) * 2u; voffB[i] = (unsigned)((Epi::PERM ? (64 * (R >> 5) + perm32(R & 31)) : Rb) * K + C) * 2u; Rr[i] = R; Cc[i] = C; }
    const size_t kstep = (size_t)(BK * 2);
    const size_t hstep = (size_t)HALF * K * 2;
    const size_t tstep = 2 * hstep;
    const size_t hstepB = Epi::PERM ? (size_t)32 * K * 2 : hstep;
    const unsigned ldsw = (unsigned)wid * 1024u;
    const int aoff = lds_byte(wr * 64 + fr, fq * 8), boff = lds_byte(wc * 32 + fr, fq * 8);
#define PG8_SA(b, h) (((b) * 2 + (h)) * HTB)
#define PG8_SB(b, h) ((4 + (b) * 2 + (h)) * HTB)
#define PG8_STAGE(bufoff, gbase, voff) do { _Pragma("unroll") for (int _i = 0; _i < 2; ++_i) \
        __builtin_amdgcn_global_load_lds((const unsigned*)((const char*)(gbase) + (voff)[_i]), (LAS unsigned*)(lds + (bufoff) + ldsw + _i * 8192), 16, 0, 0); } while (0)
#define PG8_STAGE_A(bufoff, ptr, offs, h, kb) do { _Pragma("unroll") for (int _i = 0; _i < 2; ++_i) { \
        const char* _src = GATHER ? ((const char*)g.A + (offs)[(h) * 2 + _i] + (kb)) : ((const char*)(ptr) + voffA[_i]); \
        __builtin_amdgcn_global_load_lds((const unsigned*)_src, (LAS unsigned*)(lds + (bufoff) + ldsw + _i * 8192), 16, 0, 0); } } while (0)
#define PG8_LDA(dst, b, h) do { _Pragma("unroll") for (int m = 0; m < 4; ++m) _Pragma("unroll") for (int k = 0; k < 2; ++k) dst[m][k] = *(const LAS bf16x8*)(lds + PG8_SA(b, h) + aoff + m * 2048 + k * 1024); } while (0)
#define PG8_LDB(dst, b, h) do { _Pragma("unroll") for (int n = 0; n < 2; ++n) _Pragma("unroll") for (int k = 0; k < 2; ++k) dst[n][k] = *(const LAS bf16x8*)(lds + PG8_SB(b, h) + boff + n * 2048 + k * 1024); } while (0)
#define PG8_MMA(ai, bj, At, Bt) do { __builtin_amdgcn_s_setprio(1); _Pragma("unroll") for (int m = 0; m < 4; ++m) _Pragma("unroll") for (int n = 0; n < 2; ++n) _Pragma("unroll") for (int k = 0; k < 2; ++k) \
        acc[ai][bj][m][n] = __builtin_amdgcn_mfma_f32_16x16x32_bf16(Bt[n][k], At[m][k], acc[ai][bj][m][n], 0, 0, 0); __builtin_amdgcn_s_setprio(0); } while (0)
#define PG8_WAIT_V(n) asm volatile("s_waitcnt vmcnt(" #n ")" ::: "memory")
#define PG8_WAIT_L(n) asm volatile("s_waitcnt lgkmcnt(" #n ")" ::: "memory")
#define PG8_BAR __builtin_amdgcn_s_barrier()
#define PG8_SCHED __builtin_amdgcn_sched_barrier(0)
#define PG8_OFFS(u, o) do { _Pragma("unroll") for (int _h = 0; _h < 2; ++_h) _Pragma("unroll") for (int _i = 0; _i < 2; ++_i) (o)[_h * 2 + _i] = S.row_off((u), _h * HALF + Rr[_i]) + (unsigned)Cc[_i] * 2u; } while (0)
    Unit cur, nxt; int ui = 0;
    if (!S.next(0, cur)) return;
    f32x4 acc[2][2][4][2];
#pragma unroll
    for (int a = 0; a < 2; ++a)
#pragma unroll
        for (int b = 0; b < 2; ++b)
#pragma unroll
            for (int m = 0; m < 4; ++m)
#pragma unroll
                for (int n = 0; n < 2; ++n) acc[a][b][m][n] = (f32x4){0.f, 0.f, 0.f, 0.f};
    bf16x8 At[4][2], B0[2][2], B1[2][2];
    unsigned oc[4] = {0u, 0u, 0u, 0u}, on[4] = {0u, 0u, 0u, 0u};
    const char* cA = GATHER ? (const char*)g.A : (const char*)g.A + (size_t)cur.pm * tstep; const char* cB = (const char*)g.Bt + (size_t)cur.pn * tstep;
    if (GATHER) PG8_OFFS(cur, oc);
    PG8_STAGE(PG8_SB(0, 0), cB, voffB); PG8_STAGE_A(PG8_SA(0, 0), cA, oc, 0, 0); PG8_STAGE(PG8_SB(0, 1), cB + hstepB, voffB); PG8_STAGE_A(PG8_SA(0, 1), cA + hstep, oc, 1, 0);
    if (wr == 1) PG8_BAR;
    PG8_WAIT_V(4); PG8_BAR;
    PG8_STAGE(PG8_SB(1, 0), cB + kstep, voffB); PG8_STAGE_A(PG8_SA(1, 0), cA + kstep, oc, 0, kstep); PG8_STAGE(PG8_SB(1, 1), cB + hstepB + kstep, voffB);
    PG8_WAIT_V(6); PG8_BAR;
    for (;;) {
        const bool has_next = S.next(ui + 1, nxt);
        const char* nA = GATHER ? cA : (has_next ? (const char*)g.A + (size_t)nxt.pm * tstep : cA); const char* nB = has_next ? (const char*)g.Bt + (size_t)nxt.pn * tstep : cB;
        if (GATHER) { if (has_next) PG8_OFFS(nxt, on); else {
#pragma unroll
            for (int q = 0; q < 4; ++q) on[q] = oc[q]; } }
        for (int t = 0; t < nt; t += 2) {
            const bool last = (t == nt - 2);
            const char* a1 = cA + (size_t)(t + 1) * kstep;
            const char* a2 = last ? nA : cA + (size_t)(t + 2) * kstep; const char* b2 = last ? nB : cB + (size_t)(t + 2) * kstep;
            const char* a3 = a2 + kstep; const char* b3 = b2 + kstep;
            const size_t k1 = (size_t)(t + 1) * kstep, k2 = last ? (size_t)0 : (size_t)(t + 2) * kstep, k3 = k2 + kstep;
            unsigned o2[4];
#pragma unroll
            for (int q = 0; q < 4; ++q) o2[q] = last ? on[q] : oc[q];
            PG8_LDB(B0, 0, 0); PG8_SCHED; PG8_LDA(At, 0, 0); PG8_STAGE_A(PG8_SA(1, 1), a1 + hstep, oc, 1, k1);
            PG8_WAIT_L(8); PG8_BAR; PG8_WAIT_L(0); PG8_MMA(0, 0, At, B0); PG8_BAR; PG8_SCHED;
            PG8_LDB(B1, 0, 1); PG8_STAGE(PG8_SB(0, 0), b2, voffB);
            PG8_BAR; PG8_WAIT_L(0); PG8_MMA(0, 1, At, B1); PG8_BAR;
            PG8_LDA(At, 0, 1); PG8_STAGE_A(PG8_SA(0, 0), a2, o2, 0, k2);
            PG8_BAR; PG8_WAIT_L(0); PG8_MMA(1, 0, At, B0); PG8_BAR; PG8_SCHED;
            PG8_STAGE(PG8_SB(0, 1), b2 + hstepB, voffB);
            PG8_WAIT_V(6); PG8_BAR; PG8_MMA(1, 1, At, B1); PG8_BAR;
            PG8_LDB(B0, 1, 0); PG8_SCHED; PG8_LDA(At, 1, 0); PG8_STAGE_A(PG8_SA(0, 1), a2 + hstep, o2, 1, k2);
            PG8_WAIT_L(8); PG8_BAR; PG8_WAIT_L(0); PG8_MMA(0, 0, At, B0); PG8_BAR; PG8_SCHED;
            PG8_LDB(B1, 1, 1); PG8_STAGE(PG8_SB(1, 0), b3, voffB);
            PG8_BAR; PG8_WAIT_L(0); PG8_MMA(0, 1, At, B1); PG8_BAR;
            PG8_LDA(At, 1, 1); PG8_STAGE_A(PG8_SA(1, 0), a3, o2, 0, k3);
            PG8_BAR; PG8_WAIT_L(0); PG8_MMA(1, 0, At, B0); PG8_BAR; PG8_SCHED;
            PG8_STAGE(PG8_SB(1, 1), b3 + hstepB, voffB);
            PG8_WAIT_V(6); PG8_BAR; PG8_MMA(1, 1, At, B1); PG8_BAR;
        }
        E(acc, cur, wr, wc, fr, fq);
        if (!has_next) break;
#pragma unroll
        for (int a = 0; a < 2; ++a)
#pragma unroll
            for (int b = 0; b < 2; ++b)
#pragma unroll
                for (int m = 0; m < 4; ++m)
#pragma unroll
                    for (int n = 0; n < 2; ++n) acc[a][b][m][n] = (f32x4){0.f, 0.f, 0.f, 0.f};
        cur = nxt; cA = nA; cB = nB; ++ui;
#pragma unroll
        for (int q = 0; q < 4; ++q) oc[q] = on[q];
    }
    PG8_WAIT_V(0);
    if (wr == 0) PG8_BAR;
    PG8_BAR;
#undef PG8_SA
#undef PG8_SB
#undef PG8_STAGE
#undef PG8_STAGE_A
#undef PG8_LDA
#undef PG8_LDB
#undef PG8_MMA
#undef PG8_WAIT_V
#undef PG8_WAIT_L
#undef PG8_BAR
#undef PG8_SCHED
#undef PG8_OFFS
}
}
using pg8::Unit;

struct Frame {
    LAS unsigned char* lds;
    int tid, lane, wave, bid, G;
    unsigned char* ws; float* out;
};
DI float* xs_row(const Frame& F, int t) { return t < TL ? F.out + (size_t)t * D : (float*)(F.ws + WS_XC) + (size_t)(t - TL) * D; }
DI int mod_row(int t) { return t < TL ? (t >> 13) : 4; }
DI const float* modp(const Frame& F, int l, int r, int chunk) { return (const float*)(F.ws + WS_MOD) + ((size_t)(l * 5 + r) * 6 + chunk) * D; }

DI void tr_item(const float* W, int N, int k0, int n0, bf16* WT, int K, int drow0, LAS float* scr, int lane) {
    float wv[32];
#pragma unroll
    for (int i = 0; i < 32; ++i) wv[i] = __builtin_nontemporal_load(W + (size_t)(k0 + 2 * i + (lane >> 5)) * N + n0 + (lane & 31));
#pragma unroll
    for (int i = 0; i < 32; ++i) scr[(2 * i + (lane >> 5)) * 33 + (lane & 31)] = wv[i];
    asm volatile("s_waitcnt lgkmcnt(0)" ::: "memory");
    const int c = lane & 7;
#pragma unroll
    for (int j = 0; j < 4; ++j) { const int n = (lane >> 3) + 8 * j; const LAS float* s = scr + (8 * c) * 33 + n;
        u32x4 o; o.x = pk2(s[0 * 33], s[1 * 33]); o.y = pk2(s[2 * 33], s[3 * 33]); o.z = pk2(s[4 * 33], s[5 * 33]); o.w = pk2(s[6 * 33], s[7 * 33]);
        *(u32x4*)(WT + (size_t)(drow0 + n) * K + k0 + 8 * c) = o; }
    asm volatile("s_waitcnt lgkmcnt(0)" ::: "memory");
}
DI void convert_experts(const Frame& F, const KP& p, int l) {
    LAS float* scr = (LAS float*)(F.lds + F.wave * 16384);
    const int gw = F.bid * NWAVES + F.wave, NGW = F.G * NWAVES;
    const float* wg = p.in[21] + (size_t)l * NE * D * DE; const float* wu = p.in[22] + (size_t)l * NE * D * DE; const float* wd = p.in[23] + (size_t)l * NE * DE * D;
    bf16* GU = (bf16*)(F.ws + WS_GU); bf16* DN = (bf16*)(F.ws + WS_DN);
    for (int it = gw; it < 3 * 8192; it += NGW) {
        const int which = it >> 13, r8 = it & 8191, e = r8 >> 8, r = r8 & 255;
        if (which < 2) { const int kb = r >> 4, nb = r & 15, n0 = 32 * nb;
            tr_item((which ? wu : wg) + (size_t)e * D * DE, DE, 64 * kb, n0, GU, D, e * 1024 + 256 * (n0 >> 7) + 64 * ((n0 & 127) >> 5) + (which ? 32 : 0), scr, F.lane); }
        else { const int kb = r >> 5, nb = r & 31, n0 = 32 * nb;
            tr_item(wd + (size_t)e * DE * D, D, 64 * kb, n0, DN, DE, e * 1024 + n0, scr, F.lane); }
    }
}
DI void p0_prologue(const Frame& F, const KP& p) {
    const int gw = F.bid * NWAVES + F.wave, NGW = F.G * NWAVES;
    {
        LAS float* sc = (LAS float*)(F.lds);
        LAS float* part = (LAS float*)(F.lds + 32768);
        for (int i = F.tid; i < 5 * D; i += NTHR) { const int r = i >> 10, k = i & 1023; const float v = r < 4 ? p.in[1][r * D + k] : p.in[3][k]; sc[i] = siluf(v); }
        __syncthreads();
        for (int item = F.bid; item < 192; item += F.G) {
            const int l = item / 96, n0 = (item % 96) * 64;
            const float* w = p.in[4] + (size_t)l * D * 6144 + n0 + F.lane;
            float a0 = 0.f, a1 = 0.f, a2 = 0.f, a3 = 0.f, a4 = 0.f;
            const int kb = F.wave * 128;
#pragma unroll 32
            for (int k = 0; k < 128; ++k) { const float wv = __builtin_nontemporal_load(w + (size_t)(kb + k) * 6144);
                a0 += sc[kb + k] * wv; a1 += sc[D + kb + k] * wv; a2 += sc[2 * D + kb + k] * wv; a3 += sc[3 * D + kb + k] * wv; a4 += sc[4 * D + kb + k] * wv; }
            part[(F.wave * 5 + 0) * 64 + F.lane] = a0; part[(F.wave * 5 + 1) * 64 + F.lane] = a1; part[(F.wave * 5 + 2) * 64 + F.lane] = a2;
            part[(F.wave * 5 + 3) * 64 + F.lane] = a3; part[(F.wave * 5 + 4) * 64 + F.lane] = a4;
            __syncthreads();
            if (F.tid < 320) { const int r = F.tid >> 6, n = F.tid & 63; float s = p.in[5][l * 6144 + n0 + n];
#pragma unroll
                for (int w8 = 0; w8 < 8; ++w8) s += part[(w8 * 5 + r) * 64 + n];
                ((float*)(F.ws + WS_MOD))[(size_t)(l * 5 + r) * 6144 + n0 + n] = s; }
            __syncthreads();
        }
        __syncthreads();
    }
    {
        LAS float* scr = (LAS float*)(F.lds + F.wave * 16384);
        constexpr int I_POOL = 128, I_IN = 2048 + 16, I_OUT = 512;
        for (int it = gw; it < I_POOL + I_IN + I_OUT; it += NGW) {
            int r = it;
            if (r < I_POOL) { const int g = r >> 5, q = r & 31, kb = q >> 3, nb = q & 7; tr_item(p.in[8] + (size_t)g * 65536, 256, 64 * kb, 32 * nb, (bf16*)(F.ws + WS_BTP), 256, g * 256 + 32 * nb, scr, F.lane); continue; }
            r -= I_POOL;
            if (r < I_IN) { const int kb = r < 2048 ? (r >> 7) : (r - 2048), nb = r < 2048 ? (r & 127) : 128; tr_item(p.in[11], DN_IN, 64 * kb, 32 * nb, (bf16*)(F.ws + WS_BTIN), D, 32 * nb, scr, F.lane); continue; }
            r -= I_IN;
            { const int kb = r >> 5, nb = r & 31; tr_item(p.in[16], D, 64 * kb, 32 * nb, (bf16*)(F.ws + WS_BTOUT), D, 32 * nb, scr, F.lane); }
        }
    }
    {
        const int gt = F.bid * NTHR + F.tid, NGT = F.G * NTHR;
        bf16* wr2 = (bf16*)(F.ws + WS_WR2);
        for (int i = gt; i < 2 * 48 * D; i += NGT) { const int l = i / (48 * D), r = i % (48 * D), j = r >> 10, k = r & 1023;
            const float w = j < 4 ? p.in[17][((size_t)l * D + k) * 4 + j] : (j < 36 ? p.in[19][((size_t)l * D + k) * 32 + (j - 4)] : 0.f);
            const unsigned hi = f2bf(w); const float rem = w - bf2f((unsigned short)hi);
            wr2[(size_t)(l * 2 + 0) * 48 * D + r] = (bf16)hi; wr2[(size_t)(l * 2 + 1) * 48 * D + r] = (bf16)f2bf(rem); }
        u32x4* zr = (u32x4*)((bf16*)(F.ws + WS_BTIN) + (size_t)4128 * D);
        for (int i = gt; i < 224 * D / 8; i += NGT) zr[i] = (u32x4){0u, 0u, 0u, 0u};
    }
    {
        float* rs = (float*)(F.ws + WS_RSTD);
        for (int t = gw; t < T; t += NGW) {
            const f32x4* xr = (const f32x4*)(t < TL ? p.in[0] + (size_t)t * D : p.in[2] + (size_t)(t - TL) * D) + F.lane;
            float s = 0.f;
#pragma unroll
            for (int j = 0; j < 4; ++j) { const f32x4 v = xr[64 * j]; s += (v.x * v.x + v.y * v.y) + (v.z * v.z + v.w * v.w); }
            s = wave_sum(s);
            if (F.lane == 0) rs[t] = rsqrtf(s * (1.f / D) + EPS);
        }
    }
}

DI void p1_pool_diff(const Frame& F, const KP& p) {
    const float* rs = (const float*)(F.ws + WS_RSTD);
    bf16* DD = (bf16*)(F.ws + WS_DD);
    LAS f32x4* Vs = (LAS f32x4*)(F.lds);
    const int ch4 = F.tid & 63, cg = F.tid >> 6;
    {
        const int gw = F.bid * NWAVES + F.wave;
        if (gw < 2 * 5 * 36) { const int l = gw / 180, q = gw % 180, r = q / 36, j = q % 36; const float* b2 = modp(F, l, r, 3); float s = 0.f;
            for (int i = 0; i < 16; ++i) { const int c = F.lane + 64 * i; const float w = j < 4 ? p.in[17][((size_t)l * D + c) * 4 + j] : p.in[19][((size_t)l * D + c) * 32 + (j - 4)]; s += b2[c] * w; }
            s = wave_sum(s);
            if (F.lane == 0) ((float*)(F.ws + WS_C0))[(l * 5 + r) * 48 + j] = s + (j < 4 ? p.in[18][l * 4 + j] : p.in[20][l * 32 + (j - 4)]); }
    }
    LAS float* rsl = (LAS float*)(F.lds + 65536);
    for (int it = F.bid; it < 256 + 64; it += F.G) {
        if (it < 256) {
            const int g = it & 3, bb = it >> 2, b = bb >> 4, r0 = (bb & 15) * 8, hw = 1 << g;
            const int ch = g * 256 + 4 * ch4;
            f32x4 A4 = *(const f32x4*)(p.in[6] + ch); { const f32x4 s4 = *(const f32x4*)(modp(F, 0, b, 1) + ch); A4 = A4 * (s4 + 1.f); }
            const int rlo = max(r0 - hw, 0), rhi = min(r0 + 8 + hw, 128);
            for (int i = F.tid; i < (rhi - rlo) * 64; i += NTHR) rsl[i] = rs[b * SEQ + rlo * 64 + i];
            __syncthreads();
            const float* xb = p.in[0] + (size_t)b * SEQ * D + ch + (size_t)(8 * cg) * D;
            f32x4 S[8];
#pragma unroll
            for (int cc = 0; cc < 8; ++cc) S[cc] = (f32x4){0.f, 0.f, 0.f, 0.f};
            for (int rr = rlo; rr < min(r0 + hw, 128); ++rr) {
#pragma unroll
                for (int cc = 0; cc < 8; ++cc) S[cc] += *(const f32x4*)(xb + (size_t)(rr * 64 + cc) * D) * rsl[(rr - rlo) * 64 + 8 * cg + cc]; }
            for (int r = r0; r < r0 + 8; ++r) {
                const int lo_r = max(r - hw, 0), hi_r = min(r + hw, 128);
                f32x4 xc[8], xa[8], xs_[8];
                const bool ha = (r + hw) < 128, hs = (r - hw) >= 0;
#pragma unroll
                for (int cc = 0; cc < 8; ++cc) { xc[cc] = *(const f32x4*)(xb + (size_t)(r * 64 + cc) * D);
                    xa[cc] = ha ? *(const f32x4*)(xb + (size_t)((r + hw) * 64 + cc) * D) : (f32x4){0.f, 0.f, 0.f, 0.f};
                    xs_[cc] = hs ? *(const f32x4*)(xb + (size_t)((r - hw) * 64 + cc) * D) : (f32x4){0.f, 0.f, 0.f, 0.f}; }
#pragma unroll
                for (int cc = 0; cc < 8; ++cc) Vs[(8 * cg + cc) * 64 + ch4] = S[cc];
                __syncthreads();
                f32x4 h = {0.f, 0.f, 0.f, 0.f};
                { const int c0 = 8 * cg, l0 = max(c0 - hw, 0), h0 = min(c0 + hw, 64); for (int c2 = l0; c2 < h0; ++c2) h += Vs[c2 * 64 + ch4]; }
#pragma unroll
                for (int cc = 0; cc < 8; ++cc) { const int col = 8 * cg + cc, lo_c = max(col - hw, 0), hi_c = min(col + hw, 64);
                    if (cc > 0) { if (col + hw <= 64) h += Vs[(col + hw - 1) * 64 + ch4]; if (col - hw > 0) h -= Vs[(col - hw - 1) * 64 + ch4]; }
                    const int t = b * SEQ + r * 64 + col; const float inv = 1.f / (float)((hi_r - lo_r) * (hi_c - lo_c));
                    const f32x4 xn = xc[cc] * rsl[(r - rlo) * 64 + col];
                    const f32x4 d = A4 * (h * inv - xn);
                    u32x2 o; o.x = pk2(d.x, d.y); o.y = pk2(d.z, d.w);
                    *(u32x2*)(DD + ((size_t)g * T + t) * 256 + 4 * ch4) = o; }
#pragma unroll
                for (int cc = 0; cc < 8; ++cc) { if (ha) S[cc] += xa[cc] * rsl[(r + hw - rlo) * 64 + 8 * cg + cc]; if (hs) S[cc] -= xs_[cc] * rsl[(r - hw - rlo) * 64 + 8 * cg + cc]; }
                __syncthreads();
            }
        } else {
            const int i2 = it - 256, g = i2 & 3, b = (i2 >> 2) & 3, q4 = i2 >> 4, hw = 1 << g;
            const int ch = g * 256 + 4 * ch4;
            f32x4 A4 = *(const f32x4*)(p.in[6] + ch); { const f32x4 s4 = *(const f32x4*)(modp(F, 0, 4, 1) + ch); A4 = A4 * (s4 + 1.f); }
#pragma unroll
            for (int cc = 0; cc < 8; ++cc) { const int j = 64 * q4 + 8 * cg + cc, lo = max(j - hw, 0), hi = min(j + hw, CTXL); f32x4 a = {0.f, 0.f, 0.f, 0.f};
                for (int jj = lo; jj < hi; ++jj) a += *(const f32x4*)(p.in[2] + (size_t)(b * CTXL + jj) * D + ch) * rs[TL + b * CTXL + jj];
                const int t = TL + b * CTXL + j; const float inv = 1.f / (float)(hi - lo);
                const f32x4 xn = *(const f32x4*)(p.in[2] + (size_t)(b * CTXL + j) * D + ch) * rs[t];
                const f32x4 d = A4 * (a * inv - xn);
                u32x2 o; o.x = pk2(d.x, d.y); o.y = pk2(d.z, d.w);
                *(u32x2*)(DD + ((size_t)g * T + t) * 256 + 4 * ch4) = o; }
        }
    }
}

struct PoolOrder {
    int G, c;
    DI bool next(int i, Unit& u) const { const int L = i * G + c; if (L >= 528) return false; u.pm = L; u.pn = L / 132; u.e = 0; u.rt = 0; u.nvalid = 0; return true; }
    DI unsigned row_off(const Unit&, int) const { return 0u; }
};
struct G1Order {
    int G, c;
    DI bool next(int i, Unit& u) const {
        if (G == 256) { if (i < 8) { const int x = c & 7, j = c >> 3; u.pm = (i * 8 + x) * 2 + (j >> 4); u.pn = j & 15; }
            else { const int q = (i - 8) * 256 + c; if (q >= 48 + 132) return false; if (q < 48) { u.pm = 128 + q / 12; u.pn = q % 12; } else { u.pm = q - 48; u.pn = 16; } } }
        else { const int L = i * G + c; if (L >= 2176 + 52) return false;
            if (L < 2176) { u.pm = L / 17; u.pn = L % 17; } else { const int q = L - 2176, q13 = q % 13; u.pm = 128 + q / 13; u.pn = q13 < 12 ? q13 : 16; } }
        u.e = 0; u.rt = 0; u.nvalid = 0; return true; }
    DI unsigned row_off(const Unit&, int) const { return 0u; }
};
struct G2Order {
    int G, c;
    DI bool next(int i, Unit& u) const {
        if (G == 256) { if (i >= 2) return false; const int x = c & 7, j = c >> 3; u.pm = (i * 8 + x) * 8 + (j >> 2); u.pn = j & 3; }
        else { const int L = i * G + c; if (L >= 512) return false; u.pm = L >> 2; u.pn = L & 3; }
        u.e = 0; u.rt = 0; u.nvalid = 0; return true; }
    DI unsigned row_off(const Unit&, int) const { return 0u; }
};
struct MoeOrder {
    int G, c, total; const LAS int* tb; const LAS int* cn; const Entry* ent;
    DI bool next(int i, Unit& u) const { int rtg, ct;
        if (G == 256) { const int x = c & 7, j = c >> 3; ct = j & 3; rtg = 64 * i + 8 * x + (j >> 2); if (rtg >= total) return false; }
        else { const int L = i * G + c; if (L >= 4 * total) return false; rtg = L >> 2; ct = L & 3; }
        int e = 0;
        for (int q = 1; q < NE; ++q) e += (tb[q] <= rtg) ? 1 : 0;
        u.pm = rtg; u.pn = e * 4 + ct; u.e = e; u.rt = rtg - tb[e]; u.nvalid = cn[e] - u.rt * 256; return true; }
    DI unsigned row_off(const Unit& u, int row) const { int tok = 0; if (row < u.nvalid) tok = ent[(size_t)u.e * CAP + u.rt * 256 + row].ts >> 1; return (unsigned)tok * (unsigned)(D * 2); }
};
DI void moe_tables(const Frame& F, int l, LAS int* tb, LAS int* cn) {
    if (F.tid < 64) { const unsigned* cnt = (const unsigned*)(F.ws + WS_CTL) + CW_CNT + l * 32 * CNT_STRIDE;
        const int c = F.tid < NE ? (int)__hip_atomic_load(cnt + F.tid * CNT_STRIDE, __ATOMIC_RELAXED, __HIP_MEMORY_SCOPE_AGENT) : 0;
        const int ntl = (c + 255) >> 8; int inc = ntl;
#pragma unroll
        for (int o = 1; o < 32; o <<= 1) { const int up = __shfl_up(inc, o); if (F.lane >= o) inc += up; }
        if (F.tid < NE) { cn[F.tid] = c; tb[F.tid] = inc - ntl; if (F.tid == NE - 1) tb[NE] = inc; } }
    __syncthreads();
}

struct EpiRaw {
    static constexpr bool PERM = true;
    bf16* o; int pool;
    DI void operator()(const f32x4 (&acc)[2][2][4][2], const Unit& u, int, int, int, int) const {
        int tz = threadIdx.x; asm volatile("" : "+v"(tz)); const int wr = tz >> 8, wc = (tz >> 6) & 3, fr = tz & 15, fq = (tz >> 4) & 3;
        const int rt = pool ? u.pm - 132 * u.pn : u.pm;
#pragma unroll
        for (int ai = 0; ai < 2; ++ai)
#pragma unroll
            for (int m = 0; m < 4; ++m) { bf16* dst = o + (size_t)(rt * 256 + ai * 128 + wr * 64 + m * 16 + fr) * D + u.pn * 256 + wc * 64 + 8 * fq;
#pragma unroll
                for (int bj = 0; bj < 2; ++bj) { const f32x4 v0 = acc[ai][bj][m][0], v1 = acc[ai][bj][m][1];
                    u32x4 w; w.x = pk2(v0.x, v0.y); w.y = pk2(v0.z, v0.w); w.z = pk2(v1.x, v1.y); w.w = pk2(v1.z, v1.w);
                    *(u32x4*)(dst + bj * 32) = w; } }
    }
};
struct EpiGU {
    static constexpr bool PERM = true;
    bf16* hid;
    DI void operator()(const f32x4 (&acc)[2][2][4][2], const Unit& u, int, int, int, int) const {
        int tz = threadIdx.x; asm volatile("" : "+v"(tz)); const int wr = tz >> 8, wc = (tz >> 6) & 3, fr = tz & 15, fq = (tz >> 4) & 3;
        const int ct = u.pn & 3;
#pragma unroll
        for (int ai = 0; ai < 2; ++ai)
#pragma unroll
            for (int m = 0; m < 4; ++m) { const size_t row = (size_t)u.pm * 256 + ai * 128 + wr * 64 + m * 16 + fr;
                const f32x4 g0 = acc[ai][0][m][0], g1 = acc[ai][0][m][1], u0 = acc[ai][1][m][0], u1 = acc[ai][1][m][1];
                u32x4 w; w.x = pk2(siluf(g0.x) * u0.x, siluf(g0.y) * u0.y); w.y = pk2(siluf(g0.z) * u0.z, siluf(g0.w) * u0.w);
                w.z = pk2(siluf(g1.x) * u1.x, siluf(g1.y) * u1.y); w.w = pk2(siluf(g1.z) * u1.z, siluf(g1.w) * u1.w);
                *(u32x4*)(hid + row * DE + ct * 128 + wc * 32 + 8 * fq) = w; }
    }
};
struct EpiDown {
    static constexpr bool PERM = true;
    bf16* y;
    DI void operator()(const f32x4 (&acc)[2][2][4][2], const Unit& u, int, int, int, int) const {
        int tz = threadIdx.x; asm volatile("" : "+v"(tz)); const int wr = tz >> 8, wc = (tz >> 6) & 3, fr = tz & 15, fq = (tz >> 4) & 3;
        const int ct = u.pn & 3;
#pragma unroll
        for (int ai = 0; ai < 2; ++ai)
#pragma unroll
            for (int m = 0; m < 4; ++m) { const size_t row = (size_t)u.pm * 256 + ai * 128 + wr * 64 + m * 16 + fr;
                bf16* dst = y + row * D + ct * 256 + wc * 64 + 8 * fq;
#pragma unroll
                for (int bj = 0; bj < 2; ++bj) { const f32x4 v0 = acc[ai][bj][m][0], v1 = acc[ai][bj][m][1];
                    u32x4 w; w.x = pk2(v0.x, v0.y); w.y = pk2(v0.z, v0.w); w.z = pk2(v1.x, v1.y); w.w = pk2(v1.z, v1.w);
                    *(u32x4*)(dst + bj * 32) = w; } }
    }
};
struct EpiG1 {
    static constexpr bool PERM = true;
    bf16* pqkv; bf16* z; bf16* halo; float* ab;
    DI void operator()(const f32x4 (&acc)[2][2][4][2], const Unit& u, int, int, int, int) const {
        int tz = threadIdx.x; asm volatile("" : "+v"(tz)); const int wr = tz >> 8, wc = (tz >> 6) & 3, fr = tz & 15, fq = (tz >> 4) & 3;
#pragma unroll
        for (int ai = 0; ai < 2; ++ai)
#pragma unroll
            for (int m = 0; m < 4; ++m) { const int t = u.pm * 256 + ai * 128 + wr * 64 + m * 16 + fr, rr = m * 16 + fr;
#pragma unroll
                for (int bj = 0; bj < 2; ++bj) { const f32x4 v0 = acc[ai][bj][m][0], v1 = acc[ai][bj][m][1];
                    u32x4 w; w.x = pk2(v0.x, v0.y); w.y = pk2(v0.z, v0.w); w.z = pk2(v1.x, v1.y); w.w = pk2(v1.z, v1.w);
                    const int col = u.pn * 256 + wc * 64 + bj * 32 + 8 * fq;
                    if (u.pn < 12) { *(u32x4*)(pqkv + (size_t)t * 3072 + col) = w;
                        if (rr == 0 || rr >= 62) { const int slot = rr == 0 ? 0 : rr - 61; *(u32x4*)(halo + ((size_t)(t >> 6) * 3 + slot) * 3072 + col) = w; } }
                    else if (u.pn < 16) *(u32x4*)(z + (size_t)t * D + (col - 3072)) = w;
                    else if (bj == 0 && wc == 0) { *(f32x4*)(ab + (size_t)t * 32 + 8 * fq) = v0; *(f32x4*)(ab + (size_t)t * 32 + 8 * fq + 4) = v1; } } }
    }
};
DI void p_router(const Frame& F, const KP& p, int l, int ntok) {
    LAS float* A2s = (LAS float*)(F.lds); LAS float* gBs = A2s + 1024; LAS float* gAs = A2s + 2048;
    constexpr int YT_OFF = 12288, YT_ROW = 2064, YT_SIZE = 16 * YT_ROW;
    constexpr int PT_OFF = YT_OFF + 2 * YT_SIZE, PT_SIZE = 8 * 16 * 49 * 4;
    constexpr int PS_OFF = PT_OFF + 2 * PT_SIZE;
    constexpr int LG_OFF = PS_OFF + 1024, RS_OFF = LG_OFF + 16 * 49 * 4, HI_OFF = RS_OFF + 64;
    static_assert(HI_OFF + 256 + 3072 <= LDS_MISC, "router LDS map");
    LAS float* lgs = (LAS float*)(F.lds + LG_OFF);
    LAS float* rsl = (LAS float*)(F.lds + RS_OFF);
    LAS int* hist = (LAS int*)(F.lds + HI_OFF);
    LAS int* basee = (LAS int*)(F.lds + HI_OFF + 128);
    LAS int* tiE = (LAS int*)(F.lds + HI_OFF + 256);
    LAS int* tiP = (LAS int*)(F.lds + HI_OFF + 256 + 1024);
    LAS float* tiW = (LAS float*)(F.lds + HI_OFF + 256 + 2048);
    const bf16* DL = (const bf16*)(F.ws + (l == 0 ? WS_YP : WS_Y2));
    const bf16* whi = (const bf16*)(F.ws + WS_WR2) + (size_t)(l * 2) * 48 * D; bf16* HX = (bf16*)(F.ws + WS_HX);
    unsigned* cnt = (unsigned*)(F.ws + WS_CTL) + CW_CNT + l * 32 * CNT_STRIDE;
    Entry* ent = (Entry*)(F.ws + WS_ENT);
    const float* nf = p.in[7] + l * D;
    const int fr = F.lane & 15, fq = F.lane >> 4, kw = 128 * F.wave;
    const int nunits = 256 + (ntok > TL ? 64 : 0);
    for (int un = F.bid; un < nunits; un += F.G) {
        const int t0 = un < 256 ? un * 128 : TL + (un - 256) * 16, nt16 = un < 256 ? 8 : 1, r = mod_row(t0);
        const bool ctxu = (l == 0 && t0 >= TL);
        bf16x8 bh[4][3];
        { int zo = 0; asm volatile("" : "+s"(zo));
#pragma unroll
          for (int ks = 0; ks < 4; ++ks)
#pragma unroll
            for (int n = 0; n < 3; ++n) { bh[ks][n] = *(const bf16x8*)(whi + zo + (size_t)(16 * n + fr) * D + kw + 32 * ks + 8 * fq); } }
        for (int i = F.tid; i < D; i += NTHR) { A2s[i] = nf[i] * (modp(F, l, r, 4)[i] + 1.f); const float gm = modp(F, l, r, 2)[i];
            if (l == 0) { const float ps = p.in[10][i]; gAs[i] = gm * ps; gBs[i] = gm * p.in[9][i] * ps; } else { gAs[i] = gm; gBs[i] = 0.f; } }
        if (F.tid < 32) hist[F.tid] = 0;
        __syncthreads();
        const float* c0 = (const float*)(F.ws + WS_C0) + (l * 5 + r) * 48;
        const float* xbase = l == 0 ? (t0 < TL ? p.in[0] + (size_t)t0 * D : p.in[2] + (size_t)(t0 - TL) * D) : nullptr;
        const bf16* xb16 = (const bf16*)F.out + (size_t)t0 * D;
        bf16* xo16 = (bf16*)(F.ws + (l == 0 ? WS_XS1 : WS_XS3)) + (size_t)t0 * D;
        float* xo32 = (float*)(F.ws + WS_XC) + (size_t)(t0 - TL) * D;
        f32x4 xa[4], xb[4]; u32x4 xq[4], dq[4];
#define RT_LOAD(mt_) do { const size_t ro_ = (size_t)(16 * (mt_) + fr) * D + kw + 8 * fq; _Pragma("unroll") for (int ks = 0; ks < 4; ++ks) { \
            if (l == 0) { xa[ks] = *(const f32x4*)(xbase + ro_ + 32 * ks); xb[ks] = *(const f32x4*)(xbase + ro_ + 32 * ks + 4); } else xq[ks] = *(const u32x4*)(xb16 + ro_ + 32 * ks); \
            dq[ks] = *(const u32x4*)(DL + (size_t)t0 * D + ro_ + 32 * ks); } } while (0)
        RT_LOAD(0);
        for (int mt = 0; mt < nt16; ++mt) {
            const int bf = mt & 1;
            LAS unsigned char* yt = F.lds + YT_OFF + bf * YT_SIZE; LAS float* part = (LAS float*)(F.lds + PT_OFF + bf * PT_SIZE); LAS float* pss = (LAS float*)(F.lds + PS_OFF + bf * 512);
            { f32x4 acc[3] = {{0.f, 0.f, 0.f, 0.f}, {0.f, 0.f, 0.f, 0.f}, {0.f, 0.f, 0.f, 0.f}}; float ssq = 0.f;
              const size_t ro = (size_t)(16 * mt + fr) * D + kw + 8 * fq;
#pragma unroll
              for (int ks = 0; ks < 4; ++ks) {
                f32x4 x0, x1; if (l == 0) { x0 = xa[ks]; x1 = xb[ks]; } else unpk8(xq[ks], x0, x1);
                { f32x4 da, db; unpk8(dq[ks], da, db); const LAS float* ga = gAs + kw + 32 * ks + 8 * fq; const LAS float* gb = gBs + kw + 32 * ks + 8 * fq;
                  x0 += *(const LAS f32x4*)gb + *(const LAS f32x4*)ga * da; x1 += *(const LAS f32x4*)(gb + 4) + *(const LAS f32x4*)(ga + 4) * db; }
                if (ctxu) { *(f32x4*)(xo32 + ro + 32 * ks) = x0; *(f32x4*)(xo32 + ro + 32 * ks + 4) = x1; } else *(u32x4*)(xo16 + ro + 32 * ks) = pk8(x0, x1);
                ssq += (x0.x * x0.x + x0.y * x0.y) + (x0.z * x0.z + x0.w * x0.w) + (x1.x * x1.x + x1.y * x1.y) + (x1.z * x1.z + x1.w * x1.w);
                const f32x4 y0 = x0 * *(const LAS f32x4*)(A2s + kw + 32 * ks + 8 * fq), y1 = x1 * *(const LAS f32x4*)(A2s + kw + 32 * ks + 8 * fq + 4);
                const u32x4 hq = pk8(y0, y1); f32x4 h0, h1; unpk8(hq, h0, h1);
                const bf16x8 ah = __builtin_bit_cast(bf16x8, hq), al = __builtin_bit_cast(bf16x8, pk8(y0 - h0, y1 - h1));
                *(LAS bf16x8*)(yt + fr * YT_ROW + (kw + 32 * ks + 8 * fq) * 2) = ah;
#pragma unroll
                for (int n = 0; n < 3; ++n) {
                    acc[n] = __builtin_amdgcn_mfma_f32_16x16x32_bf16(ah, bh[ks][n], acc[n], 0, 0, 0);
                    acc[n] = __builtin_amdgcn_mfma_f32_16x16x32_bf16(al, bh[ks][n], acc[n], 0, 0, 0); }
              }
              if (mt + 1 < nt16) RT_LOAD(mt + 1);
              ssq += __shfl_xor(ssq, 16); ssq += __shfl_xor(ssq, 32);
              if (fq == 0) pss[F.wave * 16 + fr] = ssq;
#pragma unroll
              for (int n = 0; n < 3; ++n)
#pragma unroll
                for (int q = 0; q < 4; ++q) part[(F.wave * 16 + 4 * fq + q) * 49 + 16 * n + fr] = acc[n][q]; }
            __syncthreads();
            if (F.tid < 256) { const int tl = F.tid >> 4, jj = F.tid & 15; float s = 0.f;
#pragma unroll
                for (int w = 0; w < 8; ++w) s += pss[w * 16 + tl];
                const float rstd = rsqrtf(s * (1.f / D) + EPS);
                if (jj == 0) rsl[tl] = rstd;
#pragma unroll
                for (int j = jj; j < 48; j += 16) { float g = 0.f;
#pragma unroll
                    for (int w = 0; w < 8; ++w) g += part[(w * 16 + tl) * 49 + j];
                    lgs[tl * 49 + j] = g * rstd + c0[j]; } }
            __syncthreads();
            if (F.tid < 16) {
                const LAS float* lg = lgs + F.tid * 49;
                const float g0 = lg[0], g1 = lg[1], g2 = lg[2], g3 = lg[3];
                int gi = 0; float gm = g0; if (g1 > gm) { gm = g1; gi = 1; } if (g2 > gm) { gm = g2; gi = 2; } if (g3 > gm) { gm = g3; gi = 3; }
                const float pg = 1.f / (__expf(g0 - gm) + __expf(g1 - gm) + __expf(g2 - gm) + __expf(g3 - gm));
                float e1 = -3.0e38f, e2 = -3.0e38f; int i1 = 0, i2 = 0;
#pragma unroll
                for (int j = 0; j < 8; ++j) { const float v = lg[4 + gi * 8 + j];
                    if (v > e1) { e2 = e1; i2 = i1; e1 = v; i1 = j; } else if (v > e2) { e2 = v; i2 = j; } }
                const float w1 = pg / (1.f + __expf(e2 - e1)), w2 = pg - w1;
                const int E0 = gi * 8 + i1, E1 = gi * 8 + i2, tl = 16 * mt + F.tid;
                tiE[tl * 2] = E0; tiE[tl * 2 + 1] = E1; tiW[tl * 2] = w1; tiW[tl * 2 + 1] = w2;
                tiP[tl * 2] = atomicAdd((int*)&hist[E0], 1); tiP[tl * 2 + 1] = atomicAdd((int*)&hist[E1], 1);
            }
#pragma unroll 1
            for (int kk = 0; kk < 2; ++kk) { const int tk = 2 * F.wave + kk; const float rstd = rsl[tk];
#pragma unroll
                for (int i = 0; i < 2; ++i) { const int c = 8 * F.lane + 512 * i; f32x4 ya, yb; unpk8(*(const LAS u32x4*)(yt + tk * YT_ROW + c * 2), ya, yb);
                    const float* b2 = modp(F, l, r, 3) + c;
                    *(u32x4*)(HX + (size_t)(t0 + 16 * mt + tk) * D + c) = pk8(ya * rstd + *(const f32x4*)b2, yb * rstd + *(const f32x4*)(b2 + 4)); } }
        }
#undef RT_LOAD
        __syncthreads();
        { int tz = threadIdx.x; asm volatile("" : "+v"(tz));
          if (tz < 32) { const int hcount = hist[tz]; basee[tz] = hcount > 0 ? (int)__hip_atomic_fetch_add(cnt + tz * CNT_STRIDE, (unsigned)hcount, __ATOMIC_RELAXED, __HIP_MEMORY_SCOPE_AGENT) : 0; } }
        __syncthreads();
        if (F.tid < 32 * nt16) { const int tl = F.tid >> 1, E = tiE[F.tid], pos = basee[E] + tiP[F.tid]; Entry en; en.ts = (t0 + tl) * 2 + (F.tid & 1); en.w = tiW[F.tid];
            ent[(size_t)E * CAP + pos] = en;
            Entry ti; ti.ts = (E << 16) | pos; ti.w = en.w; ((Entry*)(F.ws + WS_TI))[(size_t)(t0 + tl) * 2 + (F.tid & 1)] = ti; }
        __syncthreads();
    }
}

DI void p6_n1(const Frame& F, const KP& p, const LAS int* tb) {
    const int gw = F.bid * NWAVES + F.wave, NGW = F.G * NWAVES;
    const bf16* Y = (const bf16*)(F.ws + WS_Y); bf16* HX = (bf16*)(F.ws + WS_HX); const Entry* TI = (const Entry*)(F.ws + WS_TI);
    for (int t = gw; t < T; t += NGW) {
        const int r = mod_row(t); const bool lat = t < TL;
        float* xr = (float*)(F.ws + WS_XC) + (size_t)(t - TL) * D;
        const bf16* xi16 = (const bf16*)(F.ws + WS_XS1) + (size_t)t * D; bf16* xo16 = (bf16*)F.out + (size_t)t * D;
        const Entry ta = TI[(size_t)2 * t], tbb = TI[(size_t)2 * t + 1]; const float w0 = ta.w, w1 = tbb.w;
        const size_t r0 = ((size_t)tb[ta.ts >> 16] * 256 + (ta.ts & 0xffff)) * D, r1 = ((size_t)tb[tbb.ts >> 16] * 256 + (tbb.ts & 0xffff)) * D;
        f32x4 va[2], vb[2]; u32x4 y0[2], y1[2]; float s = 0.f;
#pragma unroll
        for (int i = 0; i < 2; ++i) { const int c = 8 * F.lane + 512 * i;
            if (lat) unpk8(*(const u32x4*)(xi16 + c), va[i], vb[i]); else { va[i] = *(const f32x4*)(xr + c); vb[i] = *(const f32x4*)(xr + c + 4); }
            y0[i] = *(const u32x4*)(Y + r0 + c); y1[i] = *(const u32x4*)(Y + r1 + c); }
#pragma unroll
        for (int i = 0; i < 2; ++i) { const int c = 8 * F.lane + 512 * i; f32x4 a0, b0, a1, b1; unpk8(y0[i], a0, b0); unpk8(y1[i], a1, b1);
            const float* gp = modp(F, 0, r, 5) + c;
            va[i] = va[i] + *(const f32x4*)gp * (a0 * w0 + a1 * w1); vb[i] = vb[i] + *(const f32x4*)(gp + 4) * (b0 * w0 + b1 * w1);
            if (lat) *(u32x4*)(xo16 + c) = pk8(va[i], vb[i]); else { *(f32x4*)(xr + c) = va[i]; *(f32x4*)(xr + c + 4) = vb[i]; }
            s += (va[i].x * va[i].x + va[i].y * va[i].y) + (va[i].z * va[i].z + va[i].w * va[i].w) + (vb[i].x * vb[i].x + vb[i].y * vb[i].y) + (vb[i].z * vb[i].z + vb[i].w * vb[i].w); }
        const float rstd = rsqrtf(wave_sum(s) * (1.f / D) + EPS);
#pragma unroll
        for (int i = 0; i < 2; ++i) { const int c = 8 * F.lane + 512 * i; const float* nm = p.in[6] + D + c; const float* sc = modp(F, 1, r, 1) + c; const float* sh = modp(F, 1, r, 0) + c;
            const f32x4 oa = va[i] * rstd * (*(const f32x4*)nm * (*(const f32x4*)sc + 1.f)) + *(const f32x4*)sh, ob = vb[i] * rstd * (*(const f32x4*)(nm + 4) * (*(const f32x4*)(sc + 4) + 1.f)) + *(const f32x4*)(sh + 4);
            *(u32x4*)(HX + (size_t)t * D + c) = pk8(oa, ob); }
    }
}

DI bf16x8 lds_frag(LAS unsigned char* base, int byteoff) { return *(const LAS bf16x8*)(base + byteoff); }
DI void p8_c1a(const Frame& F, const KP& p) {
    bf16* PQ = (bf16*)(F.ws + WS_PQKV); const bf16* HALO = (const bf16*)(F.ws + WS_HALO); const float* AB = (const float*)(F.ws + WS_AB);
    float* LM = (float*)(F.ws + WS_LM); bf16* PM = (bf16*)(F.ws + WS_PM); float* GCB = (float*)(F.ws + WS_GCB);
    constexpr int RS = 272;
    LAS unsigned char* qs = F.lds; LAS unsigned char* ks = F.lds + 64 * RS;
    LAS float* KKs = (LAS float*)(F.lds + 53248);
    LAS float* QKs = (LAS float*)(F.lds + 53248 + 17408);
    LAS float* gcs = (LAS float*)(F.lds + 53248 + 2 * 17408);
    LAS float* bes = gcs + 128;
    const int fr = F.lane & 15, fq = F.lane >> 4;
    const int grp = F.tid >> 4, l16 = F.tid & 15, which = grp >> 3, ro = grp & 7;
    u32x4 raw[11]; float abA = 0.f, abB = 0.f;
#define C1_LOAD(unit_) do { const int cid_ = (unit_) >> 3, h_ = (unit_) & 7, tok0_ = cid_ * 64, col_ = which * 1024 + h_ * 128 + 8 * l16; \
        const bool first_ = cid_ < 512 ? ((cid_ & 127) == 0) : (((cid_ - 512) & 3) == 0), last_ = cid_ < 512 ? ((cid_ & 127) == 127) : (((cid_ - 512) & 3) == 3); \
        if (F.wave < 6) { _Pragma("unroll") for (int q = 0; q < 11; ++q) { const int rr = 8 * ro + q - 2; u32x4 v = {0u, 0u, 0u, 0u}; \
                if (rr < 0) { if (!first_) v = *(const u32x4*)(HALO + ((size_t)(cid_ - 1) * 3 + (rr + 3)) * 3072 + col_); } \
                else if (rr > 63) { if (!last_) v = *(const u32x4*)(HALO + ((size_t)(cid_ + 1) * 3 + 0) * 3072 + col_); } \
                else v = *(const u32x4*)(PQ + (size_t)(tok0_ + rr) * 3072 + col_); \
                raw[q] = v; } } \
        else { const int d_ = F.wave - 6, jj_ = d_ ? 63 - F.lane : F.lane; const float* ab_ = AB + (size_t)(tok0_ + jj_) * 32; abA = ab_[(2 * d_) * 8 + h_]; abB = ab_[(2 * d_ + 1) * 8 + h_]; } } while (0)
    if (F.bid < NCID * NH) C1_LOAD(F.bid);
    for (int unit = F.bid; unit < NCID * NH; unit += F.G) {
        const int cid = unit >> 3, h = unit & 7;
        const int tok0 = cid * 64;
        u32x4 res[8];
        const int col = which * 1024 + h * 128 + 8 * l16;
        if (F.wave < 6) {
            f32x4 w0[4], w1[4];
#pragma unroll
            for (int k = 0; k < 4; ++k) { w0[k] = *(const f32x4*)(p.in[12] + k * 3072 + col); w1[k] = *(const f32x4*)(p.in[12] + k * 3072 + col + 4); }
#pragma unroll
            for (int j = 0; j < 8; ++j) { float o[8];
#pragma unroll
                for (int e = 0; e < 8; ++e) o[e] = 0.f;
#pragma unroll
                for (int k = 0; k < 4; ++k) { const u32x4 rw = raw[j + k];
                    o[0] += bflo(rw.x) * w0[k].x; o[1] += bfhi(rw.x) * w0[k].y; o[2] += bflo(rw.y) * w0[k].z; o[3] += bfhi(rw.y) * w0[k].w;
                    o[4] += bflo(rw.z) * w1[k].x; o[5] += bfhi(rw.z) * w1[k].y; o[6] += bflo(rw.w) * w1[k].z; o[7] += bfhi(rw.w) * w1[k].w; }
                float ss = 0.f;
#pragma unroll
                for (int e = 0; e < 8; ++e) { o[e] = siluf(o[e]); ss += o[e] * o[e]; }
                ss += __shfl_xor(ss, 1); ss += __shfl_xor(ss, 2); ss += __shfl_xor(ss, 4); ss += __shfl_xor(ss, 8);
                float sc = 1.f;
                if (which == 0) sc = rsqrtf(ss + EPS) * 0.08838834764831845f; else if (which == 1) sc = rsqrtf(ss + EPS);
                u32x4 w; w.x = pk2(o[0] * sc, o[1] * sc); w.y = pk2(o[2] * sc, o[3] * sc); w.z = pk2(o[4] * sc, o[5] * sc); w.w = pk2(o[6] * sc, o[7] * sc);
                res[j] = w;
                if (which < 2) *(LAS u32x4*)((which == 0 ? qs : ks) + (8 * ro + j) * RS + l16 * 16) = w; }
        } else { const int d = F.wave - 6;
            const float a = abA, bb = abB;
            const float g = -__expf(p.in[13][d * 8 + h]) * softplusf_(a + p.in[14][d * 8 + h]); const float be = sigmoidf_(bb);
            float gc = g;
#pragma unroll
            for (int o = 1; o < 64; o <<= 1) { const float up = __shfl_up(gc, o); if (F.lane >= o) gc += up; }
            gcs[d * 64 + F.lane] = gc; bes[d * 64 + F.lane] = be;
            const float eg = __expf(gc), glast = __shfl(gc, 63);
            float* gp = GCB + ((size_t)unit * 2 + d) * 256; gp[F.lane] = be; gp[64 + F.lane] = be * eg; gp[128 + F.lane] = eg; gp[192 + F.lane] = __expf(glast - gc); }
        __syncthreads();
        if (unit + F.G < NCID * NH) C1_LOAD(unit + F.G);
        if (F.wave < 6) {
#pragma unroll
            for (int j = 0; j < 8; ++j) *(u32x4*)(PQ + (size_t)(tok0 + 8 * ro + j) * 3072 + col) = res[j]; }
#pragma unroll
        for (int tt = 0; tt < 2; ++tt) { const int ti = 2 * F.wave + tt, mt = ti >> 2, nt = ti & 3;
            f32x4 ak = {0.f, 0.f, 0.f, 0.f}, aq = {0.f, 0.f, 0.f, 0.f};
#pragma unroll
            for (int kk = 0; kk < 4; ++kk) { const int ko = (32 * kk + 8 * fq) * 2;
                const bf16x8 bfr = lds_frag(ks, (16 * nt + fr) * RS + ko), akf = lds_frag(ks, (16 * mt + fr) * RS + ko), aqf = lds_frag(qs, (16 * mt + fr) * RS + ko);
                ak = __builtin_amdgcn_mfma_f32_16x16x32_bf16(akf, bfr, ak, 0, 0, 0); aq = __builtin_amdgcn_mfma_f32_16x16x32_bf16(aqf, bfr, aq, 0, 0, 0); }
#pragma unroll
            for (int r = 0; r < 4; ++r) { KKs[(16 * mt + 4 * fq + r) * 68 + 16 * nt + fr] = ak[r]; QKs[(16 * mt + 4 * fq + r) * 68 + 16 * nt + fr] = aq[r]; } }
        __syncthreads();
#pragma unroll
        for (int itr = 0; itr < 2; ++itr) { const int idx = (F.tid + NTHR * itr) * 8, d = idx >> 12, j1 = (idx >> 6) & 63, jb = idx & 63;
            const int t1 = d ? 63 - j1 : j1; const float g1 = gcs[d * 64 + j1], b1 = bes[d * 64 + j1]; float x[8];
#pragma unroll
            for (int e = 0; e < 8; ++e) { const int j2 = jb + e; x[e] = 0.f;
                if (j2 <= j1) { const int t2 = d ? 63 - j2 : j2; const float f = __expf(g1 - gcs[d * 64 + j2]); x[e] = QKs[t1 * 68 + t2] * f;
                    if (j2 < j1) LM[(size_t)unit * 4096 + t1 * 64 + t2] = b1 * KKs[t1 * 68 + t2] * f; } }
            if (jb <= j1 && j1 < jb + 8) LM[(size_t)unit * 4096 + t1 * 64 + t1] = 0.f;
            u32x4 w; w.x = pk2(x[0], x[1]); w.y = pk2(x[2], x[3]); w.z = pk2(x[4], x[5]); w.w = pk2(x[6], x[7]);
            *(u32x4*)(PM + ((size_t)unit * 2 + d) * 4096 + j1 * 64 + jb) = w; }
        __syncthreads();
    }
#undef C1_LOAD
}

DI void p9_c1b(const Frame& F) {
    const float* LM = (const float*)(F.ws + WS_LM); bf16* TM = (bf16*)(F.ws + WS_TM);
    LAS float* Ls = (LAS float*)(F.lds);
    for (int k0 = 0; F.bid + k0 * F.G < NCID * NH; k0 += 4) {
        {
            f32x4 lv[8];
#pragma unroll
            for (int itr = 0; itr < 8; ++itr) { const int uqs = itr >> 1, un = F.bid + (k0 + uqs) * F.G;
                lv[itr] = un < NCID * NH ? *(const f32x4*)(LM + (size_t)un * 4096 + (size_t)(F.tid + NTHR * (itr & 1)) * 4) : (f32x4){0.f, 0.f, 0.f, 0.f}; }
#pragma unroll
            for (int itr = 0; itr < 8; ++itr) { const int uq = itr >> 1, e0 = (F.tid + NTHR * (itr & 1)) * 4, i1 = e0 >> 6;
#pragma unroll
                for (int e = 0; e < 4; ++e) { const int i2 = (e0 & 63) + e; const float v = lv[itr][e];
                    if (i2 < i1) Ls[((uq * 2 + 0) * 64 + i1) * 64 + i2] = v; else if (i2 > i1) Ls[((uq * 2 + 1) * 64 + (63 - i1)) * 64 + (63 - i2)] = v; } }
        }
        __syncthreads();
        {
            const int uq = F.wave >> 1, d = F.wave & 1, c = F.lane;
            LAS float* L = Ls + (uq * 2 + d) * 4096;
            float Tc[64];
            Tc[0] = (c == 0) ? 1.f : 0.f;
#pragma unroll
            for (int i = 1; i < 64; ++i) {
                f32x4 lr[16];
#pragma unroll
                for (int q = 0; q < (i + 3) / 4; ++q) lr[q] = *(const LAS f32x4*)(L + i * 64 + 4 * q);
                float a0 = (c == i) ? 1.f : 0.f, a1 = 0.f, a2 = 0.f, a3 = 0.f;
#pragma unroll
                for (int q = 0; q < (i + 3) / 4; ++q) { const f32x4 l4 = lr[q]; const int j4 = 4 * q;
                    a0 -= l4.x * Tc[j4];
                    if (j4 + 1 < i) a1 -= l4.y * Tc[j4 + 1];
                    if (j4 + 2 < i) a2 -= l4.z * Tc[j4 + 2];
                    if (j4 + 3 < i) a3 -= l4.w * Tc[j4 + 3]; }
                Tc[i] = (a0 + a1) + (a2 + a3);
            }
            LAS unsigned short* Tl = (LAS unsigned short*)L;
#pragma unroll
            for (int i = 0; i < 64; ++i) Tl[i * 64 + c] = (unsigned short)f2bf(Tc[i]);
            asm volatile("s_waitcnt lgkmcnt(0)" ::: "memory");
            const int un = F.bid + (k0 + uq) * F.G;
            if (un < NCID * NH) { bf16* dst = TM + ((size_t)un * 2 + d) * 4096;
#pragma unroll
                for (int q = 0; q < 8; ++q) *(u32x4*)(dst + (size_t)(q * 64 + c) * 8) = *(const LAS u32x4*)(Tl + (q * 64 + c) * 8); }
        }
        __syncthreads();
    }
}

typedef short s16x4 __attribute__((ext_vector_type(4)));
constexpr int SB_K = 0, SB_Q = 16384, SB_T = 32768, SB_P = 40960, SB_V = 49152, SB_G = 53248, SB_SIZE = 54272;
constexpr int SW_SBT = 2 * SB_SIZE, SW_XT = SW_SBT + 8704, SW_VNT = SW_XT + 4608, SW_VDT = SW_VNT + 4608;
static_assert(SW_VDT + 4608 <= LDS_MISC, "scan LDS map");
DI unsigned offb(unsigned row, unsigned ch) { return 256u * row + 16u * (ch ^ (((row & 3u) << 2) | ((row >> 2) & 3u))); }
DI unsigned offt(unsigned row, unsigned ch) { return 128u * row + 16u * (ch ^ ((row >> 1) & 7u)); }
#define SC_GLDS(src, ldsoff) __builtin_amdgcn_global_load_lds((const unsigned*)(src), (LAS unsigned*)(F.lds + (ldsoff)), 16, 0, 0)
#define SC_LBAR() do { asm volatile("s_waitcnt lgkmcnt(0)" ::: "memory"); __builtin_amdgcn_s_barrier(); asm volatile("" ::: "memory"); } while (0)
DI void scan_chunk(int s, int b, int d, int& cid, int& outp) {
    if (s < 4) { const int cc = d ? 3 - s : s; cid = 512 + b * 4 + cc; outp = 0; } else { const int c2 = s - 4, cc = d ? 127 - c2 : c2; cid = b * 128 + cc; outp = 1; }
}
DI void scan_issue(const Frame& F, int buf, int s, int b, int h, int d, int v0) {
    const unsigned char* PQ = F.ws + WS_PQKV; const float* GCB = (const float*)(F.ws + WS_GCB);
    int cid, outp; scan_chunk(s, b, d, cid, outp);
    const int tok0 = cid * 64, w = F.wave, L = F.lane, bo = buf * SB_SIZE;
    const size_t mb = ((size_t)(cid * 8 + h) * 2 + d);
    const unsigned char* TMb = F.ws + WS_TM + mb * 8192; const unsigned char* PMb = F.ws + WS_PM + mb * 8192;
#pragma unroll
    for (int ii = 0; ii < 2; ++ii) { const int i = 2 * w + ii, row = 4 * i + (L >> 4), slot = L & 15, ch = slot ^ (((row & 3) << 2) | ((row >> 2) & 3)), tok = tok0 + (d ? 63 - row : row);
        const unsigned off = (unsigned)tok * 6144u + (unsigned)(h * 256 + ch * 16);
        SC_GLDS(PQ + 2048 + off, bo + SB_K + i * 1024); if (outp) SC_GLDS(PQ + off, bo + SB_Q + i * 1024); }
    { const int row = 8 * w + (L >> 3), slot = L & 7, ch = slot ^ ((row >> 1) & 7); const unsigned off = (unsigned)(row * 128 + ch * 16);
        SC_GLDS(TMb + off, bo + SB_T + w * 1024); if (outp) SC_GLDS(PMb + off, bo + SB_P + w * 1024); }
    if (w < 4) { const int row = 16 * w + (L >> 2), c = L & 3, tok = tok0 + (d ? 63 - row : row);
        SC_GLDS(PQ + 4096 + ((unsigned)tok * 6144u + (unsigned)(h * 256 + v0 * 2 + 16 * c)), bo + SB_V + w * 1024); }
    else if (w == 4) SC_GLDS(GCB + mb * 256 + L * 4, bo + SB_G);
}
DI void scan_step(const Frame& F, int buf, int s, int b, int h, int d, int v0, f32x4 (&Sacc)[2], int mt, int nt, int fr, int fq) {
    LAS unsigned char* L = F.lds; LAS unsigned char* B = F.lds + buf * SB_SIZE;
    bf16* OD = (bf16*)(F.ws + WS_O) + (size_t)d * TL * D;
    int cid, outp; scan_chunk(s, b, d, cid, outp);
    const int tok0 = cid * 64;
    f32x4 aX = {0.f, 0.f, 0.f, 0.f}, aO = {0.f, 0.f, 0.f, 0.f};
#pragma unroll
    for (int ks = 0; ks < 4; ++ks) { const bf16x8 sb = *(const LAS bf16x8*)(L + SW_SBT + (16 * nt + fr) * 272 + (32 * ks + 8 * fq) * 2);
        const bf16x8 kA = *(const LAS bf16x8*)(B + SB_K + offb(16 * mt + fr, 4 * ks + fq));
        aX = __builtin_amdgcn_mfma_f32_16x16x32_bf16(kA, sb, aX, 0, 0, 0);
        if (outp) { const bf16x8 qA = *(const LAS bf16x8*)(B + SB_Q + offb(16 * mt + fr, 4 * ks + fq)); aO = __builtin_amdgcn_mfma_f32_16x16x32_bf16(sb, qA, aO, 0, 0, 0); } }
    const LAS unsigned char* Gr = B + SB_G + (16 * mt + 4 * fq) * 4;
    const f32x4 be = *(const LAS f32x4*)Gr, s1 = *(const LAS f32x4*)(Gr + 256), dr = *(const LAS f32x4*)(Gr + 768);
    float x[4];
#pragma unroll
    for (int r = 0; r < 4; ++r) { const float vv = bf2f(*(const LAS unsigned short*)(B + SB_V + (16 * mt + 4 * fq + r) * 64 + (16 * nt + fr) * 2));
        x[r] = vv * be[r] - s1[r] * aX[r]; }
    if (outp) { const float egj = *(const LAS float*)(B + SB_G + 512 + (16 * mt + fr) * 4); aO = aO * egj; }
    { u32x2 w; w.x = pk2(x[0], x[1]); w.y = pk2(x[2], x[3]); *(LAS u32x2*)(L + SW_XT + (16 * nt + fr) * 144 + (16 * mt + 4 * fq) * 2) = w; }
    SC_LBAR();
    f32x4 aV = {0.f, 0.f, 0.f, 0.f};
#pragma unroll
    for (int ks = 0; ks < 2; ++ks) { const bf16x8 xb = *(const LAS bf16x8*)(L + SW_XT + (16 * nt + fr) * 144 + (32 * ks + 8 * fq) * 2);
        const bf16x8 tA = *(const LAS bf16x8*)(B + SB_T + offt(16 * mt + fr, 4 * ks + fq));
        aV = __builtin_amdgcn_mfma_f32_16x16x32_bf16(tA, xb, aV, 0, 0, 0); }
    { u32x2 w; w.x = pk2(aV[0], aV[1]); w.y = pk2(aV[2], aV[3]); *(LAS u32x2*)(L + SW_VNT + (16 * nt + fr) * 144 + (16 * mt + 4 * fq) * 2) = w;
      w.x = pk2(aV[0] * dr[0], aV[1] * dr[1]); w.y = pk2(aV[2] * dr[2], aV[3] * dr[3]); *(LAS u32x2*)(L + SW_VDT + (16 * nt + fr) * 144 + (16 * mt + 4 * fq) * 2) = w; }
    SC_LBAR();
    const float decay = *(const LAS float*)(B + SB_G + 512 + 63 * 4);
    const int w8 = 2 * mt + nt;
    bf16x8 kt[2];
    { const unsigned q4 = (unsigned)fr >> 2, p4 = (unsigned)fr & 3u, kb = (unsigned)(size_t)(B + SB_K) + 8u * (p4 & 1u);
      const unsigned a00 = kb + offb(8 * fq + 0 + q4, 2 * w8 + (p4 >> 1)), a01 = kb + offb(8 * fq + 4 + q4, 2 * w8 + (p4 >> 1));
      const unsigned a10 = kb + offb(32 + 8 * fq + 0 + q4, 2 * w8 + (p4 >> 1)), a11 = kb + offb(32 + 8 * fq + 4 + q4, 2 * w8 + (p4 >> 1));
      s16x4 t00, t01, t10, t11;
      asm volatile("ds_read_b64_tr_b16 %0, %4\n\tds_read_b64_tr_b16 %1, %5\n\tds_read_b64_tr_b16 %2, %6\n\tds_read_b64_tr_b16 %3, %7\n\ts_waitcnt lgkmcnt(0)"
                   : "=&v"(t00), "=&v"(t01), "=&v"(t10), "=&v"(t11) : "v"(a00), "v"(a01), "v"(a10), "v"(a11) : "memory");
      kt[0] = (bf16x8){t00[0], t00[1], t00[2], t00[3], t01[0], t01[1], t01[2], t01[3]};
      kt[1] = (bf16x8){t10[0], t10[1], t10[2], t10[3], t11[0], t11[1], t11[2], t11[3]}; }
#pragma unroll
    for (int n = 0; n < 2; ++n) { Sacc[n] = Sacc[n] * decay;
#pragma unroll
        for (int ks = 0; ks < 2; ++ks) { const bf16x8 vd = *(const LAS bf16x8*)(L + SW_VDT + (16 * n + fr) * 144 + (32 * ks + 8 * fq) * 2);
            Sacc[n] = __builtin_amdgcn_mfma_f32_16x16x32_bf16(kt[ks], vd, Sacc[n], 0, 0, 0); } }
    if (outp) {
#pragma unroll
        for (int ks = 0; ks < 2; ++ks) { const bf16x8 vn = *(const LAS bf16x8*)(L + SW_VNT + (16 * nt + fr) * 144 + (32 * ks + 8 * fq) * 2);
            const bf16x8 pA = *(const LAS bf16x8*)(B + SB_P + offt(16 * mt + fr, 4 * ks + fq));
            aO = __builtin_amdgcn_mfma_f32_16x16x32_bf16(vn, pA, aO, 0, 0, 0); }
    }
#pragma unroll
    for (int n = 0; n < 2; ++n) { u32x2 w; w.x = pk2(Sacc[n][0], Sacc[n][1]); w.y = pk2(Sacc[n][2], Sacc[n][3]);
        *(LAS u32x2*)(L + SW_SBT + (16 * n + fr) * 272 + (16 * w8 + 4 * fq) * 2) = w; }
    if (outp) {
        { const int jc = 16 * mt + fr, tc = tok0 + (d ? 63 - jc : jc); u32x2 w; w.x = pk2(aO[0], aO[1]); w.y = pk2(aO[2], aO[3]);
          *(u32x2*)(OD + (size_t)tc * D + h * 128 + v0 + 16 * nt + 4 * fq) = w; }
        asm volatile("s_waitcnt vmcnt(1)" ::: "memory");
    } else asm volatile("s_waitcnt vmcnt(0)" ::: "memory");
    SC_LBAR();
}
DI void p10_scan(const Frame& F) {
    const int mt = F.wave >> 1, nt = F.wave & 1, fr = F.lane & 15, fq = F.lane >> 4;
    for (int u0 = F.bid; u0 < 256; u0 += F.G) {
        const int xcd = u0 & 7, qq = u0 >> 3, sl = qq & 3, chain = xcd + 8 * (qq >> 2);
        const int d = chain & 1, h = (chain >> 1) & 7, b = chain >> 4, v0 = sl * 32;
        for (int i = F.tid; i < 8704 / 4; i += NTHR) ((LAS unsigned*)(F.lds + SW_SBT))[i] = 0u;
        f32x4 Sacc[2] = {{0.f, 0.f, 0.f, 0.f}, {0.f, 0.f, 0.f, 0.f}};
        scan_issue(F, 0, 0, b, h, d, v0);
        asm volatile("s_waitcnt vmcnt(0)" ::: "memory");
        SC_LBAR();
        for (int s = 0; s < 132; ++s) {
            if (s + 1 < 132) scan_issue(F, (s + 1) & 1, s + 1, b, h, d, v0);
            scan_step(F, s & 1, s, b, h, d, v0, Sacc, mt, nt, fr, fq);
        }
    }
}

DI void p11_onorm(const Frame& F, const KP& p) {
    const int gw = F.bid * NWAVES + F.wave, NGW = F.G * NWAVES;
    const bf16* O0 = (const bf16*)(F.ws + WS_O); const bf16* O1 = O0 + (size_t)TL * D; const bf16* Z = (const bf16*)(F.ws + WS_Z); bf16* HX = (bf16*)(F.ws + WS_HX);
    for (int t = gw; t < TL; t += NGW) {
        const int c = 16 * F.lane;
        float o[16], zz[16]; float ss = 0.f;
#pragma unroll
        for (int q = 0; q < 2; ++q) { const u32x4 a = *(const u32x4*)(O0 + (size_t)t * D + c + 8 * q), bq = *(const u32x4*)(O1 + (size_t)t * D + c + 8 * q), zq = *(const u32x4*)(Z + (size_t)t * D + c + 8 * q);
            o[8 * q + 0] = bflo(a.x) + bflo(bq.x); o[8 * q + 1] = bfhi(a.x) + bfhi(bq.x); o[8 * q + 2] = bflo(a.y) + bflo(bq.y); o[8 * q + 3] = bfhi(a.y) + bfhi(bq.y);
            o[8 * q + 4] = bflo(a.z) + bflo(bq.z); o[8 * q + 5] = bfhi(a.z) + bfhi(bq.z); o[8 * q + 6] = bflo(a.w) + bflo(bq.w); o[8 * q + 7] = bfhi(a.w) + bfhi(bq.w);
            zz[8 * q + 0] = bflo(zq.x); zz[8 * q + 1] = bfhi(zq.x); zz[8 * q + 2] = bflo(zq.y); zz[8 * q + 3] = bfhi(zq.y); zz[8 * q + 4] = bflo(zq.z); zz[8 * q + 5] = bfhi(zq.z); zz[8 * q + 6] = bflo(zq.w); zz[8 * q + 7] = bfhi(zq.w); }
#pragma unroll
        for (int e = 0; e < 16; ++e) ss += o[e] * o[e];
        ss += __shfl_xor(ss, 1); ss += __shfl_xor(ss, 2); ss += __shfl_xor(ss, 4);
        const float rs = rsqrtf(ss * (1.f / 128.f) + EPS);
        const float* nw = p.in[15] + (c & 127);
        unsigned w[8];
#pragma unroll
        for (int e = 0; e < 8; ++e) w[e] = pk2(o[2 * e] * rs * nw[2 * e] * siluf(zz[2 * e]), o[2 * e + 1] * rs * nw[2 * e + 1] * siluf(zz[2 * e + 1]));
        *(u32x4*)(HX + (size_t)t * D + c) = (u32x4){w[0], w[1], w[2], w[3]}; *(u32x4*)(HX + (size_t)t * D + c + 8) = (u32x4){w[4], w[5], w[6], w[7]};
    }
}

DI void p16_final(const Frame& F, const KP& p, const LAS int* tb) {
    const int gw = F.bid * NWAVES + F.wave, NGW = F.G * NWAVES;
    const bf16* Y = (const bf16*)(F.ws + WS_Y); const Entry* TI = (const Entry*)(F.ws + WS_TI);
    for (int t = gw; t < TL; t += NGW) {
        const int r = t >> 13; float* xr = F.out + (size_t)t * D; const bf16* xi16 = (const bf16*)(F.ws + WS_XS3) + (size_t)t * D;
        const Entry ta = TI[(size_t)2 * t], tbb = TI[(size_t)2 * t + 1]; const float w0 = ta.w, w1 = tbb.w;
        const size_t r0 = ((size_t)tb[ta.ts >> 16] * 256 + (ta.ts & 0xffff)) * D, r1 = ((size_t)tb[tbb.ts >> 16] * 256 + (tbb.ts & 0xffff)) * D;
        f32x4 va[2], vb[2]; u32x4 y0[2], y1[2]; float s = 0.f;
#pragma unroll
        for (int i = 0; i < 2; ++i) { const int c = 8 * F.lane + 512 * i; unpk8(*(const u32x4*)(xi16 + c), va[i], vb[i]); y0[i] = *(const u32x4*)(Y + r0 + c); y1[i] = *(const u32x4*)(Y + r1 + c); }
#pragma unroll
        for (int i = 0; i < 2; ++i) { const int c = 8 * F.lane + 512 * i; f32x4 a0, b0, a1, b1; unpk8(y0[i], a0, b0); unpk8(y1[i], a1, b1);
            const float* gp = modp(F, 1, r, 5) + c;
            va[i] = va[i] + *(const f32x4*)gp * (a0 * w0 + a1 * w1); vb[i] = vb[i] + *(const f32x4*)(gp + 4) * (b0 * w0 + b1 * w1);
            s += (va[i].x * va[i].x + va[i].y * va[i].y) + (va[i].z * va[i].z + va[i].w * va[i].w) + (vb[i].x * vb[i].x + vb[i].y * vb[i].y) + (vb[i].z * vb[i].z + vb[i].w * vb[i].w); }
        const float rstd = rsqrtf(wave_sum(s) * (1.f / D) + EPS);
#pragma unroll
        for (int i = 0; i < 2; ++i) { const int c = 8 * F.lane + 512 * i; *(f32x4*)(xr + c) = va[i] * rstd * *(const f32x4*)(p.in[24] + c); *(f32x4*)(xr + c + 4) = vb[i] * rstd * *(const f32x4*)(p.in[24] + c + 4); }
    }
}

__global__ void __launch_bounds__(NTHR, 2) fwd_kernel(KP kp) {
    extern __shared__ __attribute__((aligned(16))) unsigned char lds_raw[];
    Frame F;
    F.lds = (LAS unsigned char*)lds_raw; F.tid = threadIdx.x; F.lane = F.tid & 63; F.wave = __builtin_amdgcn_readfirstlane(F.tid >> 6);
    F.bid = blockIdx.x; F.G = gridDim.x; F.ws = kp.ws; F.out = kp.out;
    volatile LAS unsigned* misc = (volatile LAS unsigned*)(F.lds + LDS_MISC);
    if (F.tid < 4) misc[F.tid] = 0u;
    __syncthreads();
    const int lo = kp.ph_lo, hi = kp.ph_hi;
    XcdBarrier bar; bar.bar = (unsigned*)(F.ws + WS_CTL) + CW_BAR; bar.x = 0; bar.st = misc;
    if (hi - lo > 1) bar = xcd_barrier_post((unsigned*)(F.ws + WS_CTL) + CW_BAR, misc);
#ifndef PHSEL
#define PHSEL 0x1FFFF
#endif
#define IN(k) (((PHSEL >> (k)) & 1) && lo <= (k) && (k) < hi)
#define SEAM(k) do { if (IN(k) && IN((k) + 1)) xcd_barrier(bar); } while (0)
    LAS int* tb = (LAS int*)(F.lds + LDS_MISC + 64); LAS int* cn = (LAS int*)(F.lds + LDS_MISC + 64 + 256);
    const float* MOD = (const float*)(F.ws + WS_MOD);

    if (IN(0)) { p0_prologue(F, kp); } SEAM(0);
    if (IN(1)) { p1_pool_diff(F, kp); __syncthreads(); convert_experts(F, kp, 0); } SEAM(1);
    if (IN(2)) { pg8::Gemm g{(const bf16*)(F.ws + WS_DD), (const bf16*)(F.ws + WS_BTP), 256}; PoolOrder S{F.G, F.bid};
        EpiRaw E{(bf16*)(F.ws + WS_YP), 1};
        pg8::gemm_phase<EpiRaw, PoolOrder, false>(F.lds, g, S, E); } SEAM(2);
    if (IN(3)) { p_router(F, kp, 0, T); } SEAM(3);
    if (IN(4)) { moe_tables(F, 0, tb, cn);
        pg8::Gemm g{(const bf16*)(F.ws + WS_HX), (const bf16*)(F.ws + WS_GU), 1024}; MoeOrder S{F.G, F.bid, tb[NE], tb, cn, (const Entry*)(F.ws + WS_ENT)};
        EpiGU E{(bf16*)(F.ws + WS_HID)};
        pg8::gemm_phase<EpiGU, MoeOrder, true>(F.lds, g, S, E); } SEAM(4);
    if (IN(5)) { moe_tables(F, 0, tb, cn);
        pg8::Gemm g{(const bf16*)(F.ws + WS_HID), (const bf16*)(F.ws + WS_DN), 512}; MoeOrder S{F.G, F.bid, tb[NE], tb, cn, (const Entry*)(F.ws + WS_ENT)};
        EpiDown E{(bf16*)(F.ws + WS_Y)};
        pg8::gemm_phase<EpiDown, MoeOrder, false>(F.lds, g, S, E); } SEAM(5);
    if (IN(6)) { moe_tables(F, 0, tb, cn); p6_n1(F, kp, tb); } SEAM(6);
    if (IN(7)) { pg8::Gemm g{(const bf16*)(F.ws + WS_HX), (const bf16*)(F.ws + WS_BTIN), 1024}; G1Order S{F.G, F.bid};
        EpiG1 E{(bf16*)(F.ws + WS_PQKV), (bf16*)(F.ws + WS_Z), (bf16*)(F.ws + WS_HALO), (float*)(F.ws + WS_AB)};
        pg8::gemm_phase<EpiG1, G1Order, false>(F.lds, g, S, E); } SEAM(7);
    if (IN(8)) { p8_c1a(F, kp); asm volatile("s_waitcnt vmcnt(0)" ::: "memory"); __syncthreads(); }
#ifdef PROBE_K
    SEAM(8);
#endif
    if (IN(9)) { p9_c1b(F); } SEAM(9);
    if (IN(10)) { p10_scan(F); } SEAM(10);
    if (IN(11)) { p11_onorm(F, kp); convert_experts(F, kp, 1); } SEAM(11);
    if (IN(12)) { pg8::Gemm g{(const bf16*)(F.ws + WS_HX), (const bf16*)(F.ws + WS_BTOUT), 1024}; G2Order S{F.G, F.bid};
        EpiRaw E{(bf16*)(F.ws + WS_Y2), 0};
        pg8::gemm_phase<EpiRaw, G2Order, false>(F.lds, g, S, E); } SEAM(12);
    if (IN(13)) { p_router(F, kp, 1, TL); } SEAM(13);
    if (IN(14)) { moe_tables(F, 1, tb, cn);
        pg8::Gemm g{(const bf16*)(F.ws + WS_HX), (const bf16*)(F.ws + WS_GU), 1024}; MoeOrder S{F.G, F.bid, tb[NE], tb, cn, (const Entry*)(F.ws + WS_ENT)};
        EpiGU E{(bf16*)(F.ws + WS_HID)};
        pg8::gemm_phase<EpiGU, MoeOrder, true>(F.lds, g, S, E); } SEAM(14);
    if (IN(15)) { moe_tables(F, 1, tb, cn);
        pg8::Gemm g{(const bf16*)(F.ws + WS_HID), (const bf16*)(F.ws + WS_DN), 512}; MoeOrder S{F.G, F.bid, tb[NE], tb, cn, (const Entry*)(F.ws + WS_ENT)};
        EpiDown E{(bf16*)(F.ws + WS_Y)};
        pg8::gemm_phase<EpiDown, MoeOrder, false>(F.lds, g, S, E); } SEAM(15);
    if (IN(16)) { moe_tables(F, 1, tb, cn); p16_final(F, kp, tb); }
#undef IN
#undef SEAM
}

extern "C" void kernel_launch(void* const* d_in, const int* in_sizes, int n_in, void* d_out, int out_size, void* d_ws, size_t ws_size, hipStream_t stream) {
    static int grid = 0;
    if (grid == 0) {
        if (n_in != 25 || out_size != TL * D || ws_size < WS_END) { fprintf(stderr, "kernel_launch: unexpected shapes (n_in %d, out %d, ws %zu < %zu)\n", n_in, out_size, ws_size, (size_t)WS_END); grid = -1; return; }
        int dev = 0, cus = 0, per_cu = 0;
        if (hipGetDevice(&dev) != hipSuccess || hipDeviceGetAttribute(&cus, hipDeviceAttributeMultiprocessorCount, dev) != hipSuccess) { grid = -1; return; }
        if (hipFuncSetAttribute((const void*)fwd_kernel, hipFuncAttributeMaxDynamicSharedMemorySize, LDS_BYTES) != hipSuccess) { fprintf(stderr, "kernel_launch: hipFuncSetAttribute failed\n"); grid = -1; return; }
        if (hipOccupancyMaxActiveBlocksPerMultiprocessor(&per_cu, (const void*)fwd_kernel, NTHR, LDS_BYTES) != hipSuccess || per_cu < 1) fprintf(stderr, "kernel_launch: occupancy query says %d\n", per_cu);
        (void)hipGetLastError();
        grid = cus;
    }
    if (grid < 0) return;
    (void)hipMemsetAsync((char*)d_ws + WS_CTL, 0, CTL_BYTES, stream);
    KP kp{};
    for (int i = 0; i < 25; ++i) kp.in[i] = (const float*)d_in[i];
    kp.out = (float*)d_out; kp.ws = (unsigned char*)d_ws;
#if MK_ONE_LAUNCH
    kp.ph_lo = 0; kp.ph_hi = PH_N;
    hipLaunchKernelGGL(fwd_kernel, dim3(grid), dim3(NTHR), LDS_BYTES, stream, kp);
#else
    for (int ph = 0; ph < PH_N; ++ph) { kp.ph_lo = ph; kp.ph_hi = ph + 1; hipLaunchKernelGGL(fwd_kernel, dim3(grid), dim3(NTHR), LDS_BYTES, stream, kp); }
#endif
}
```

```cpp
#include <hip/hip_runtime.h>
#include <cstdio>
#include <cstdint>

#ifndef MK_ONE_LAUNCH
#define MK_ONE_LAUNCH 1
#endif

#define GAS __attribute__((address_space(1)))
#define LAS __attribute__((address_space(3)))
typedef unsigned short bf16;
typedef short bf16x8 __attribute__((ext_vector_type(8)));
typedef short bf16x4 __attribute__((ext_vector_type(4)));
typedef float f32x4 __attribute__((ext_vector_type(4)));
typedef float f32x2 __attribute__((ext_vector_type(2)));
typedef unsigned u32x4 __attribute__((ext_vector_type(4)));
typedef unsigned u32x2 __attribute__((ext_vector_type(2)));
#define DI __device__ __forceinline__

constexpr int D = 1024, NB = 4, SEQ = 8192, CTXL = 256;
constexpr int TL = NB * SEQ;
constexpr int TC = NB * CTXL;
constexpr int T = TL + TC;
constexpr int NE = 32, DE = 512, NH = 8;
constexpr int NCID = 528;
constexpr int DN_IN = 4128;
constexpr float EPS = 1e-6f;
constexpr int CAP = T;
constexpr int NWAVES = 8, NTHR = 512;

constexpr size_t MiB = 1u << 20;
constexpr size_t WS_CTL = 0, CTL_BYTES = 1 * MiB;
constexpr size_t WS_BTP = 1 * MiB;
constexpr size_t WS_BTOUT = 1 * MiB + 512 * 1024;
constexpr size_t WS_BTIN = 3 * MiB + 512 * 1024;
constexpr size_t WS_MOD = 12 * MiB;
constexpr size_t WS_WRT = 12 * MiB + 256 * 1024;
constexpr size_t WS_WAB = 12 * MiB + 576 * 1024;
constexpr size_t WS_RSTD = 12 * MiB + 704 * 1024;
constexpr size_t WS_WR2 = 13 * MiB;
constexpr size_t WS_C0 = 13 * MiB + 512 * 1024;
constexpr size_t WS_XC = 14 * MiB;
constexpr size_t WS_TI = 18 * MiB;
constexpr size_t WS_GU = 20 * MiB;
constexpr size_t WS_DN = 84 * MiB;
constexpr size_t WS_TM = 20 * MiB;
constexpr size_t WS_AB = 86 * MiB;
constexpr size_t WS_HALO = 91 * MiB;
constexpr size_t WS_GCB = 101 * MiB;
constexpr size_t WS_HX = 116 * MiB;
constexpr size_t WS_PM = 116 * MiB;
constexpr size_t WS_XS1 = 182 * MiB;
constexpr size_t WS_XS3 = 472 * MiB;
constexpr size_t WS_DD = 182 * MiB;
constexpr size_t WS_YP = 248 * MiB;
constexpr size_t WS_Y2 = 380 * MiB;
constexpr size_t WS_HID = 248 * MiB;
constexpr size_t WS_Y = 322 * MiB;
constexpr size_t WS_PQKV = 182 * MiB;
constexpr size_t WS_Z = 380 * MiB;
constexpr size_t WS_LM = 444 * MiB;
constexpr size_t WS_O = 444 * MiB;
constexpr size_t WS_ENT = 572 * MiB;
constexpr size_t WS_END = 572 * MiB + (size_t)NE * CAP * 8;
static_assert(WS_END <= 581 * MiB, "ws map");
constexpr int CW_BAR = 4096;
constexpr int CW_CNT = 16384, CNT_STRIDE = 1024;
constexpr int LDS_BYTES = 147456;
constexpr int LDS_MISC = 139264;
constexpr int PH_N = 17;

struct Entry { int ts; float w; };
struct KP { const float* in[25]; float* out; unsigned char* ws; int ph_lo, ph_hi; };

typedef __bf16 hwbf2 __attribute__((ext_vector_type(2)));
DI unsigned f2bf(float f) { const __bf16 h = (__bf16)f; return (unsigned)__builtin_bit_cast(unsigned short, h); }
DI unsigned pk2(float lo, float hi) { const f32x2 v = {lo, hi}; const hwbf2 r = __builtin_convertvector(v, hwbf2); return __builtin_bit_cast(unsigned, r); }
DI float bflo(unsigned w) { return __builtin_bit_cast(float, w << 16); }
DI float bfhi(unsigned w) { return __builtin_bit_cast(float, w & 0xffff0000u); }
DI float bf2f(unsigned short b) { return __builtin_bit_cast(float, ((unsigned)b) << 16); }
DI void unpk8(const u32x4 q, f32x4& a, f32x4& b) { a = (f32x4){bflo(q.x), bfhi(q.x), bflo(q.y), bfhi(q.y)}; b = (f32x4){bflo(q.z), bfhi(q.z), bflo(q.w), bfhi(q.w)}; }
DI u32x4 pk8(const f32x4 a, const f32x4 b) { u32x4 q; q.x = pk2(a.x, a.y); q.y = pk2(a.z, a.w); q.z = pk2(b.x, b.y); q.w = pk2(b.z, b.w); return q; }
DI float wave_sum(float v) {
#pragma unroll
    for (int o = 1; o < 64; o <<= 1) v += __shfl_xor(v, o);
    return v;
}
DI float siluf(float x) { return x * __builtin_amdgcn_rcpf(1.f + __expf(-x)); }
DI float sigmoidf_(float x) { return __builtin_amdgcn_rcpf(1.f + __expf(-x)); }
DI float softplusf_(float x) { return fmaxf(x, 0.f) + log1pf(__expf(-fabsf(x))); }

#define XB_TMO      128
#define XB_XCNT(j)  (256  + 64 * (j))
#define XB_XSUB(j)  (1280 + 64 * (j))
#define XB_XGEN(j)  (2304 + 64 * (j))
#define XB_TOP      3328
#define XB_TOPGEN   3392
#define XCD_BAR_WORDS 3456
#define XB_SPIN_CAP (1u << 18)
__device__ __forceinline__ unsigned xb_ld(unsigned* p)              { return __hip_atomic_load(p, __ATOMIC_RELAXED, __HIP_MEMORY_SCOPE_AGENT); }
__device__ __forceinline__ unsigned xb_add(unsigned* p, unsigned v) { return __hip_atomic_fetch_add(p, v, __ATOMIC_RELAXED, __HIP_MEMORY_SCOPE_AGENT); }
__device__ __forceinline__ unsigned xb_xcc_id() { return (unsigned)__builtin_amdgcn_s_getreg((3 << 11) | 20) & 0xFu; }
#define XB_SPIN(cond, bar) do { unsigned _sp = 0; while (cond) { __builtin_amdgcn_s_sleep(1); \
    if ((++_sp & 255u) == 0u) { if (xb_ld(&(bar)[XB_TMO])) break; if (_sp > XB_SPIN_CAP) { atomicAdd(&(bar)[XB_TMO], 1u); break; } } } } while (0)
struct XcdBarrier { unsigned* bar; unsigned x; volatile LAS unsigned* st; };
__device__ __forceinline__ XcdBarrier xcd_barrier_post(unsigned* bar, volatile LAS unsigned* st) {
    XcdBarrier b; b.bar = bar; b.x = xb_xcc_id(); b.st = st;
    if (threadIdx.x == 0) (void)xb_add(&bar[XB_XCNT(b.x)], 1u);
    return b;
}
__device__ __forceinline__ void xcd_barrier_complete(unsigned* bar, unsigned x, unsigned& nloc, unsigned& nx) {
    const unsigned G = gridDim.x * gridDim.y * gridDim.z;
    unsigned sum, cnt, mine, sp = 0u;
    for (;;) {
        sum = 0u; cnt = 0u; mine = 0u;
#pragma unroll
        for (unsigned j = 0; j < 16; ++j) { const unsigned c = xb_ld(&bar[XB_XCNT(j)]); sum += c; cnt += (c > 0u) ? 1u : 0u; mine = (j == x) ? c : mine; }
        if (sum == G) break;
        __builtin_amdgcn_s_sleep(1);
        if ((++sp & 255u) == 0u) { if (xb_ld(&bar[XB_TMO])) break; if (sp > XB_SPIN_CAP) { atomicAdd(&bar[XB_TMO], 1u); break; } }
    }
    nloc = mine > 0u ? mine : 1u; nx = cnt > 0u ? cnt : 1u;
}
__device__ __forceinline__ void xcd_barrier(const XcdBarrier& b) {
    asm volatile("s_waitcnt vmcnt(0)" ::: "memory");
    __syncthreads();
    if (threadIdx.x == 0) {
        unsigned* bar = b.bar;
        __builtin_amdgcn_s_waitcnt(0);
        unsigned nloc = b.st[0], nx = b.st[1];
        if (nloc == 0u) { xcd_barrier_complete(bar, b.x, nloc, nx); b.st[0] = nloc; b.st[1] = nx; }
        const unsigned old = xb_add(&bar[XB_XSUB(b.x)], 1u);
        const unsigned gen = old / nloc;
        if (old + 1u == (gen + 1u) * nloc) {
            __builtin_amdgcn_fence(__ATOMIC_RELEASE, "agent");
            asm volatile("s_waitcnt vmcnt(0)" ::: "memory");
            const unsigned og = xb_add(&bar[XB_TOP], 1u);
            const unsigned tg = og / nx;
            if (og + 1u == (tg + 1u) * nx) xb_add(&bar[XB_TOPGEN], 1u);
            else XB_SPIN(xb_ld(&bar[XB_TOPGEN]) == tg, bar);
            __builtin_amdgcn_fence(__ATOMIC_ACQUIRE, "agent");
            xb_add(&bar[XB_XGEN(b.x)], 1u);
            asm volatile("s_waitcnt vmcnt(0)" ::: "memory");
        } else {
            XB_SPIN(xb_ld(&bar[XB_XGEN(b.x)]) == gen, bar);
            __builtin_amdgcn_fence(__ATOMIC_ACQUIRE, "agent");
            asm volatile("s_waitcnt vmcnt(0)" ::: "memory");
        }
    }
    __syncthreads();
}

namespace pg8 {
constexpr int BM = 256, BK = 64, HALF = 128, HTB = HALF * BK * 2, STAGE_BYTES = 8 * HTB;
DI int lds_byte(int r, int c) { const int st = (r >> 4) * 2 + (c >> 5), rr = r & 15, cc = c & 31, ob = rr * 64 + cc * 2; return st * 1024 + (ob ^ (((ob >> 9) & 1) << 5)); }
DI void stage_rc(int b, int& R, int& C) { const int st = b / 1024, sb = b % 1024, swz = sb ^ (((sb >> 9) & 1) << 5); R = (st >> 1) * 16 + swz / 64; C = (st & 1) * 32 + (swz % 64) / 2; }
DI int perm32(int rho) { const int n = rho >> 4, i = rho & 15; return 8 * (i >> 2) + 4 * n + (i & 3); }
struct Unit { int pm, pn, e, rt, nvalid; };
struct Gemm { const bf16* A; const bf16* Bt; int K; };

template <class Epi, class Sched, bool GATHER>
DI void gemm_phase(LAS unsigned char* lds, const Gemm g, const Sched& S, const Epi& E) {
    const int tid = threadIdx.x, wid = __builtin_amdgcn_readfirstlane(tid >> 6), lane = tid & 63, wr = wid >> 2, wc = wid & 3, fr = lane & 15, fq = lane >> 4;
    const int K = g.K, nt = K / BK;
    unsigned voffA[2], voffB[2]; int Rr[2], Cc[2];
#pragma unroll
    for (int i = 0; i < 2; ++i) { int R, C; stage_rc(tid * 16 + i * 8192, R, C); const int Rb = Epi::PERM ? ((R & ~31) + perm32(R & 31)) : R;
        voffA[i] = (unsigned)(R * K + C) * 2u; voffB[i] = (unsigned)((Epi::PERM ? (64 * (R >> 5) + perm32(R & 31)) : Rb) * K + C) * 2u; Rr[i] = R; Cc[i] = C; }
    const size_t kstep = (size_t)(BK * 2);
    const size_t hstep = (size_t)HALF * K * 2;
    const size_t tstep = 2 * hstep;
    const size_t hstepB = Epi::PERM ? (size_t)32 * K * 2 : hstep;
    const unsigned ldsw = (unsigned)wid * 1024u;
    const int aoff = lds_byte(wr * 64 + fr, fq * 8), boff = lds_byte(wc * 32 + fr, fq * 8);
#define PG8_SA(b, h) (((b) * 2 + (h)) * HTB)
#define PG8_SB(b, h) ((4 + (b) * 2 + (h)) * HTB)
#define PG8_STAGE(bufoff, gbase, voff) do { _Pragma("unroll") for (int _i = 0; _i < 2; ++_i) \
        __builtin_amdgcn_global_load_lds((const unsigned*)((const char*)(gbase) + (voff)[_i]), (LAS unsigned*)(lds + (bufoff) + ldsw + _i * 8192), 16, 0, 0); } while (0)
#define PG8_STAGE_A(bufoff, ptr, offs, h, kb) do { _Pragma("unroll") for (int _i = 0; _i < 2; ++_i) { \
        const char* _src = GATHER ? ((const char*)g.A + (offs)[(h) * 2 + _i] + (kb)) : ((const char*)(ptr) + voffA[_i]); \
        __builtin_amdgcn_global_load_lds((const unsigned*)_src, (LAS unsigned*)(lds + (bufoff) + ldsw + _i * 8192), 16, 0, 0); } } while (0)
#define PG8_LDA(dst, b, h) do { _Pragma("unroll") for (int m = 0; m < 4; ++m) _Pragma("unroll") for (int k = 0; k < 2; ++k) dst[m][k] = *(const LAS bf16x8*)(lds + PG8_SA(b, h) + aoff + m * 2048 + k * 1024); } while (0)
#define PG8_LDB(dst, b, h) do { _Pragma("unroll") for (int n = 0; n < 2; ++n) _Pragma("unroll") for (int k = 0; k < 2; ++k) dst[n][k] = *(const LAS bf16x8*)(lds + PG8_SB(b, h) + boff + n * 2048 + k * 1024); } while (0)
#define PG8_MMA(ai, bj, At, Bt) do { __builtin_amdgcn_s_setprio(1); _Pragma("unroll") for (int m = 0; m < 4; ++m) _Pragma("unroll") for (int n = 0; n < 2; ++n) _Pragma("unroll") for (int k = 0; k < 2; ++k) \
        acc[ai][bj][m][n] = __builtin_amdgcn_mfma_f32_16x16x32_bf16(Bt[n][k], At[m][k], acc[ai][bj][m][n], 0, 0, 0); __builtin_amdgcn_s_setprio(0); } while (0)
#define PG8_WAIT_V(n) asm volatile("s_waitcnt vmcnt(" #n ")" ::: "memory")
#define PG8_WAIT_L(n) asm volatile("s_waitcnt lgkmcnt(" #n ")" ::: "memory")
#define PG8_BAR __builtin_amdgcn_s_barrier()
#define PG8_SCHED __builtin_amdgcn_sched_barrier(0)
#define PG8_OFFS(u, o) do { _Pragma("unroll") for (int _h = 0; _h < 2; ++_h) _Pragma("unroll") for (int _i = 0; _i < 2; ++_i) (o)[_h * 2 + _i] = S.row_off((u), _h * HALF + Rr[_i]) + (unsigned)Cc[_i] * 2u; } while (0)
    Unit cur, nxt; int ui = 0;
    if (!S.next(0, cur)) return;
    f32x4 acc[2][2][4][2];
#pragma unroll
    for (int a = 0; a < 2; ++a)
#pragma unroll
        for (int b = 0; b < 2; ++b)
#pragma unroll
            for (int m = 0; m < 4; ++m)
#pragma unroll
                for (int n = 0; n < 2; ++n) acc[a][b][m][n] = (f32x4){0.f, 0.f, 0.f, 0.f};
    bf16x8 At[4][2], B0[2][2], B1[2][2];
    unsigned oc[4] = {0u, 0u, 0u, 0u}, on[4] = {0u, 0u, 0u, 0u};
    const char* cA = GATHER ? (const char*)g.A : (const char*)g.A + (size_t)cur.pm * tstep; const char* cB = (const char*)g.Bt + (size_t)cur.pn * tstep;
    if (GATHER) PG8_OFFS(cur, oc);
    PG8_STAGE(PG8_SB(0, 0), cB, voffB); PG8_STAGE_A(PG8_SA(0, 0), cA, oc, 0, 0); PG8_STAGE(PG8_SB(0, 1), cB + hstepB, voffB); PG8_STAGE_A(PG8_SA(0, 1), cA + hstep, oc, 1, 0);
    if (wr == 1) PG8_BAR;
    PG8_WAIT_V(4); PG8_BAR;
    PG8_STAGE(PG8_SB(1, 0), cB + kstep, voffB); PG8_STAGE_A(PG8_SA(1, 0), cA + kstep, oc, 0, kstep); PG8_STAGE(PG8_SB(1, 1), cB + hstepB + kstep, voffB);
    PG8_WAIT_V(6); PG8_BAR;
    for (;;) {
        const bool has_next = S.next(ui + 1, nxt);
        const char* nA = GATHER ? cA : (has_next ? (const char*)g.A + (size_t)nxt.pm * tstep : cA); const char* nB = has_next ? (const char*)g.Bt + (size_t)nxt.pn * tstep : cB;
        if (GATHER) { if (has_next) PG8_OFFS(nxt, on); else {
#pragma unroll
            for (int q = 0; q < 4; ++q) on[q] = oc[q]; } }
        for (int t = 0; t < nt; t += 2) {
            const bool last = (t == nt - 2);
            const char* a1 = cA + (size_t)(t + 1) * kstep;
            const char* a2 = last ? nA : cA + (size_t)(t + 2) * kstep; const char* b2 = last ? nB : cB + (size_t)(t + 2) * kstep;
            const char* a3 = a2 + kstep; const char* b3 = b2 + kstep;
            const size_t k1 = (size_t)(t + 1) * kstep, k2 = last ? (size_t)0 : (size_t)(t + 2) * kstep, k3 = k2 + kstep;
            unsigned o2[4];
#pragma unroll
            for (int q = 0; q < 4; ++q) o2[q] = last ? on[q] : oc[q];
            PG8_LDB(B0, 0, 0); PG8_SCHED; PG8_LDA(At, 0, 0); PG8_STAGE_A(PG8_SA(1, 1), a1 + hstep, oc, 1, k1);
            PG8_WAIT_L(8); PG8_BAR; PG8_WAIT_L(0); PG8_MMA(0, 0, At, B0); PG8_BAR; PG8_SCHED;
            PG8_LDB(B1, 0, 1); PG8_STAGE(PG8_SB(0, 0), b2, voffB);
            PG8_BAR; PG8_WAIT_L(0); PG8_MMA(0, 1, At, B1); PG8_BAR;
            PG8_LDA(At, 0, 1); PG8_STAGE_A(PG8_SA(0, 0), a2, o2, 0, k2);
            PG8_BAR; PG8_WAIT_L(0); PG8_MMA(1, 0, At, B0); PG8_BAR; PG8_SCHED;
            PG8_STAGE(PG8_SB(0, 1), b2 + hstepB, voffB);
            PG8_WAIT_V(6); PG8_BAR; PG8_MMA(1, 1, At, B1); PG8_BAR;
            PG8_LDB(B0, 1, 0); PG8_SCHED; PG8_LDA(At, 1, 0); PG8_STAGE_A(PG8_SA(0, 1), a2 + hstep, o2, 1, k2);
            PG8_WAIT_L(8); PG8_BAR; PG8_WAIT_L(0); PG8_MMA(0, 0, At, B0); PG8_BAR; PG8_SCHED;
            PG8_LDB(B1, 1, 1); PG8_STAGE(PG8_SB(1, 0), b3, voffB);
            PG8_BAR; PG8_WAIT_L(0); PG8_MMA(0, 1, At, B1); PG8_BAR;
            PG8_LDA(At, 1, 1); PG8_STAGE_A(PG8_SA(1, 0), a3, o2, 0, k3);
            PG8_BAR; PG8_WAIT_L(0); PG8_MMA(1, 0, At, B0); PG8_BAR; PG8_SCHED;
            PG8_STAGE(PG8_SB(1, 1), b3 + hstepB, voffB);
            PG8_WAIT_V(6); PG8_BAR; PG8_MMA(1, 1, At, B1); PG8_BAR;
        }
        E(acc, cur, wr, wc, fr, fq);
        if (!has_next) break;
#pragma unroll
        for (int a = 0; a < 2; ++a)
#pragma unroll
            for (int b = 0; b < 2; ++b)
#pragma unroll
                for (int m = 0; m < 4; ++m)
#pragma unroll
                    for (int n = 0; n < 2; ++n) acc[a][b][m][n] = (f32x4){0.f, 0.f, 0.f, 0.f};
        cur = nxt; cA = nA; cB = nB; ++ui;
#pragma unroll
        for (int q = 0; q < 4; ++q) oc[q] = on[q];
    }
    PG8_WAIT_V(0);
    if (wr == 0) PG8_BAR;
    PG8_BAR;
#undef PG8_SA
#undef PG8_SB
#undef PG8_STAGE
#undef PG8_STAGE_A
#undef PG8_LDA
#undef PG8_LDB
#undef PG8_MMA
#undef PG8_WAIT_V
#undef PG8_WAIT_L
#undef PG8_BAR
#undef PG8_SCHED
#undef PG8_OFFS
}
}
using pg8::Unit;

struct Frame {
    LAS unsigned char* lds;
    int tid, lane, wave, bid, G;
    unsigned char* ws; float* out;
};
DI float* xs_row(const Frame& F, int t) { return t < TL ? F.out + (size_t)t * D : (float*)(F.ws + WS_XC) + (size_t)(t - TL) * D; }
DI int mod_row(int t) { return t < TL ? (t >> 13) : 4; }
DI const float* modp(const Frame& F, int l, int r, int chunk) { return (const float*)(F.ws + WS_MOD) + ((size_t)(l * 5 + r) * 6 + chunk) * D; }

DI void tr_item(const float* W, int N, int k0, int n0, bf16* WT, int K, int drow0, LAS float* scr, int lane) {
    float wv[32];
#pragma unroll
    for (int i = 0; i < 32; ++i) wv[i] = __builtin_nontemporal_load(W + (size_t)(k0 + 2 * i + (lane >> 5)) * N + n0 + (lane & 31));
#pragma unroll
    for (int i = 0; i < 32; ++i) scr[(2 * i + (lane >> 5)) * 33 + (lane & 31)] = wv[i];
    asm volatile("s_waitcnt lgkmcnt(0)" ::: "memory");
    const int c = lane & 7;
#pragma unroll
    for (int j = 0; j < 4; ++j) { const int n = (lane >> 3) + 8 * j; const LAS float* s = scr + (8 * c) * 33 + n;
        u32x4 o; o.x = pk2(s[0 * 33], s[1 * 33]); o.y = pk2(s[2 * 33], s[3 * 33]); o.z = pk2(s[4 * 33], s[5 * 33]); o.w = pk2(s[6 * 33], s[7 * 33]);
        *(u32x4*)(WT + (size_t)(drow0 + n) * K + k0 + 8 * c) = o; }
    asm volatile("s_waitcnt lgkmcnt(0)" ::: "memory");
}
DI void convert_experts(const Frame& F, const KP& p, int l) {
    LAS float* scr = (LAS float*)(F.lds + F.wave * 16384);
    const int gw = F.bid * NWAVES + F.wave, NGW = F.G * NWAVES;
    const float* wg = p.in[21] + (size_t)l * NE * D * DE; const float* wu = p.in[22] + (size_t)l * NE * D * DE; const float* wd = p.in[23] + (size_t)l * NE * DE * D;
    bf16* GU = (bf16*)(F.ws + WS_GU); bf16* DN = (bf16*)(F.ws + WS_DN);
    for (int it = gw; it < 3 * 8192; it += NGW) {
        const int which = it >> 13, r8 = it & 8191, e = r8 >> 8, r = r8 & 255;
        if (which < 2) { const int kb = r >> 4, nb = r & 15, n0 = 32 * nb;
            tr_item((which ? wu : wg) + (size_t)e * D * DE, DE, 64 * kb, n0, GU, D, e * 1024 + 256 * (n0 >> 7) + 64 * ((n0 & 127) >> 5) + (which ? 32 : 0), scr, F.lane); }
        else { const int kb = r >> 5, nb = r & 31, n0 = 32 * nb;
            tr_item(wd + (size_t)e * DE * D, D, 64 * kb, n0, DN, DE, e * 1024 + n0, scr, F.lane); }
    }
}
DI void p0_prologue(const Frame& F, const KP& p) {
    const int gw = F.bid * NWAVES + F.wave, NGW = F.G * NWAVES;
    {
        LAS float* sc = (LAS float*)(F.lds);
        LAS float* part = (LAS float*)(F.lds + 32768);
        for (int i = F.tid; i < 5 * D; i += NTHR) { const int r = i >> 10, k = i & 1023; const float v = r < 4 ? p.in[1][r * D + k] : p.in[3][k]; sc[i] = siluf(v); }
        __syncthreads();
        for (int item = F.bid; item < 192; item += F.G) {
            const int l = item / 96, n0 = (item % 96) * 64;
            const float* w = p.in[4] + (size_t)l * D * 6144 + n0 + F.lane;
            float a0 = 0.f, a1 = 0.f, a2 = 0.f, a3 = 0.f, a4 = 0.f;
            const int kb = F.wave * 128;
#pragma unroll 32
            for (int k = 0; k < 128; ++k) { const float wv = __builtin_nontemporal_load(w + (size_t)(kb + k) * 6144);
                a0 += sc[kb + k] * wv; a1 += sc[D + kb + k] * wv; a2 += sc[2 * D + kb + k] * wv; a3 += sc[3 * D + kb + k] * wv; a4 += sc[4 * D + kb + k] * wv; }
            part[(F.wave * 5 + 0) * 64 + F.lane] = a0; part[(F.wave * 5 + 1) * 64 + F.lane] = a1; part[(F.wave * 5 + 2) * 64 + F.lane] = a2;
            part[(F.wave * 5 + 3) * 64 + F.lane] = a3; part[(F.wave * 5 + 4) * 64 + F.lane] = a4;
            __syncthreads();
            if (F.tid < 320) { const int r = F.tid >> 6, n = F.tid & 63; float s = p.in[5][l * 6144 + n0 + n];
#pragma unroll
                for (int w8 = 0; w8 < 8; ++w8) s += part[(w8 * 5 + r) * 64 + n];
                ((float*)(F.ws + WS_MOD))[(size_t)(l * 5 + r) * 6144 + n0 + n] = s; }
            __syncthreads();
        }
        __syncthreads();
    }
    {
        LAS float* scr = (LAS float*)(F.lds + F.wave * 16384);
        constexpr int I_POOL = 128, I_IN = 2048 + 16, I_OUT = 512;
        for (int it = gw; it < I_POOL + I_IN + I_OUT; it += NGW) {
            int r = it;
            if (r < I_POOL) { const int g = r >> 5, q = r & 31, kb = q >> 3, nb = q & 7; tr_item(p.in[8] + (size_t)g * 65536, 256, 64 * kb, 32 * nb, (bf16*)(F.ws + WS_BTP), 256, g * 256 + 32 * nb, scr, F.lane); continue; }
            r -= I_POOL;
            if (r < I_IN) { const int kb = r < 2048 ? (r >> 7) : (r - 2048), nb = r < 2048 ? (r & 127) : 128; tr_item(p.in[11], DN_IN, 64 * kb, 32 * nb, (bf16*)(F.ws + WS_BTIN), D, 32 * nb, scr, F.lane); continue; }
            r -= I_IN;
            { const int kb = r >> 5, nb = r & 31; tr_item(p.in[16], D, 64 * kb, 32 * nb, (bf16*)(F.ws + WS_BTOUT), D, 32 * nb, scr, F.lane); }
        }
    }
    {
        const int gt = F.bid * NTHR + F.tid, NGT = F.G * NTHR;
        bf16* wr2 = (bf16*)(F.ws + WS_WR2);
        for (int i = gt; i < 2 * 48 * D; i += NGT) { const int l = i / (48 * D), r = i % (48 * D), j = r >> 10, k = r & 1023;
            const float w = j < 4 ? p.in[17][((size_t)l * D + k) * 4 + j] : (j < 36 ? p.in[19][((size_t)l * D + k) * 32 + (j - 4)] : 0.f);
            const unsigned hi = f2bf(w); const float rem = w - bf2f((unsigned short)hi);
            wr2[(size_t)(l * 2 + 0) * 48 * D + r] = (bf16)hi; wr2[(size_t)(l * 2 + 1) * 48 * D + r] = (bf16)f2bf(rem); }
        u32x4* zr = (u32x4*)((bf16*)(F.ws + WS_BTIN) + (size_t)4128 * D);
        for (int i = gt; i < 224 * D / 8; i += NGT) zr[i] = (u32x4){0u, 0u, 0u, 0u};
    }
    {
        float* rs = (float*)(F.ws + WS_RSTD);
        for (int t = gw; t < T; t += NGW) {
            const f32x4* xr = (const f32x4*)(t < TL ? p.in[0] + (size_t)t * D : p.in[2] + (size_t)(t - TL) * D) + F.lane;
            float s = 0.f;
#pragma unroll
            for (int j = 0; j < 4; ++j) { const f32x4 v = xr[64 * j]; s += (v.x * v.x + v.y * v.y) + (v.z * v.z + v.w * v.w); }
            s = wave_sum(s);
            if (F.lane == 0) rs[t] = rsqrtf(s * (1.f / D) + EPS);
        }
    }
}

DI void p1_pool_diff(const Frame& F, const KP& p) {
    const float* rs = (const float*)(F.ws + WS_RSTD);
    bf16* DD = (bf16*)(F.ws + WS_DD);
    LAS f32x4* Vs = (LAS f32x4*)(F.lds);
    const int ch4 = F.tid & 63, cg = F.tid >> 6;
    {
        const int gw = F.bid * NWAVES + F.wave;
        if (gw < 2 * 5 * 36) { const int l = gw / 180, q = gw % 180, r = q / 36, j = q % 36; const float* b2 = modp(F, l, r, 3); float s = 0.f;
            for (int i = 0; i < 16; ++i) { const int c = F.lane + 64 * i; const float w = j < 4 ? p.in[17][((size_t)l * D + c) * 4 + j] : p.in[19][((size_t)l * D + c) * 32 + (j - 4)]; s += b2[c] * w; }
            s = wave_sum(s);
            if (F.lane == 0) ((float*)(F.ws + WS_C0))[(l * 5 + r) * 48 + j] = s + (j < 4 ? p.in[18][l * 4 + j] : p.in[20][l * 32 + (j - 4)]); }
    }
    LAS float* rsl = (LAS float*)(F.lds + 65536);
    for (int it = F.bid; it < 256 + 64; it += F.G) {
        if (it < 256) {
            const int g = it & 3, bb = it >> 2, b = bb >> 4, r0 = (bb & 15) * 8, hw = 1 << g;
            const int ch = g * 256 + 4 * ch4;
            f32x4 A4 = *(const f32x4*)(p.in[6] + ch); { const f32x4 s4 = *(const f32x4*)(modp(F, 0, b, 1) + ch); A4 = A4 * (s4 + 1.f); }
            const int rlo = max(r0 - hw, 0), rhi = min(r0 + 8 + hw, 128);
            for (int i = F.tid; i < (rhi - rlo) * 64; i += NTHR) rsl[i] = rs[b * SEQ + rlo * 64 + i];
            __syncthreads();
            const float* xb = p.in[0] + (size_t)b * SEQ * D + ch + (size_t)(8 * cg) * D;
            f32x4 S[8];
#pragma unroll
            for (int cc = 0; cc < 8; ++cc) S[cc] = (f32x4){0.f, 0.f, 0.f, 0.f};
            for (int rr = rlo; rr < min(r0 + hw, 128); ++rr) {
#pragma unroll
                for (int cc = 0; cc < 8; ++cc) S[cc] += *(const f32x4*)(xb + (size_t)(rr * 64 + cc) * D) * rsl[(rr - rlo) * 64 + 8 * cg + cc]; }
            for (int r = r0; r < r0 + 8; ++r) {
                const int lo_r = max(r - hw, 0), hi_r = min(r + hw, 128);
                f32x4 xc[8], xa[8], xs_[8];
                const bool ha = (r + hw) < 128, hs = (r - hw) >= 0;
#pragma unroll
                for (int cc = 0; cc < 8; ++cc) { xc[cc] = *(const f32x4*)(xb + (size_t)(r * 64 + cc) * D);
                    xa[cc] = ha ? *(const f32x4*)(xb + (size_t)((r + hw) * 64 + cc) * D) : (f32x4){0.f, 0.f, 0.f, 0.f};
                    xs_[cc] = hs ? *(const f32x4*)(xb + (size_t)((r - hw) * 64 + cc) * D) : (f32x4){0.f, 0.f, 0.f, 0.f}; }
#pragma unroll
                for (int cc = 0; cc < 8; ++cc) Vs[(8 * cg + cc) * 64 + ch4] = S[cc];
                __syncthreads();
                f32x4 h = {0.f, 0.f, 0.f, 0.f};
                { const int c0 = 8 * cg, l0 = max(c0 - hw, 0), h0 = min(c0 + hw, 64); for (int c2 = l0; c2 < h0; ++c2) h += Vs[c2 * 64 + ch4]; }
#pragma unroll
                for (int cc = 0; cc < 8; ++cc) { const int col = 8 * cg + cc, lo_c = max(col - hw, 0), hi_c = min(col + hw, 64);
                    if (cc > 0) { if (col + hw <= 64) h += Vs[(col + hw - 1) * 64 + ch4]; if (col - hw > 0) h -= Vs[(col - hw - 1) * 64 + ch4]; }
                    const int t = b * SEQ + r * 64 + col; const float inv = __builtin_amdgcn_rcpf((float)((hi_r - lo_r) * (hi_c - lo_c)));
                    const f32x4 xn = xc[cc] * rsl[(r - rlo) * 64 + col];
                    const f32x4 d = A4 * (h * inv - xn);
                    u32x2 o; o.x = pk2(d.x, d.y); o.y = pk2(d.z, d.w);
                    *(u32x2*)(DD + ((size_t)g * T + t) * 256 + 4 * ch4) = o; }
#pragma unroll
                for (int cc = 0; cc < 8; ++cc) { if (ha) S[cc] += xa[cc] * rsl[(r + hw - rlo) * 64 + 8 * cg + cc]; if (hs) S[cc] -= xs_[cc] * rsl[(r - hw - rlo) * 64 + 8 * cg + cc]; }
                __syncthreads();
            }
        } else {
            const int i2 = it - 256, g = i2 & 3, b = (i2 >> 2) & 3, q4 = i2 >> 4, hw = 1 << g;
            const int ch = g * 256 + 4 * ch4;
            f32x4 A4 = *(const f32x4*)(p.in[6] + ch); { const f32x4 s4 = *(const f32x4*)(modp(F, 0, 4, 1) + ch); A4 = A4 * (s4 + 1.f); }
#pragma unroll
            for (int cc = 0; cc < 8; ++cc) { const int j = 64 * q4 + 8 * cg + cc, lo = max(j - hw, 0), hi = min(j + hw, CTXL); f32x4 a = {0.f, 0.f, 0.f, 0.f};
                for (int jj = lo; jj < hi; ++jj) a += *(const f32x4*)(p.in[2] + (size_t)(b * CTXL + jj) * D + ch) * rs[TL + b * CTXL + jj];
                const int t = TL + b * CTXL + j; const float inv = 1.f / (float)(hi - lo);
                const f32x4 xn = *(const f32x4*)(p.in[2] + (size_t)(b * CTXL + j) * D + ch) * rs[t];
                const f32x4 d = A4 * (a * inv - xn);
                u32x2 o; o.x = pk2(d.x, d.y); o.y = pk2(d.z, d.w);
                *(u32x2*)(DD + ((size_t)g * T + t) * 256 + 4 * ch4) = o; }
        }
    }
}

struct PoolOrder {
    int G, c;
    DI bool next(int i, Unit& u) const { const int L = i * G + c; if (L >= 528) return false; u.pm = L; u.pn = L / 132; u.e = 0; u.rt = 0; u.nvalid = 0; return true; }
    DI unsigned row_off(const Unit&, int) const { return 0u; }
};
struct G1Order {
    int G, c;
    DI bool next(int i, Unit& u) const {
        if (G == 256) { if (i < 8) { const int x = c & 7, j = c >> 3; u.pm = (i * 8 + x) * 2 + (j >> 4); u.pn = j & 15; }
            else { const int q = (i - 8) * 256 + c; if (q >= 48 + 132) return false; if (q < 48) { u.pm = 128 + q / 12; u.pn = q % 12; } else { u.pm = q - 48; u.pn = 16; } } }
        else { const int L = i * G + c; if (L >= 2176 + 52) return false;
            if (L < 2176) { u.pm = L / 17; u.pn = L % 17; } else { const int q = L - 2176, q13 = q % 13; u.pm = 128 + q / 13; u.pn = q13 < 12 ? q13 : 16; } }
        u.e = 0; u.rt = 0; u.nvalid = 0; return true; }
    DI unsigned row_off(const Unit&, int) const { return 0u; }
};
struct G2Order {
    int G, c;
    DI bool next(int i, Unit& u) const {
        if (G == 256) { if (i >= 2) return false; const int x = c & 7, j = c >> 3; u.pm = (i * 8 + x) * 8 + (j >> 2); u.pn = j & 3; }
        else { const int L = i * G + c; if (L >= 512) return false; u.pm = L >> 2; u.pn = L & 3; }
        u.e = 0; u.rt = 0; u.nvalid = 0; return true; }
    DI unsigned row_off(const Unit&, int) const { return 0u; }
};
struct MoeOrder {
    int G, c, total; const LAS int* tb; const LAS int* cn; const Entry* ent;
    DI bool next(int i, Unit& u) const { int rtg, ct;
        if (G == 256) { const int x = c & 7, j = c >> 3; ct = j & 3; rtg = 64 * i + 8 * x + (j >> 2); if (rtg >= total) return false; }
        else { const int L = i * G + c; if (L >= 4 * total) return false; rtg = L >> 2; ct = L & 3; }
        int e = 0;
        for (int q = 1; q < NE; ++q) e += (tb[q] <= rtg) ? 1 : 0;
        u.pm = rtg; u.pn = e * 4 + ct; u.e = e; u.rt = rtg - tb[e]; u.nvalid = cn[e] - u.rt * 256; return true; }
    DI unsigned row_off(const Unit& u, int row) const { int tok = 0; if (row < u.nvalid) tok = ent[(size_t)u.e * CAP + u.rt * 256 + row].ts >> 1; return (unsigned)tok * (unsigned)(D * 2); }
};
DI void moe_tables(const Frame& F, int l, LAS int* tb, LAS int* cn) {
    if (F.tid < 64) { const unsigned* cnt = (const unsigned*)(F.ws + WS_CTL) + CW_CNT + l * 32 * CNT_STRIDE;
        const int c = F.tid < NE ? (int)__hip_atomic_load(cnt + F.tid * CNT_STRIDE, __ATOMIC_RELAXED, __HIP_MEMORY_SCOPE_AGENT) : 0;
        const int ntl = (c + 255) >> 8; int inc = ntl;
#pragma unroll
        for (int o = 1; o < 32; o <<= 1) { const int up = __shfl_up(inc, o); if (F.lane >= o) inc += up; }
        if (F.tid < NE) { cn[F.tid] = c; tb[F.tid] = inc - ntl; if (F.tid == NE - 1) tb[NE] = inc; } }
    __syncthreads();
}

struct EpiRaw {
    static constexpr bool PERM = true;
    bf16* o; int pool;
    DI void operator()(const f32x4 (&acc)[2][2][4][2], const Unit& u, int, int, int, int) const {
        int tz = threadIdx.x; asm volatile("" : "+v"(tz)); const int wr = tz >> 8, wc = (tz >> 6) & 3, fr = tz & 15, fq = (tz >> 4) & 3;
        const int rt = pool ? u.pm - 132 * u.pn : u.pm;
#pragma unroll
        for (int ai = 0; ai < 2; ++ai)
#pragma unroll
            for (int m = 0; m < 4; ++m) { bf16* dst = o + (size_t)(rt * 256 + ai * 128 + wr * 64 + m * 16 + fr) * D + u.pn * 256 + wc * 64 + 8 * fq;
#pragma unroll
                for (int bj = 0; bj < 2; ++bj) { const f32x4 v0 = acc[ai][bj][m][0], v1 = acc[ai][bj][m][1];
                    u32x4 w; w.x = pk2(v0.x, v0.y); w.y = pk2(v0.z, v0.w); w.z = pk2(v1.x, v1.y); w.w = pk2(v1.z, v1.w);
                    *(u32x4*)(dst + bj * 32) = w; } }
    }
};
struct EpiGU {
    static constexpr bool PERM = true;
    bf16* hid;
    DI void operator()(const f32x4 (&acc)[2][2][4][2], const Unit& u, int, int, int, int) const {
        int tz = threadIdx.x; asm volatile("" : "+v"(tz)); const int wr = tz >> 8, wc = (tz >> 6) & 3, fr = tz & 15, fq = (tz >> 4) & 3;
        const int ct = u.pn & 3;
#pragma unroll
        for (int ai = 0; ai < 2; ++ai)
#pragma unroll
            for (int m = 0; m < 4; ++m) { const size_t row = (size_t)u.pm * 256 + ai * 128 + wr * 64 + m * 16 + fr;
                const f32x4 g0 = acc[ai][0][m][0], g1 = acc[ai][0][m][1], u0 = acc[ai][1][m][0], u1 = acc[ai][1][m][1];
                u32x4 w; w.x = pk2(siluf(g0.x) * u0.x, siluf(g0.y) * u0.y); w.y = pk2(siluf(g0.z) * u0.z, siluf(g0.w) * u0.w);
                w.z = pk2(siluf(g1.x) * u1.x, siluf(g1.y) * u1.y); w.w = pk2(siluf(g1.z) * u1.z, siluf(g1.w) * u1.w);
                *(u32x4*)(hid + row * DE + ct * 128 + wc * 32 + 8 * fq) = w; }
    }
};
struct EpiDown {
    static constexpr bool PERM = true;
    bf16* y;
    DI void operator()(const f32x4 (&acc)[2][2][4][2], const Unit& u, int, int, int, int) const {
        int tz = threadIdx.x; asm volatile("" : "+v"(tz)); const int wr = tz >> 8, wc = (tz >> 6) & 3, fr = tz & 15, fq = (tz >> 4) & 3;
        const int ct = u.pn & 3;
#pragma unroll
        for (int ai = 0; ai < 2; ++ai)
#pragma unroll
            for (int m = 0; m < 4; ++m) { const size_t row = (size_t)u.pm * 256 + ai * 128 + wr * 64 + m * 16 + fr;
                bf16* dst = y + row * D + ct * 256 + wc * 64 + 8 * fq;
#pragma unroll
                for (int bj = 0; bj < 2; ++bj) { const f32x4 v0 = acc[ai][bj][m][0], v1 = acc[ai][bj][m][1];
                    u32x4 w; w.x = pk2(v0.x, v0.y); w.y = pk2(v0.z, v0.w); w.z = pk2(v1.x, v1.y); w.w = pk2(v1.z, v1.w);
                    *(u32x4*)(dst + bj * 32) = w; } }
    }
};
struct EpiG1 {
    static constexpr bool PERM = true;
    bf16* pqkv; bf16* z; bf16* halo; float* ab;
    DI void operator()(const f32x4 (&acc)[2][2][4][2], const Unit& u, int, int, int, int) const {
        int tz = threadIdx.x; asm volatile("" : "+v"(tz)); const int wr = tz >> 8, wc = (tz >> 6) & 3, fr = tz & 15, fq = (tz >> 4) & 3;
#pragma unroll
        for (int ai = 0; ai < 2; ++ai)
#pragma unroll
            for (int m = 0; m < 4; ++m) { const int t = u.pm * 256 + ai * 128 + wr * 64 + m * 16 + fr, rr = m * 16 + fr;
#pragma unroll
                for (int bj = 0; bj < 2; ++bj) { const f32x4 v0 = acc[ai][bj][m][0], v1 = acc[ai][bj][m][1];
                    u32x4 w; w.x = pk2(v0.x, v0.y); w.y = pk2(v0.z, v0.w); w.z = pk2(v1.x, v1.y); w.w = pk2(v1.z, v1.w);
                    const int col = u.pn * 256 + wc * 64 + bj * 32 + 8 * fq;
                    if (u.pn < 12) { *(u32x4*)(pqkv + (size_t)t * 3072 + col) = w;
                        if (rr == 0 || rr >= 62) { const int slot = rr == 0 ? 0 : rr - 61; *(u32x4*)(halo + ((size_t)(t >> 6) * 3 + slot) * 3072 + col) = w; } }
                    else if (u.pn < 16) *(u32x4*)(z + (size_t)t * D + (col - 3072)) = w;
                    else if (bj == 0 && wc == 0) { *(f32x4*)(ab + (size_t)t * 32 + 8 * fq) = v0; *(f32x4*)(ab + (size_t)t * 32 + 8 * fq + 4) = v1; } } }
    }
};
DI void p_router(const Frame& F, const KP& p, int l, int ntok) {
    LAS float* A2s = (LAS float*)(F.lds); LAS float* gBs = A2s + 1024; LAS float* gAs = A2s + 2048;
    constexpr int YT_OFF = 12288, YT_ROW = 2064, YT_SIZE = 16 * YT_ROW;
    constexpr int PT_OFF = YT_OFF + 2 * YT_SIZE, PT_SIZE = 8 * 16 * 49 * 4;
    constexpr int PS_OFF = PT_OFF + 2 * PT_SIZE;
    constexpr int LG_OFF = PS_OFF + 1024, RS_OFF = LG_OFF + 16 * 49 * 4, HI_OFF = RS_OFF + 64;
    static_assert(HI_OFF + 256 + 3072 <= LDS_MISC, "router LDS map");
    LAS float* lgs = (LAS float*)(F.lds + LG_OFF);
    LAS float* rsl = (LAS float*)(F.lds + RS_OFF);
    LAS int* hist = (LAS int*)(F.lds + HI_OFF);
    LAS int* basee = (LAS int*)(F.lds + HI_OFF + 128);
    LAS int* tiE = (LAS int*)(F.lds + HI_OFF + 256);
    LAS int* tiP = (LAS int*)(F.lds + HI_OFF + 256 + 1024);
    LAS float* tiW = (LAS float*)(F.lds + HI_OFF + 256 + 2048);
    const bf16* DL = (const bf16*)(F.ws + (l == 0 ? WS_YP : WS_Y2));
    const bf16* whi = (const bf16*)(F.ws + WS_WR2) + (size_t)(l * 2) * 48 * D; bf16* HX = (bf16*)(F.ws + WS_HX);
    unsigned* cnt = (unsigned*)(F.ws + WS_CTL) + CW_CNT + l * 32 * CNT_STRIDE;
    Entry* ent = (Entry*)(F.ws + WS_ENT);
    const float* nf = p.in[7] + l * D;
    const int fr = F.lane & 15, fq = F.lane >> 4, kw = 128 * F.wave;
    const int nunits = 256 + (ntok > TL ? 64 : 0);
    for (int un = F.bid; un < nunits; un += F.G) {
        const int t0 = un < 256 ? un * 128 : TL + (un - 256) * 16, nt16 = un < 256 ? 8 : 1, r = mod_row(t0);
        const bool ctxu = (l == 0 && t0 >= TL);
        bf16x8 bh[4][3];
        { int zo = 0; asm volatile("" : "+s"(zo));
#pragma unroll
          for (int ks = 0; ks < 4; ++ks)
#pragma unroll
            for (int n = 0; n < 3; ++n) { bh[ks][n] = *(const bf16x8*)(whi + zo + (size_t)(16 * n + fr) * D + kw + 32 * ks + 8 * fq); } }
        for (int i = F.tid; i < D; i += NTHR) { A2s[i] = nf[i] * (modp(F, l, r, 4)[i] + 1.f); const float gm = modp(F, l, r, 2)[i];
            if (l == 0) { const float ps = p.in[10][i]; gAs[i] = gm * ps; gBs[i] = gm * p.in[9][i] * ps; } else { gAs[i] = gm; gBs[i] = 0.f; } }
        if (F.tid < 32) hist[F.tid] = 0;
        __syncthreads();
        const float* c0 = (const float*)(F.ws + WS_C0) + (l * 5 + r) * 48;
        const float* xbase = l == 0 ? (t0 < TL ? p.in[0] + (size_t)t0 * D : p.in[2] + (size_t)(t0 - TL) * D) : nullptr;
        const bf16* xb16 = (const bf16*)F.out + (size_t)t0 * D;
        bf16* xo16 = (bf16*)(F.ws + (l == 0 ? WS_XS1 : WS_XS3)) + (size_t)t0 * D;
        float* xo32 = (float*)(F.ws + WS_XC) + (size_t)(t0 - TL) * D;
        f32x4 xa[4], xb[4]; u32x4 xq[4], dq[4];
#define RT_LOAD(mt_) do { const size_t ro_ = (size_t)(16 * (mt_) + fr) * D + kw + 8 * fq; _Pragma("unroll") for (int ks = 0; ks < 4; ++ks) { \
            if (l == 0) { xa[ks] = *(const f32x4*)(xbase + ro_ + 32 * ks); xb[ks] = *(const f32x4*)(xbase + ro_ + 32 * ks + 4); } else xq[ks] = *(const u32x4*)(xb16 + ro_ + 32 * ks); \
            dq[ks] = *(const u32x4*)(DL + (size_t)t0 * D + ro_ + 32 * ks); } } while (0)
        RT_LOAD(0);
        for (int mt = 0; mt < nt16; ++mt) {
            const int bf = mt & 1;
            LAS unsigned char* yt = F.lds + YT_OFF + bf * YT_SIZE; LAS float* part = (LAS float*)(F.lds + PT_OFF + bf * PT_SIZE); LAS float* pss = (LAS float*)(F.lds + PS_OFF + bf * 512);
            { f32x4 acc[3] = {{0.f, 0.f, 0.f, 0.f}, {0.f, 0.f, 0.f, 0.f}, {0.f, 0.f, 0.f, 0.f}}; float ssq = 0.f;
              const size_t ro = (size_t)(16 * mt + fr) * D + kw + 8 * fq;
#pragma unroll
              for (int ks = 0; ks < 4; ++ks) {
                f32x4 x0, x1; if (l == 0) { x0 = xa[ks]; x1 = xb[ks]; } else unpk8(xq[ks], x0, x1);
                { f32x4 da, db; unpk8(dq[ks], da, db); const LAS float* ga = gAs + kw + 32 * ks + 8 * fq; const LAS float* gb = gBs + kw + 32 * ks + 8 * fq;
                  x0 += *(const LAS f32x4*)gb + *(const LAS f32x4*)ga * da; x1 += *(const LAS f32x4*)(gb + 4) + *(const LAS f32x4*)(ga + 4) * db; }
                if (ctxu) { *(f32x4*)(xo32 + ro + 32 * ks) = x0; *(f32x4*)(xo32 + ro + 32 * ks + 4) = x1; } else *(u32x4*)(xo16 + ro + 32 * ks) = pk8(x0, x1);
                ssq += (x0.x * x0.x + x0.y * x0.y) + (x0.z * x0.z + x0.w * x0.w) + (x1.x * x1.x + x1.y * x1.y) + (x1.z * x1.z + x1.w * x1.w);
                const f32x4 y0 = x0 * *(const LAS f32x4*)(A2s + kw + 32 * ks + 8 * fq), y1 = x1 * *(const LAS f32x4*)(A2s + kw + 32 * ks + 8 * fq + 4);
                const u32x4 hq = pk8(y0, y1); f32x4 h0, h1; unpk8(hq, h0, h1);
                const bf16x8 ah = __builtin_bit_cast(bf16x8, hq), al = __builtin_bit_cast(bf16x8, pk8(y0 - h0, y1 - h1));
                *(LAS bf16x8*)(yt + fr * YT_ROW + (kw + 32 * ks + 8 * fq) * 2) = ah;
#pragma unroll
                for (int n = 0; n < 3; ++n) {
                    acc[n] = __builtin_amdgcn_mfma_f32_16x16x32_bf16(ah, bh[ks][n], acc[n], 0, 0, 0);
                    acc[n] = __builtin_amdgcn_mfma_f32_16x16x32_bf16(al, bh[ks][n], acc[n], 0, 0, 0); }
              }
              if (mt + 1 < nt16) RT_LOAD(mt + 1);
              ssq += __shfl_xor(ssq, 16); ssq += __shfl_xor(ssq, 32);
              if (fq == 0) pss[F.wave * 16 + fr] = ssq;
#pragma unroll
              for (int n = 0; n < 3; ++n)
#pragma unroll
                for (int q = 0; q < 4; ++q) part[(F.wave * 16 + 4 * fq + q) * 49 + 16 * n + fr] = acc[n][q]; }
            __syncthreads();
            if (F.tid < 256) { const int tl = F.tid >> 4, jj = F.tid & 15; float s = 0.f;
#pragma unroll
                for (int w = 0; w < 8; ++w) s += pss[w * 16 + tl];
                const float rstd = rsqrtf(s * (1.f / D) + EPS);
                if (jj == 0) rsl[tl] = rstd;
#pragma unroll
                for (int j = jj; j < 48; j += 16) { float g = 0.f;
#pragma unroll
                    for (int w = 0; w < 8; ++w) g += part[(w * 16 + tl) * 49 + j];
                    lgs[tl * 49 + j] = g * rstd + c0[j]; } }
            __syncthreads();
            if (F.tid < 16) {
                const LAS float* lg = lgs + F.tid * 49;
                const float g0 = lg[0], g1 = lg[1], g2 = lg[2], g3 = lg[3];
                int gi = 0; float gm = g0; if (g1 > gm) { gm = g1; gi = 1; } if (g2 > gm) { gm = g2; gi = 2; } if (g3 > gm) { gm = g3; gi = 3; }
                const float pg = 1.f / (__expf(g0 - gm) + __expf(g1 - gm) + __expf(g2 - gm) + __expf(g3 - gm));
                float e1 = -3.0e38f, e2 = -3.0e38f; int i1 = 0, i2 = 0;
#pragma unroll
                for (int j = 0; j < 8; ++j) { const float v = lg[4 + gi * 8 + j];
                    if (v > e1) { e2 = e1; i2 = i1; e1 = v; i1 = j; } else if (v > e2) { e2 = v; i2 = j; } }
                const float w1 = pg / (1.f + __expf(e2 - e1)), w2 = pg - w1;
                const int E0 = gi * 8 + i1, E1 = gi * 8 + i2, tl = 16 * mt + F.tid;
                tiE[tl * 2] = E0; tiE[tl * 2 + 1] = E1; tiW[tl * 2] = w1; tiW[tl * 2 + 1] = w2;
                tiP[tl * 2] = atomicAdd((int*)&hist[E0], 1); tiP[tl * 2 + 1] = atomicAdd((int*)&hist[E1], 1);
            }
#pragma unroll 1
            for (int kk = 0; kk < 2; ++kk) { const int tk = 2 * F.wave + kk; const float rstd = rsl[tk];
#pragma unroll
                for (int i = 0; i < 2; ++i) { const int c = 8 * F.lane + 512 * i; f32x4 ya, yb; unpk8(*(const LAS u32x4*)(yt + tk * YT_ROW + c * 2), ya, yb);
                    const float* b2 = modp(F, l, r, 3) + c;
                    *(u32x4*)(HX + (size_t)(t0 + 16 * mt + tk) * D + c) = pk8(ya * rstd + *(const f32x4*)b2, yb * rstd + *(const f32x4*)(b2 + 4)); } }
        }
#undef RT_LOAD
        __syncthreads();
        { int tz = threadIdx.x; asm volatile("" : "+v"(tz));
          if (tz < 32) { const int hcount = hist[tz]; basee[tz] = hcount > 0 ? (int)__hip_atomic_fetch_add(cnt + tz * CNT_STRIDE, (unsigned)hcount, __ATOMIC_RELAXED, __HIP_MEMORY_SCOPE_AGENT) : 0; } }
        __syncthreads();
        if (F.tid < 32 * nt16) { const int tl = F.tid >> 1, E = tiE[F.tid], pos = basee[E] + tiP[F.tid]; Entry en; en.ts = (t0 + tl) * 2 + (F.tid & 1); en.w = tiW[F.tid];
            ent[(size_t)E * CAP + pos] = en;
            Entry ti; ti.ts = (E << 16) | pos; ti.w = en.w; ((Entry*)(F.ws + WS_TI))[(size_t)(t0 + tl) * 2 + (F.tid & 1)] = ti; }
        __syncthreads();
    }
}

DI void p6_n1(const Frame& F, const KP& p, const LAS int* tb) {
    const int gw = F.bid * NWAVES + F.wave, NGW = F.G * NWAVES;
    const bf16* Y = (const bf16*)(F.ws + WS_Y); bf16* HX = (bf16*)(F.ws + WS_HX); const Entry* TI = (const Entry*)(F.ws + WS_TI);
    for (int t = gw; t < T; t += NGW) {
        const int r = mod_row(t); const bool lat = t < TL;
        float* xr = (float*)(F.ws + WS_XC) + (size_t)(t - TL) * D;
        const bf16* xi16 = (const bf16*)(F.ws + WS_XS1) + (size_t)t * D; bf16* xo16 = (bf16*)F.out + (size_t)t * D;
        const Entry ta = TI[(size_t)2 * t], tbb = TI[(size_t)2 * t + 1]; const float w0 = ta.w, w1 = tbb.w;
        const size_t r0 = ((size_t)tb[ta.ts >> 16] * 256 + (ta.ts & 0xffff)) * D, r1 = ((size_t)tb[tbb.ts >> 16] * 256 + (tbb.ts & 0xffff)) * D;
        f32x4 va[2], vb[2]; u32x4 y0[2], y1[2]; float s = 0.f;
#pragma unroll
        for (int i = 0; i < 2; ++i) { const int c = 8 * F.lane + 512 * i;
            if (lat) unpk8(*(const u32x4*)(xi16 + c), va[i], vb[i]); else { va[i] = *(const f32x4*)(xr + c); vb[i] = *(const f32x4*)(xr + c + 4); }
            y0[i] = *(const u32x4*)(Y + r0 + c); y1[i] = *(const u32x4*)(Y + r1 + c); }
#pragma unroll
        for (int i = 0; i < 2; ++i) { const int c = 8 * F.lane + 512 * i; f32x4 a0, b0, a1, b1; unpk8(y0[i], a0, b0); unpk8(y1[i], a1, b1);
            const float* gp = modp(F, 0, r, 5) + c;
            va[i] = va[i] + *(const f32x4*)gp * (a0 * w0 + a1 * w1); vb[i] = vb[i] + *(const f32x4*)(gp + 4) * (b0 * w0 + b1 * w1);
            if (lat) *(u32x4*)(xo16 + c) = pk8(va[i], vb[i]); else { *(f32x4*)(xr + c) = va[i]; *(f32x4*)(xr + c + 4) = vb[i]; }
            s += (va[i].x * va[i].x + va[i].y * va[i].y) + (va[i].z * va[i].z + va[i].w * va[i].w) + (vb[i].x * vb[i].x + vb[i].y * vb[i].y) + (vb[i].z * vb[i].z + vb[i].w * vb[i].w); }
        const float rstd = rsqrtf(wave_sum(s) * (1.f / D) + EPS);
#pragma unroll
        for (int i = 0; i < 2; ++i) { const int c = 8 * F.lane + 512 * i; const float* nm = p.in[6] + D + c; const float* sc = modp(F, 1, r, 1) + c; const float* sh = modp(F, 1, r, 0) + c;
            const f32x4 oa = va[i] * rstd * (*(const f32x4*)nm * (*(const f32x4*)sc + 1.f)) + *(const f32x4*)sh, ob = vb[i] * rstd * (*(const f32x4*)(nm + 4) * (*(const f32x4*)(sc + 4) + 1.f)) + *(const f32x4*)(sh + 4);
            *(u32x4*)(HX + (size_t)t * D + c) = pk8(oa, ob); }
    }
}

DI bf16x8 lds_frag(LAS unsigned char* base, int byteoff) { return *(const LAS bf16x8*)(base + byteoff); }
DI void p8_c1a(const Frame& F, const KP& p) {
    bf16* PQ = (bf16*)(F.ws + WS_PQKV); const bf16* HALO = (const bf16*)(F.ws + WS_HALO); const float* AB = (const float*)(F.ws + WS_AB);
    float* LM = (float*)(F.ws + WS_LM); bf16* PM = (bf16*)(F.ws + WS_PM); float* GCB = (float*)(F.ws + WS_GCB);
    constexpr int RS = 272;
    LAS unsigned char* qs = F.lds; LAS unsigned char* ks = F.lds + 64 * RS;
    LAS float* KKs = (LAS float*)(F.lds + 53248);
    LAS float* QKs = (LAS float*)(F.lds + 53248 + 17408);
    LAS float* gcs = (LAS float*)(F.lds + 53248 + 2 * 17408);
    LAS float* bes = gcs + 128;
    const int fr = F.lane & 15, fq = F.lane >> 4;
    const int grp = F.tid >> 4, l16 = F.tid & 15, which = grp >> 3, ro = grp & 7;
    u32x4 raw[11]; float abA = 0.f, abB = 0.f;
#define C1_LOAD(unit_) do { const int cid_ = (unit_) >> 3, h_ = (unit_) & 7, tok0_ = cid_ * 64, col_ = which * 1024 + h_ * 128 + 8 * l16; \
        const bool first_ = cid_ < 512 ? ((cid_ & 127) == 0) : (((cid_ - 512) & 3) == 0), last_ = cid_ < 512 ? ((cid_ & 127) == 127) : (((cid_ - 512) & 3) == 3); \
        if (F.wave < 6) { _Pragma("unroll") for (int q = 0; q < 11; ++q) { const int rr = 8 * ro + q - 2; u32x4 v = {0u, 0u, 0u, 0u}; \
                if (rr < 0) { if (!first_) v = *(const u32x4*)(HALO + ((size_t)(cid_ - 1) * 3 + (rr + 3)) * 3072 + col_); } \
                else if (rr > 63) { if (!last_) v = *(const u32x4*)(HALO + ((size_t)(cid_ + 1) * 3 + 0) * 3072 + col_); } \
                else v = *(const u32x4*)(PQ + (size_t)(tok0_ + rr) * 3072 + col_); \
                raw[q] = v; } } \
        else { const int d_ = F.wave - 6, jj_ = d_ ? 63 - F.lane : F.lane; const float* ab_ = AB + (size_t)(tok0_ + jj_) * 32; abA = ab_[(2 * d_) * 8 + h_]; abB = ab_[(2 * d_ + 1) * 8 + h_]; } } while (0)
    if (F.bid < NCID * NH) C1_LOAD(F.bid);
    for (int unit = F.bid; unit < NCID * NH; unit += F.G) {
        const int cid = unit >> 3, h = unit & 7;
        const int tok0 = cid * 64;
        u32x4 res[8];
        const int col = which * 1024 + h * 128 + 8 * l16;
        if (F.wave < 6) {
            f32x4 w0[4], w1[4];
#pragma unroll
            for (int k = 0; k < 4; ++k) { w0[k] = *(const f32x4*)(p.in[12] + k * 3072 + col); w1[k] = *(const f32x4*)(p.in[12] + k * 3072 + col + 4); }
#pragma unroll
            for (int j = 0; j < 8; ++j) { float o[8];
#pragma unroll
                for (int e = 0; e < 8; ++e) o[e] = 0.f;
#pragma unroll
                for (int k = 0; k < 4; ++k) { const u32x4 rw = raw[j + k];
                    o[0] += bflo(rw.x) * w0[k].x; o[1] += bfhi(rw.x) * w0[k].y; o[2] += bflo(rw.y) * w0[k].z; o[3] += bfhi(rw.y) * w0[k].w;
                    o[4] += bflo(rw.z) * w1[k].x; o[5] += bfhi(rw.z) * w1[k].y; o[6] += bflo(rw.w) * w1[k].z; o[7] += bfhi(rw.w) * w1[k].w; }
                float ss = 0.f;
#pragma unroll
                for (int e = 0; e < 8; ++e) { o[e] = siluf(o[e]); ss += o[e] * o[e]; }
                ss += __shfl_xor(ss, 1); ss += __shfl_xor(ss, 2); ss += __shfl_xor(ss, 4); ss += __shfl_xor(ss, 8);
                float sc = 1.f;
                if (which == 0) sc = rsqrtf(ss + EPS) * 0.08838834764831845f; else if (which == 1) sc = rsqrtf(ss + EPS);
                u32x4 w; w.x = pk2(o[0] * sc, o[1] * sc); w.y = pk2(o[2] * sc, o[3] * sc); w.z = pk2(o[4] * sc, o[5] * sc); w.w = pk2(o[6] * sc, o[7] * sc);
                res[j] = w;
                if (which < 2) *(LAS u32x4*)((which == 0 ? qs : ks) + (8 * ro + j) * RS + l16 * 16) = w; }
        } else { const int d = F.wave - 6;
            const float a = abA, bb = abB;
            const float g = -__expf(p.in[13][d * 8 + h]) * softplusf_(a + p.in[14][d * 8 + h]); const float be = sigmoidf_(bb);
            float gc = g;
#pragma unroll
            for (int o = 1; o < 64; o <<= 1) { const float up = __shfl_up(gc, o); if (F.lane >= o) gc += up; }
            gcs[d * 64 + F.lane] = gc; bes[d * 64 + F.lane] = be;
            const float eg = __expf(gc), glast = __shfl(gc, 63);
            float* gp = GCB + ((size_t)unit * 2 + d) * 256; gp[F.lane] = be; gp[64 + F.lane] = be * eg; gp[128 + F.lane] = eg; gp[192 + F.lane] = __expf(glast - gc); }
        __syncthreads();
        if (unit + F.G < NCID * NH) C1_LOAD(unit + F.G);
        if (F.wave < 6) {
#pragma unroll
            for (int j = 0; j < 8; ++j) *(u32x4*)(PQ + (size_t)(tok0 + 8 * ro + j) * 3072 + col) = res[j]; }
#pragma unroll
        for (int tt = 0; tt < 2; ++tt) { const int ti = 2 * F.wave + tt, mt = ti >> 2, nt = ti & 3;
            f32x4 ak = {0.f, 0.f, 0.f, 0.f}, aq = {0.f, 0.f, 0.f, 0.f};
#pragma unroll
            for (int kk = 0; kk < 4; ++kk) { const int ko = (32 * kk + 8 * fq) * 2;
                const bf16x8 bfr = lds_frag(ks, (16 * nt + fr) * RS + ko), akf = lds_frag(ks, (16 * mt + fr) * RS + ko), aqf = lds_frag(qs, (16 * mt + fr) * RS + ko);
                ak = __builtin_amdgcn_mfma_f32_16x16x32_bf16(akf, bfr, ak, 0, 0, 0); aq = __builtin_amdgcn_mfma_f32_16x16x32_bf16(aqf, bfr, aq, 0, 0, 0); }
#pragma unroll
            for (int r = 0; r < 4; ++r) { KKs[(16 * mt + 4 * fq + r) * 68 + 16 * nt + fr] = ak[r]; QKs[(16 * mt + 4 * fq + r) * 68 + 16 * nt + fr] = aq[r]; } }
        __syncthreads();
#pragma unroll
        for (int itr = 0; itr < 2; ++itr) { const int idx = (F.tid + NTHR * itr) * 8, d = idx >> 12, j1 = (idx >> 6) & 63, jb = idx & 63;
            const int t1 = d ? 63 - j1 : j1; const float g1 = gcs[d * 64 + j1], b1 = bes[d * 64 + j1]; float x[8];
#pragma unroll
            for (int e = 0; e < 8; ++e) { const int j2 = jb + e; x[e] = 0.f;
                if (j2 <= j1) { const int t2 = d ? 63 - j2 : j2; const float f = __expf(g1 - gcs[d * 64 + j2]); x[e] = QKs[t1 * 68 + t2] * f;
                    if (j2 < j1) LM[(size_t)unit * 4096 + t1 * 64 + t2] = b1 * KKs[t1 * 68 + t2] * f; } }
            if (jb <= j1 && j1 < jb + 8) LM[(size_t)unit * 4096 + t1 * 64 + t1] = 0.f;
            u32x4 w; w.x = pk2(x[0], x[1]); w.y = pk2(x[2], x[3]); w.z = pk2(x[4], x[5]); w.w = pk2(x[6], x[7]);
            *(u32x4*)(PM + ((size_t)unit * 2 + d) * 4096 + j1 * 64 + jb) = w; }
        __syncthreads();
    }
#undef C1_LOAD
}

DI void p9_c1b(const Frame& F) {
    const float* LM = (const float*)(F.ws + WS_LM); bf16* TM = (bf16*)(F.ws + WS_TM);
    LAS float* Ls = (LAS float*)(F.lds);
    for (int k0 = 0; F.bid + k0 * F.G < NCID * NH; k0 += 4) {
        {
            f32x4 lv[8];
#pragma unroll
            for (int itr = 0; itr < 8; ++itr) { const int uqs = itr >> 1, un = F.bid + (k0 + uqs) * F.G;
                lv[itr] = un < NCID * NH ? *(const f32x4*)(LM + (size_t)un * 4096 + (size_t)(F.tid + NTHR * (itr & 1)) * 4) : (f32x4){0.f, 0.f, 0.f, 0.f}; }
#pragma unroll
            for (int itr = 0; itr < 8; ++itr) { const int uq = itr >> 1, e0 = (F.tid + NTHR * (itr & 1)) * 4, i1 = e0 >> 6;
#pragma unroll
                for (int e = 0; e < 4; ++e) { const int i2 = (e0 & 63) + e; const float v = lv[itr][e];
                    if (i2 < i1) Ls[((uq * 2 + 0) * 64 + i1) * 64 + i2] = v; else if (i2 > i1) Ls[((uq * 2 + 1) * 64 + (63 - i1)) * 64 + (63 - i2)] = v; } }
        }
        __syncthreads();
        {
            const int uq = F.wave >> 1, d = F.wave & 1, c = F.lane;
            LAS float* L = Ls + (uq * 2 + d) * 4096;
            float Tc[64];
            Tc[0] = (c == 0) ? 1.f : 0.f;
#pragma unroll
            for (int i = 1; i < 64; ++i) {
                f32x4 lr[16];
#pragma unroll
                for (int q = 0; q < (i + 3) / 4; ++q) lr[q] = *(const LAS f32x4*)(L + i * 64 + 4 * q);
                float a0 = (c == i) ? 1.f : 0.f, a1 = 0.f, a2 = 0.f, a3 = 0.f;
#pragma unroll
                for (int q = 0; q < (i + 3) / 4; ++q) { const f32x4 l4 = lr[q]; const int j4 = 4 * q;
                    a0 -= l4.x * Tc[j4];
                    if (j4 + 1 < i) a1 -= l4.y * Tc[j4 + 1];
                    if (j4 + 2 < i) a2 -= l4.z * Tc[j4 + 2];
                    if (j4 + 3 < i) a3 -= l4.w * Tc[j4 + 3]; }
                Tc[i] = (a0 + a1) + (a2 + a3);
            }
            LAS unsigned short* Tl = (LAS unsigned short*)L;
#pragma unroll
            for (int i = 0; i < 64; ++i) Tl[i * 64 + c] = (unsigned short)f2bf(Tc[i]);
            asm volatile("s_waitcnt lgkmcnt(0)" ::: "memory");
            const int un = F.bid + (k0 + uq) * F.G;
            if (un < NCID * NH) { bf16* dst = TM + ((size_t)un * 2 + d) * 4096;
#pragma unroll
                for (int q = 0; q < 8; ++q) *(u32x4*)(dst + (size_t)(q * 64 + c) * 8) = *(const LAS u32x4*)(Tl + (q * 64 + c) * 8); }
        }
        __syncthreads();
    }
}

typedef short s16x4 __attribute__((ext_vector_type(4)));
constexpr int SB_K = 0, SB_Q = 16384, SB_T = 32768, SB_P = 40960, SB_V = 49152, SB_G = 53248, SB_SIZE = 54272;
constexpr int SW_SBT = 2 * SB_SIZE, SW_XT = SW_SBT + 8704, SW_VNT = SW_XT + 4608, SW_VDT = SW_VNT + 4608;
static_assert(SW_VDT + 4608 <= LDS_MISC, "scan LDS map");
DI unsigned offb(unsigned row, unsigned ch) { return 256u * row + 16u * (ch ^ (((row & 3u) << 2) | ((row >> 2) & 3u))); }
DI unsigned offt(unsigned row, unsigned ch) { return 128u * row + 16u * (ch ^ ((row >> 1) & 7u)); }
#define SC_GLDS(src, ldsoff) __builtin_amdgcn_global_load_lds((const unsigned*)(src), (LAS unsigned*)(F.lds + (ldsoff)), 16, 0, 0)
#define SC_LBAR() do { asm volatile("s_waitcnt lgkmcnt(0)" ::: "memory"); __builtin_amdgcn_s_barrier(); asm volatile("" ::: "memory"); } while (0)
DI void scan_chunk(int s, int b, int d, int& cid, int& outp) {
    if (s < 4) { const int cc = d ? 3 - s : s; cid = 512 + b * 4 + cc; outp = 0; } else { const int c2 = s - 4, cc = d ? 127 - c2 : c2; cid = b * 128 + cc; outp = 1; }
}
DI void scan_issue(const Frame& F, int buf, int s, int b, int h, int d, int v0) {
    const unsigned char* PQ = F.ws + WS_PQKV; const float* GCB = (const float*)(F.ws + WS_GCB);
    int cid, outp; scan_chunk(s, b, d, cid, outp);
    const int tok0 = cid * 64, w = F.wave, L = F.lane, bo = buf * SB_SIZE;
    const size_t mb = ((size_t)(cid * 8 + h) * 2 + d);
    const unsigned char* TMb = F.ws + WS_TM + mb * 8192; const unsigned char* PMb = F.ws + WS_PM + mb * 8192;
#pragma unroll
    for (int ii = 0; ii < 2; ++ii) { const int i = 2 * w + ii, row = 4 * i + (L >> 4), slot = L & 15, ch = slot ^ (((row & 3) << 2) | ((row >> 2) & 3)), tok = tok0 + (d ? 63 - row : row);
        const unsigned off = (unsigned)tok * 6144u + (unsigned)(h * 256 + ch * 16);
        SC_GLDS(PQ + 2048 + off, bo + SB_K + i * 1024); if (outp) SC_GLDS(PQ + off, bo + SB_Q + i * 1024); }
    { const int row = 8 * w + (L >> 3), slot = L & 7, ch = slot ^ ((row >> 1) & 7); const unsigned off = (unsigned)(row * 128 + ch * 16);
        SC_GLDS(TMb + off, bo + SB_T + w * 1024); if (outp) SC_GLDS(PMb + off, bo + SB_P + w * 1024); }
    if (w < 4) { const int row = 16 * w + (L >> 2), c = L & 3, tok = tok0 + (d ? 63 - row : row);
        SC_GLDS(PQ + 4096 + ((unsigned)tok * 6144u + (unsigned)(h * 256 + v0 * 2 + 16 * c)), bo + SB_V + w * 1024); }
    else if (w == 4) SC_GLDS(GCB + mb * 256 + L * 4, bo + SB_G);
}
DI void scan_step(const Frame& F, int buf, int s, int b, int h, int d, int v0, f32x4 (&Sacc)[2], int mt, int nt, int fr, int fq) {
    LAS unsigned char* L = F.lds; LAS unsigned char* B = F.lds + buf * SB_SIZE;
    bf16* OD = (bf16*)(F.ws + WS_O) + (size_t)d * TL * D;
    int cid, outp; scan_chunk(s, b, d, cid, outp);
    const int tok0 = cid * 64;
    f32x4 aX = {0.f, 0.f, 0.f, 0.f}, aO = {0.f, 0.f, 0.f, 0.f};
#pragma unroll
    for (int ks = 0; ks < 4; ++ks) { const bf16x8 sb = *(const LAS bf16x8*)(L + SW_SBT + (16 * nt + fr) * 272 + (32 * ks + 8 * fq) * 2);
        const bf16x8 kA = *(const LAS bf16x8*)(B + SB_K + offb(16 * mt + fr, 4 * ks + fq));
        aX = __builtin_amdgcn_mfma_f32_16x16x32_bf16(kA, sb, aX, 0, 0, 0);
        if (outp) { const bf16x8 qA = *(const LAS bf16x8*)(B + SB_Q + offb(16 * mt + fr, 4 * ks + fq)); aO = __builtin_amdgcn_mfma_f32_16x16x32_bf16(sb, qA, aO, 0, 0, 0); } }
    const LAS unsigned char* Gr = B + SB_G + (16 * mt + 4 * fq) * 4;
    const f32x4 be = *(const LAS f32x4*)Gr, s1 = *(const LAS f32x4*)(Gr + 256), dr = *(const LAS f32x4*)(Gr + 768);
    float x[4];
#pragma unroll
    for (int r = 0; r < 4; ++r) { const float vv = bf2f(*(const LAS unsigned short*)(B + SB_V + (16 * mt + 4 * fq + r) * 64 + (16 * nt + fr) * 2));
        x[r] = vv * be[r] - s1[r] * aX[r]; }
    if (outp) { const float egj = *(const LAS float*)(B + SB_G + 512 + (16 * mt + fr) * 4); aO = aO * egj; }
    { u32x2 w; w.x = pk2(x[0], x[1]); w.y = pk2(x[2], x[3]); *(LAS u32x2*)(L + SW_XT + (16 * nt + fr) * 144 + (16 * mt + 4 * fq) * 2) = w; }
    SC_LBAR();
    f32x4 aV = {0.f, 0.f, 0.f, 0.f};
#pragma unroll
    for (int ks = 0; ks < 2; ++ks) { const bf16x8 xb = *(const LAS bf16x8*)(L + SW_XT + (16 * nt + fr) * 144 + (32 * ks + 8 * fq) * 2);
        const bf16x8 tA = *(const LAS bf16x8*)(B + SB_T + offt(16 * mt + fr, 4 * ks + fq));
        aV = __builtin_amdgcn_mfma_f32_16x16x32_bf16(tA, xb, aV, 0, 0, 0); }
    { u32x2 w; w.x = pk2(aV[0], aV[1]); w.y = pk2(aV[2], aV[3]); *(LAS u32x2*)(L + SW_VNT + (16 * nt + fr) * 144 + (16 * mt + 4 * fq) * 2) = w;
      w.x = pk2(aV[0] * dr[0], aV[1] * dr[1]); w.y = pk2(aV[2] * dr[2], aV[3] * dr[3]); *(LAS u32x2*)(L + SW_VDT + (16 * nt + fr) * 144 + (16 * mt + 4 * fq) * 2) = w; }
    SC_LBAR();
    const float decay = *(const LAS float*)(B + SB_G + 512 + 63 * 4);
    const int w8 = 2 * mt + nt;
    bf16x8 kt[2];
    { const unsigned q4 = (unsigned)fr >> 2, p4 = (unsigned)fr & 3u, kb = (unsigned)(size_t)(B + SB_K) + 8u * (p4 & 1u);
      const unsigned a00 = kb + offb(8 * fq + 0 + q4, 2 * w8 + (p4 >> 1)), a01 = kb + offb(8 * fq + 4 + q4, 2 * w8 + (p4 >> 1));
      const unsigned a10 = kb + offb(32 + 8 * fq + 0 + q4, 2 * w8 + (p4 >> 1)), a11 = kb + offb(32 + 8 * fq + 4 + q4, 2 * w8 + (p4 >> 1));
      s16x4 t00, t01, t10, t11;
      asm volatile("ds_read_b64_tr_b16 %0, %4\n\tds_read_b64_tr_b16 %1, %5\n\tds_read_b64_tr_b16 %2, %6\n\tds_read_b64_tr_b16 %3, %7\n\ts_waitcnt lgkmcnt(0)"
                   : "=&v"(t00), "=&v"(t01), "=&v"(t10), "=&v"(t11) : "v"(a00), "v"(a01), "v"(a10), "v"(a11) : "memory");
      kt[0] = (bf16x8){t00[0], t00[1], t00[2], t00[3], t01[0], t01[1], t01[2], t01[3]};
      kt[1] = (bf16x8){t10[0], t10[1], t10[2], t10[3], t11[0], t11[1], t11[2], t11[3]}; }
#pragma unroll
    for (int n = 0; n < 2; ++n) { Sacc[n] = Sacc[n] * decay;
#pragma unroll
        for (int ks = 0; ks < 2; ++ks) { const bf16x8 vd = *(const LAS bf16x8*)(L + SW_VDT + (16 * n + fr) * 144 + (32 * ks + 8 * fq) * 2);
            Sacc[n] = __builtin_amdgcn_mfma_f32_16x16x32_bf16(kt[ks], vd, Sacc[n], 0, 0, 0); } }
    if (outp) {
#pragma unroll
        for (int ks = 0; ks < 2; ++ks) { const bf16x8 vn = *(const LAS bf16x8*)(L + SW_VNT + (16 * nt + fr) * 144 + (32 * ks + 8 * fq) * 2);
            const bf16x8 pA = *(const LAS bf16x8*)(B + SB_P + offt(16 * mt + fr, 4 * ks + fq));
            aO = __builtin_amdgcn_mfma_f32_16x16x32_bf16(vn, pA, aO, 0, 0, 0); }
    }
#pragma unroll
    for (int n = 0; n < 2; ++n) { u32x2 w; w.x = pk2(Sacc[n][0], Sacc[n][1]); w.y = pk2(Sacc[n][2], Sacc[n][3]);
        *(LAS u32x2*)(L + SW_SBT + (16 * n + fr) * 272 + (16 * w8 + 4 * fq) * 2) = w; }
    if (outp) {
        { const int jc = 16 * mt + fr, tc = tok0 + (d ? 63 - jc : jc); u32x2 w; w.x = pk2(aO[0], aO[1]); w.y = pk2(aO[2], aO[3]);
          *(u32x2*)(OD + (size_t)tc * D + h * 128 + v0 + 16 * nt + 4 * fq) = w; }
        asm volatile("s_waitcnt vmcnt(1)" ::: "memory");
    } else asm volatile("s_waitcnt vmcnt(0)" ::: "memory");
    SC_LBAR();
}
DI void p10_scan(const Frame& F) {
    const int mt = F.wave >> 1, nt = F.wave & 1, fr = F.lane & 15, fq = F.lane >> 4;
    for (int u0 = F.bid; u0 < 256; u0 += F.G) {
        const int xcd = u0 & 7, qq = u0 >> 3, sl = qq & 3, chain = xcd + 8 * (qq >> 2);
        const int d = chain & 1, h = (chain >> 1) & 7, b = chain >> 4, v0 = sl * 32;
        for (int i = F.tid; i < 8704 / 4; i += NTHR) ((LAS unsigned*)(F.lds + SW_SBT))[i] = 0u;
        f32x4 Sacc[2] = {{0.f, 0.f, 0.f, 0.f}, {0.f, 0.f, 0.f, 0.f}};
        scan_issue(F, 0, 0, b, h, d, v0);
        asm volatile("s_waitcnt vmcnt(0)" ::: "memory");
        SC_LBAR();
        for (int s = 0; s < 132; ++s) {
            if (s + 1 < 132) scan_issue(F, (s + 1) & 1, s + 1, b, h, d, v0);
            scan_step(F, s & 1, s, b, h, d, v0, Sacc, mt, nt, fr, fq);
        }
    }
}

DI void p11_onorm(const Frame& F, const KP& p) {
    const int gw = F.bid * NWAVES + F.wave, NGW = F.G * NWAVES;
    const bf16* O0 = (const bf16*)(F.ws + WS_O); const bf16* O1 = O0 + (size_t)TL * D; const bf16* Z = (const bf16*)(F.ws + WS_Z); bf16* HX = (bf16*)(F.ws + WS_HX);
    for (int t = gw; t < TL; t += NGW) {
        const int c = 16 * F.lane;
        float o[16], zz[16]; float ss = 0.f;
#pragma unroll
        for (int q = 0; q < 2; ++q) { const u32x4 a = *(const u32x4*)(O0 + (size_t)t * D + c + 8 * q), bq = *(const u32x4*)(O1 + (size_t)t * D + c + 8 * q), zq = *(const u32x4*)(Z + (size_t)t * D + c + 8 * q);
            o[8 * q + 0] = bflo(a.x) + bflo(bq.x); o[8 * q + 1] = bfhi(a.x) + bfhi(bq.x); o[8 * q + 2] = bflo(a.y) + bflo(bq.y); o[8 * q + 3] = bfhi(a.y) + bfhi(bq.y);
            o[8 * q + 4] = bflo(a.z) + bflo(bq.z); o[8 * q + 5] = bfhi(a.z) + bfhi(bq.z); o[8 * q + 6] = bflo(a.w) + bflo(bq.w); o[8 * q + 7] = bfhi(a.w) + bfhi(bq.w);
            zz[8 * q + 0] = bflo(zq.x); zz[8 * q + 1] = bfhi(zq.x); zz[8 * q + 2] = bflo(zq.y); zz[8 * q + 3] = bfhi(zq.y); zz[8 * q + 4] = bflo(zq.z); zz[8 * q + 5] = bfhi(zq.z); zz[8 * q + 6] = bflo(zq.w); zz[8 * q + 7] = bfhi(zq.w); }
#pragma unroll
        for (int e = 0; e < 16; ++e) ss += o[e] * o[e];
        ss += __shfl_xor(ss, 1); ss += __shfl_xor(ss, 2); ss += __shfl_xor(ss, 4);
        const float rs = rsqrtf(ss * (1.f / 128.f) + EPS);
        const float* nw = p.in[15] + (c & 127);
        unsigned w[8];
#pragma unroll
        for (int e = 0; e < 8; ++e) w[e] = pk2(o[2 * e] * rs * nw[2 * e] * siluf(zz[2 * e]), o[2 * e + 1] * rs * nw[2 * e + 1] * siluf(zz[2 * e + 1]));
        *(u32x4*)(HX + (size_t)t * D + c) = (u32x4){w[0], w[1], w[2], w[3]}; *(u32x4*)(HX + (size_t)t * D + c + 8) = (u32x4){w[4], w[5], w[6], w[7]};
    }
}

DI void p16_final(const Frame& F, const KP& p, const LAS int* tb) {
    const int gw = F.bid * NWAVES + F.wave, NGW = F.G * NWAVES;
    const bf16* Y = (const bf16*)(F.ws + WS_Y); const Entry* TI = (const Entry*)(F.ws + WS_TI);
    for (int t = gw; t < TL; t += NGW) {
        const int r = t >> 13; float* xr = F.out + (size_t)t * D; const bf16* xi16 = (const bf16*)(F.ws + WS_XS3) + (size_t)t * D;
        const Entry ta = TI[(size_t)2 * t], tbb = TI[(size_t)2 * t + 1]; const float w0 = ta.w, w1 = tbb.w;
        const size_t r0 = ((size_t)tb[ta.ts >> 16] * 256 + (ta.ts & 0xffff)) * D, r1 = ((size_t)tb[tbb.ts >> 16] * 256 + (tbb.ts & 0xffff)) * D;
        f32x4 va[2], vb[2]; u32x4 y0[2], y1[2]; float s = 0.f;
#pragma unroll
        for (int i = 0; i < 2; ++i) { const int c = 8 * F.lane + 512 * i; unpk8(*(const u32x4*)(xi16 + c), va[i], vb[i]); y0[i] = *(const u32x4*)(Y + r0 + c); y1[i] = *(const u32x4*)(Y + r1 + c); }
#pragma unroll
        for (int i = 0; i < 2; ++i) { const int c = 8 * F.lane + 512 * i; f32x4 a0, b0, a1, b1; unpk8(y0[i], a0, b0); unpk8(y1[i], a1, b1);
            const float* gp = modp(F, 1, r, 5) + c;
            va[i] = va[i] + *(const f32x4*)gp * (a0 * w0 + a1 * w1); vb[i] = vb[i] + *(const f32x4*)(gp + 4) * (b0 * w0 + b1 * w1);
            s += (va[i].x * va[i].x + va[i].y * va[i].y) + (va[i].z * va[i].z + va[i].w * va[i].w) + (vb[i].x * vb[i].x + vb[i].y * vb[i].y) + (vb[i].z * vb[i].z + vb[i].w * vb[i].w); }
        const float rstd = rsqrtf(wave_sum(s) * (1.f / D) + EPS);
#pragma unroll
        for (int i = 0; i < 2; ++i) { const int c = 8 * F.lane + 512 * i; *(f32x4*)(xr + c) = va[i] * rstd * *(const f32x4*)(p.in[24] + c); *(f32x4*)(xr + c + 4) = vb[i] * rstd * *(const f32x4*)(p.in[24] + c + 4); }
    }
}

__global__ void __launch_bounds__(NTHR, 2) fwd_kernel(KP kp) {
    extern __shared__ __attribute__((aligned(16))) unsigned char lds_raw[];
    Frame F;
    F.lds = (LAS unsigned char*)lds_raw; F.tid = threadIdx.x; F.lane = F.tid & 63; F.wave = __builtin_amdgcn_readfirstlane(F.tid >> 6);
    F.bid = blockIdx.x; F.G = gridDim.x; F.ws = kp.ws; F.out = kp.out;
    volatile LAS unsigned* misc = (volatile LAS unsigned*)(F.lds + LDS_MISC);
    if (F.tid < 4) misc[F.tid] = 0u;
    __syncthreads();
    const int lo = kp.ph_lo, hi = kp.ph_hi;
    XcdBarrier bar; bar.bar = (unsigned*)(F.ws + WS_CTL) + CW_BAR; bar.x = 0; bar.st = misc;
    if (hi - lo > 1) bar = xcd_barrier_post((unsigned*)(F.ws + WS_CTL) + CW_BAR, misc);
#ifndef PHSEL
#define PHSEL 0x1FFFF
#endif
#define IN(k) (((PHSEL >> (k)) & 1) && lo <= (k) && (k) < hi)
#define SEAM(k) do { if (IN(k) && IN((k) + 1)) xcd_barrier(bar); } while (0)
    LAS int* tb = (LAS int*)(F.lds + LDS_MISC + 64); LAS int* cn = (LAS int*)(F.lds + LDS_MISC + 64 + 256);
    const float* MOD = (const float*)(F.ws + WS_MOD);

    if (IN(0)) { p0_prologue(F, kp); } SEAM(0);
    if (IN(1)) { p1_pool_diff(F, kp); __syncthreads(); convert_experts(F, kp, 0); } SEAM(1);
    if (IN(2)) { pg8::Gemm g{(const bf16*)(F.ws + WS_DD), (const bf16*)(F.ws + WS_BTP), 256}; PoolOrder S{F.G, F.bid};
        EpiRaw E{(bf16*)(F.ws + WS_YP), 1};
        pg8::gemm_phase<EpiRaw, PoolOrder, false>(F.lds, g, S, E); } SEAM(2);
    if (IN(3)) { p_router(F, kp, 0, T); } SEAM(3);
    if (IN(4)) { moe_tables(F, 0, tb, cn);
        pg8::Gemm g{(const bf16*)(F.ws + WS_HX), (const bf16*)(F.ws + WS_GU), 1024}; MoeOrder S{F.G, F.bid, tb[NE], tb, cn, (const Entry*)(F.ws + WS_ENT)};
        EpiGU E{(bf16*)(F.ws + WS_HID)};
        pg8::gemm_phase<EpiGU, MoeOrder, true>(F.lds, g, S, E); } SEAM(4);
    if (IN(5)) { moe_tables(F, 0, tb, cn);
        pg8::Gemm g{(const bf16*)(F.ws + WS_HID), (const bf16*)(F.ws + WS_DN), 512}; MoeOrder S{F.G, F.bid, tb[NE], tb, cn, (const Entry*)(F.ws + WS_ENT)};
        EpiDown E{(bf16*)(F.ws + WS_Y)};
        pg8::gemm_phase<EpiDown, MoeOrder, false>(F.lds, g, S, E); } SEAM(5);
    if (IN(6)) { moe_tables(F, 0, tb, cn); p6_n1(F, kp, tb); } SEAM(6);
    if (IN(7)) { pg8::Gemm g{(const bf16*)(F.ws + WS_HX), (const bf16*)(F.ws + WS_BTIN), 1024}; G1Order S{F.G, F.bid};
        EpiG1 E{(bf16*)(F.ws + WS_PQKV), (bf16*)(F.ws + WS_Z), (bf16*)(F.ws + WS_HALO), (float*)(F.ws + WS_AB)};
        pg8::gemm_phase<EpiG1, G1Order, false>(F.lds, g, S, E); } SEAM(7);
    if (IN(8)) { p8_c1a(F, kp); asm volatile("s_waitcnt vmcnt(0)" ::: "memory"); __syncthreads(); }
#ifdef PROBE_K
    SEAM(8);
#endif
    if (IN(9)) { p9_c1b(F); } SEAM(9);
    if (IN(10)) { p10_scan(F); } SEAM(10);
    if (IN(11)) { p11_onorm(F, kp); convert_experts(F, kp, 1); } SEAM(11);
    if (IN(12)) { pg8::Gemm g{(const bf16*)(F.ws + WS_HX), (const bf16*)(F.ws + WS_BTOUT), 1024}; G2Order S{F.G, F.bid};
        EpiRaw E{(bf16*)(F.ws + WS_Y2), 0};
        pg8::gemm_phase<EpiRaw, G2Order, false>(F.lds, g, S, E); } SEAM(12);
    if (IN(13)) { p_router(F, kp, 1, TL); } SEAM(13);
    if (IN(14)) { moe_tables(F, 1, tb, cn);
        pg8::Gemm g{(const bf16*)(F.ws + WS_HX), (const bf16*)(F.ws + WS_GU), 1024}; MoeOrder S{F.G, F.bid, tb[NE], tb, cn, (const Entry*)(F.ws + WS_ENT)};
        EpiGU E{(bf16*)(F.ws + WS_HID)};
        pg8::gemm_phase<EpiGU, MoeOrder, true>(F.lds, g, S, E); } SEAM(14);
    if (IN(15)) { moe_tables(F, 1, tb, cn);
        pg8::Gemm g{(const bf16*)(F.ws + WS_HID), (const bf16*)(F.ws + WS_DN), 512}; MoeOrder S{F.G, F.bid, tb[NE], tb, cn, (const Entry*)(F.ws + WS_ENT)};
        EpiDown E{(bf16*)(F.ws + WS_Y)};
        pg8::gemm_phase<EpiDown, MoeOrder, false>(F.lds, g, S, E); } SEAM(15);
    if (IN(16)) { moe_tables(F, 1, tb, cn); p16_final(F, kp, tb); }
#undef IN
#undef SEAM
}

extern "C" void kernel_launch(void* const* d_in, const int* in_sizes, int n_in, void* d_out, int out_size, void* d_ws, size_t ws_size, hipStream_t stream) {
    static int grid = 0;
    if (grid == 0) {
        if (n_in != 25 || out_size != TL * D || ws_size < WS_END) { fprintf(stderr, "kernel_launch: unexpected shapes (n_in %d, out %d, ws %zu < %zu)\n", n_in, out_size, ws_size, (size_t)WS_END); grid = -1; return; }
        int dev = 0, cus = 0, per_cu = 0;
        if (hipGetDevice(&dev) != hipSuccess || hipDeviceGetAttribute(&cus, hipDeviceAttributeMultiprocessorCount, dev) != hipSuccess) { grid = -1; return; }
        if (hipFuncSetAttribute((const void*)fwd_kernel, hipFuncAttributeMaxDynamicSharedMemorySize, LDS_BYTES) != hipSuccess) { fprintf(stderr, "kernel_launch: hipFuncSetAttribute failed\n"); grid = -1; return; }
        if (hipOccupancyMaxActiveBlocksPerMultiprocessor(&per_cu, (const void*)fwd_kernel, NTHR, LDS_BYTES) != hipSuccess || per_cu < 1) fprintf(stderr, "kernel_launch: occupancy query says %d\n", per_cu);
        (void)hipGetLastError();
        grid = cus;
    }
    if (grid < 0) return;
    (void)hipMemsetAsync((char*)d_ws + WS_CTL, 0, CTL_BYTES, stream);
    KP kp{};
    for (int i = 0; i < 25; ++i) kp.in[i] = (const float*)d_in[i];
    kp.out = (float*)d_out; kp.ws = (unsigned char*)d_ws;
#if MK_ONE_LAUNCH
    kp.ph_lo = 0; kp.ph_hi = PH_N;
    hipLaunchKernelGGL(fwd_kernel, dim3(grid), dim3(NTHR), LDS_BYTES, stream, kp);
#else
    for (int ph = 0; ph < PH_N; ++ph) { kp.ph_lo = ph; kp.ph_hi = ph + 1; hipLaunchKernelGGL(fwd_kernel, dim3(grid), dim3(NTHR), LDS_BYTES, stream, kp); }
#endif
}
```

```cpp
#include <hip/hip_runtime.h>
#include <type_traits>
#include <cstdio>
#include <cstdint>

#ifndef MK_ONE_LAUNCH
#define MK_ONE_LAUNCH 1
#endif

#define GAS __attribute__((address_space(1)))
#define LAS __attribute__((address_space(3)))
typedef unsigned short bf16;
typedef short bf16x8 __attribute__((ext_vector_type(8)));
typedef short bf16x4 __attribute__((ext_vector_type(4)));
typedef float f32x4 __attribute__((ext_vector_type(4)));
typedef float f32x2 __attribute__((ext_vector_type(2)));
typedef unsigned u32x4 __attribute__((ext_vector_type(4)));
typedef unsigned u32x2 __attribute__((ext_vector_type(2)));
#define DI __device__ __forceinline__

constexpr int D = 1024, NB = 4, SEQ = 8192, CTXL = 256;
constexpr int TL = NB * SEQ;
constexpr int TC = NB * CTXL;
constexpr int T = TL + TC;
constexpr int NE = 32, DE = 512, NH = 8;
constexpr int NCID = 528;
constexpr int DN_IN = 4128;
constexpr float EPS = 1e-6f;
constexpr int CAP = T;
constexpr int NWAVES = 8, NTHR = 512;

constexpr size_t MiB = 1u << 20;
constexpr size_t WS_CTL = 0, CTL_BYTES = 1 * MiB;
constexpr size_t WS_BTP = 1 * MiB;
constexpr size_t WS_BTOUT = 1 * MiB + 512 * 1024;
constexpr size_t WS_BTIN = 3 * MiB + 512 * 1024;
constexpr size_t WS_MOD = 12 * MiB;
constexpr size_t WS_WRT = 12 * MiB + 256 * 1024;
constexpr size_t WS_WAB = 12 * MiB + 576 * 1024;
constexpr size_t WS_RSTD = 12 * MiB + 704 * 1024;
constexpr size_t WS_XN = 322 * MiB;
constexpr size_t WS_WR2 = 13 * MiB;
constexpr size_t WS_C0 = 13 * MiB + 512 * 1024;
constexpr size_t WS_XC = 14 * MiB;
constexpr size_t WS_TI = 18 * MiB;
constexpr size_t WS_GU = 20 * MiB;
constexpr size_t WS_DN = 84 * MiB;
constexpr size_t WS_TM = 20 * MiB;
constexpr size_t WS_AB = 86 * MiB;
constexpr size_t WS_HALO = 91 * MiB;
constexpr size_t WS_GCB = 101 * MiB;
constexpr size_t WS_HX = 116 * MiB;
constexpr size_t WS_PM = 116 * MiB;
constexpr size_t WS_XS1 = 182 * MiB;
constexpr size_t WS_XS3 = 472 * MiB;
constexpr size_t WS_DD = 182 * MiB;
constexpr size_t WS_YP = 248 * MiB;
constexpr size_t WS_Y2 = 380 * MiB;
constexpr size_t WS_HID = 248 * MiB;
constexpr size_t WS_Y = 322 * MiB;
constexpr size_t WS_PQKV = 182 * MiB;
constexpr size_t WS_Z = 380 * MiB;
constexpr size_t WS_LM = 444 * MiB;
constexpr size_t WS_O = 444 * MiB;
constexpr size_t WS_ENT = 572 * MiB;
constexpr size_t WS_END = 572 * MiB + (size_t)NE * CAP * 8;
static_assert(WS_END <= 581 * MiB, "ws map");
constexpr int CW_BAR = 4096;
constexpr int CW_CNT = 16384, CNT_STRIDE = 1024;
constexpr int LDS_BYTES = 147456;
constexpr int LDS_MISC = 139264;
constexpr int PH_N = 17;

struct Entry { int ts; float w; };
struct KP { const float* in[25]; float* out; unsigned char* ws; int ph_lo, ph_hi; };

typedef __bf16 hwbf2 __attribute__((ext_vector_type(2)));
DI unsigned f2bf(float f) { const __bf16 h = (__bf16)f; return (unsigned)__builtin_bit_cast(unsigned short, h); }
DI unsigned pk2(float lo, float hi) { const f32x2 v = {lo, hi}; const hwbf2 r = __builtin_convertvector(v, hwbf2); return __builtin_bit_cast(unsigned, r); }
DI float bflo(unsigned w) { return __builtin_bit_cast(float, w << 16); }
DI float bfhi(unsigned w) { return __builtin_bit_cast(float, w & 0xffff0000u); }
DI float bf2f(unsigned short b) { return __builtin_bit_cast(float, ((unsigned)b) << 16); }
DI void unpk8(const u32x4 q, f32x4& a, f32x4& b) { a = (f32x4){bflo(q.x), bfhi(q.x), bflo(q.y), bfhi(q.y)}; b = (f32x4){bflo(q.z), bfhi(q.z), bflo(q.w), bfhi(q.w)}; }
DI u32x4 pk8(const f32x4 a, const f32x4 b) { u32x4 q; q.x = pk2(a.x, a.y); q.y = pk2(a.z, a.w); q.z = pk2(b.x, b.y); q.w = pk2(b.z, b.w); return q; }
DI float wave_sum(float v) {
#pragma unroll
    for (int o = 1; o < 64; o <<= 1) v += __shfl_xor(v, o);
    return v;
}
#define LDS_BAR() do { asm volatile("s_waitcnt lgkmcnt(0)" ::: "memory"); __builtin_amdgcn_s_barrier(); asm volatile("" ::: "memory"); } while (0)
DI float siluf(float x) { return x * __builtin_amdgcn_rcpf(1.f + __expf(-x)); }
DI float sigmoidf_(float x) { return __builtin_amdgcn_rcpf(1.f + __expf(-x)); }
DI float softplusf_(float x) { return fmaxf(x, 0.f) + log1pf(__expf(-fabsf(x))); }

#define XB_TMO      128
#define XB_XCNT(j)  (256  + 64 * (j))
#define XB_XSUB(j)  (1280 + 64 * (j))
#define XB_XGEN(j)  (2304 + 64 * (j))
#define XB_TOP      3328
#define XB_TOPGEN   3392
#define XCD_BAR_WORDS 3456
#define XB_SPIN_CAP (1u << 18)
__device__ __forceinline__ unsigned xb_ld(unsigned* p)              { return __hip_atomic_load(p, __ATOMIC_RELAXED, __HIP_MEMORY_SCOPE_AGENT); }
__device__ __forceinline__ unsigned xb_add(unsigned* p, unsigned v) { return __hip_atomic_fetch_add(p, v, __ATOMIC_RELAXED, __HIP_MEMORY_SCOPE_AGENT); }
__device__ __forceinline__ unsigned xb_xcc_id() { return (unsigned)__builtin_amdgcn_s_getreg((3 << 11) | 20) & 0xFu; }
#define XB_SPIN(cond, bar) do { unsigned _sp = 0; while (cond) { __builtin_amdgcn_s_sleep(1); \
    if ((++_sp & 255u) == 0u) { if (xb_ld(&(bar)[XB_TMO])) break; if (_sp > XB_SPIN_CAP) { atomicAdd(&(bar)[XB_TMO], 1u); break; } } } } while (0)
struct XcdBarrier { unsigned* bar; unsigned x; volatile LAS unsigned* st; };
__device__ __forceinline__ XcdBarrier xcd_barrier_post(unsigned* bar, volatile LAS unsigned* st) {
    XcdBarrier b; b.bar = bar; b.x = xb_xcc_id(); b.st = st;
    if (threadIdx.x == 0) (void)xb_add(&bar[XB_XCNT(b.x)], 1u);
    return b;
}
__device__ __forceinline__ void xcd_barrier_complete(unsigned* bar, unsigned x, unsigned& nloc, unsigned& nx) {
    const unsigned G = gridDim.x * gridDim.y * gridDim.z;
    unsigned sum, cnt, mine, sp = 0u;
    for (;;) {
        sum = 0u; cnt = 0u; mine = 0u;
#pragma unroll
        for (unsigned j = 0; j < 16; ++j) { const unsigned c = xb_ld(&bar[XB_XCNT(j)]); sum += c; cnt += (c > 0u) ? 1u : 0u; mine = (j == x) ? c : mine; }
        if (sum == G) break;
        __builtin_amdgcn_s_sleep(1);
        if ((++sp & 255u) == 0u) { if (xb_ld(&bar[XB_TMO])) break; if (sp > XB_SPIN_CAP) { atomicAdd(&bar[XB_TMO], 1u); break; } }
    }
    nloc = mine > 0u ? mine : 1u; nx = cnt > 0u ? cnt : 1u;
}
__device__ __forceinline__ void xcd_barrier(const XcdBarrier& b) {
    asm volatile("s_waitcnt vmcnt(0)" ::: "memory");
    __syncthreads();
    if (threadIdx.x == 0) {
        unsigned* bar = b.bar;
        __builtin_amdgcn_s_waitcnt(0);
        unsigned nloc = b.st[0], nx = b.st[1];
        if (nloc == 0u) { xcd_barrier_complete(bar, b.x, nloc, nx); b.st[0] = nloc; b.st[1] = nx; }
        const unsigned old = xb_add(&bar[XB_XSUB(b.x)], 1u);
        const unsigned gen = old / nloc;
        if (old + 1u == (gen + 1u) * nloc) {
            __builtin_amdgcn_fence(__ATOMIC_RELEASE, "agent");
            asm volatile("s_waitcnt vmcnt(0)" ::: "memory");
            const unsigned og = xb_add(&bar[XB_TOP], 1u);
            const unsigned tg = og / nx;
            if (og + 1u == (tg + 1u) * nx) xb_add(&bar[XB_TOPGEN], 1u);
            else XB_SPIN(xb_ld(&bar[XB_TOPGEN]) == tg, bar);
            __builtin_amdgcn_fence(__ATOMIC_ACQUIRE, "agent");
            xb_add(&bar[XB_XGEN(b.x)], 1u);
            asm volatile("s_waitcnt vmcnt(0)" ::: "memory");
        } else {
            XB_SPIN(xb_ld(&bar[XB_XGEN(b.x)]) == gen, bar);
            __builtin_amdgcn_fence(__ATOMIC_ACQUIRE, "agent");
            asm volatile("s_waitcnt vmcnt(0)" ::: "memory");
        }
    }
    __syncthreads();
}

namespace pg8 {
constexpr int BM = 256, BK = 64, HALF = 128, HTB = HALF * BK * 2, STAGE_BYTES = 8 * HTB;
DI int lds_byte(int r, int c) { const int st = (r >> 4) * 2 + (c >> 5), rr = r & 15, cc = c & 31, ob = rr * 64 + cc * 2; return st * 1024 + (ob ^ (((ob >> 9) & 1) << 5)); }
DI void stage_rc(int b, int& R, int& C) { const int st = b / 1024, sb = b % 1024, swz = sb ^ (((sb >> 9) & 1) << 5); R = (st >> 1) * 16 + swz / 64; C = (st & 1) * 32 + (swz % 64) / 2; }
DI int perm32(int rho) { const int n = rho >> 4, i = rho & 15; return 8 * (i >> 2) + 4 * n + (i & 3); }
struct Unit { int pm, pn, e, rt, nvalid, hoff = 0, halfu = 0; };
struct Gemm { const bf16* A; const bf16* Bt; int K; };

template <class Epi, class Sched, bool GATHER>
DI void gemm_phase(LAS unsigned char* lds, const Gemm g, const Sched& S, const Epi& E) {
    const int tid = threadIdx.x, wid = __builtin_amdgcn_readfirstlane(tid >> 6), lane = tid & 63, wr = wid >> 2, wc = wid & 3, fr = lane & 15, fq = lane >> 4;
    int Kq = g.K; asm volatile("" : "+s"(Kq));
    const int K = Kq, nt = K / BK;
    unsigned voffA[2], voffB[2]; int Rr[2], Cc[2];
#pragma unroll
    for (int i = 0; i < 2; ++i) { int R, C; stage_rc(tid * 16 + i * 8192, R, C); const int Rb = Epi::PERM ? ((R & ~31) + perm32(R & 31)) : R;
        voffA[i] = (unsigned)(R * K + C) * 2u; voffB[i] = (unsigned)((Epi::PERM ? (64 * (R >> 5) + perm32(R & 31)) : Rb) * K + C) * 2u; Rr[i] = R; Cc[i] = C; }
    const size_t kstep = (size_t)(BK * 2);
    const size_t hstep = (size_t)HALF * K * 2;
    const size_t tstep = 2 * hstep;
    const size_t hstepB = Epi::PERM ? (size_t)32 * K * 2 : hstep;
    const unsigned ldsw = (unsigned)wid * 1024u;
    const int aoff = lds_byte(wr * 64 + fr, fq * 8), boff = lds_byte(wc * 32 + fr, fq * 8);
#define PG8_SA(b, h) (((b) * 2 + (h)) * HTB)
#define PG8_SB(b, h) ((4 + (b) * 2 + (h)) * HTB)
#define PG8_STAGE(bufoff, gbase, voff) do { _Pragma("unroll") for (int _i = 0; _i < 2; ++_i) \
        __builtin_amdgcn_global_load_lds((const unsigned*)((const char*)(gbase) + (voff)[_i]), (LAS unsigned*)(lds + (bufoff) + ldsw + _i * 8192), 16, 0, 0); } while (0)
#define PG8_STAGE_A(bufoff, ptr, offs, h, kb) do { _Pragma("unroll") for (int _i = 0; _i < 2; ++_i) { \
        const char* _src = GATHER ? ((const char*)g.A + (offs)[(h) * 2 + _i] + (kb)) : ((const char*)(ptr) + voffA[_i]); \
        __builtin_amdgcn_global_load_lds((const unsigned*)_src, (LAS unsigned*)(lds + (bufoff) + ldsw + _i * 8192), 16, 0, 0); } } while (0)
#define PG8_LDA(dst, b, h) do { _Pragma("unroll") for (int m = 0; m < 4; ++m) _Pragma("unroll") for (int k = 0; k < 2; ++k) dst[m][k] = *(const LAS bf16x8*)(lds + PG8_SA(b, h) + aoff + m * 2048 + k * 1024); } while (0)
#define PG8_LDB(dst, b, h) do { _Pragma("unroll") for (int n = 0; n < 2; ++n) _Pragma("unroll") for (int k = 0; k < 2; ++k) dst[n][k] = *(const LAS bf16x8*)(lds + PG8_SB(b, h) + boff + n * 2048 + k * 1024); } while (0)
#define PG8_MMA(ai, bj, At, Bt) do { __builtin_amdgcn_s_setprio(1); _Pragma("unroll") for (int m = 0; m < 4; ++m) _Pragma("unroll") for (int n = 0; n < 2; ++n) _Pragma("unroll") for (int k = 0; k < 2; ++k) \
        acc[ai][bj][m][n] = __builtin_amdgcn_mfma_f32_16x16x32_bf16(Bt[n][k], At[m][k], acc[ai][bj][m][n], 0, 0, 0); __builtin_amdgcn_s_setprio(0); } while (0)
#define PG8_WAIT_V(n) asm volatile("s_waitcnt vmcnt(" #n ")" ::: "memory")
#define PG8_WAIT_L(n) asm volatile("s_waitcnt lgkmcnt(" #n ")" ::: "memory")
#define PG8_BAR __builtin_amdgcn_s_barrier()
#define PG8_SCHED __builtin_amdgcn_sched_barrier(0)
    LAS unsigned char* og = lds + 8 * HTB + wid * 1024;
#define PG8_OFFS_ISSUE(u) do { _Pragma("unroll") for (int _h = 0; _h < 2; ++_h) _Pragma("unroll") for (int _i = 0; _i < 2; ++_i) \
        __builtin_amdgcn_global_load_lds((const unsigned*)S.row_ptr((u), ((u).halfu ? (u).hoff : _h * HALF) + Rr[_i]), (LAS unsigned*)(og + (_h * 2 + _i) * 256), 4, 0, 0); } while (0)
#define PG8_OFFS_READ(o) do { _Pragma("unroll") for (int _q = 0; _q < 4; ++_q) (o)[_q] = S.off_of(*(const LAS int*)(og + _q * 256 + lane * 4)) + (unsigned)Cc[_q & 1] * 2u; } while (0)
    Unit cur, nxt, nn; int ui = 0;
    if (!S.next(0, cur)) return;
    bool has_next = S.next(1, nxt);
    f32x4 acc[2][2][4][2];
#pragma unroll
    for (int a = 0; a < 2; ++a)
#pragma unroll
        for (int b = 0; b < 2; ++b)
#pragma unroll
            for (int m = 0; m < 4; ++m)
#pragma unroll
                for (int n = 0; n < 2; ++n) acc[a][b][m][n] = (f32x4){0.f, 0.f, 0.f, 0.f};
    bf16x8 At[4][2], B0[2][2], B1[2][2];
    unsigned oc[4] = {0u, 0u, 0u, 0u}, on[4] = {0u, 0u, 0u, 0u};
    const char* cA = GATHER ? (const char*)g.A : (const char*)g.A + (size_t)cur.pm * tstep + (size_t)cur.hoff * K * 2; const char* cB = (const char*)g.Bt + (size_t)cur.pn * tstep;
    if (GATHER) { PG8_OFFS_ISSUE(cur); PG8_WAIT_V(0); PG8_OFFS_READ(oc); PG8_WAIT_L(0);
        if (has_next) { PG8_OFFS_ISSUE(nxt); PG8_WAIT_V(0); PG8_OFFS_READ(on); PG8_WAIT_L(0); } else {
#pragma unroll
        for (int q = 0; q < 4; ++q) on[q] = oc[q]; } }
    PG8_STAGE(PG8_SB(0, 0), cB, voffB); PG8_STAGE_A(PG8_SA(0, 0), cA, oc, 0, 0); PG8_STAGE(PG8_SB(0, 1), cB + hstepB, voffB); PG8_STAGE_A(PG8_SA(0, 1), cA + hstep, oc, 1, 0);
    if (wr == 1) PG8_BAR;
    PG8_WAIT_V(4); PG8_BAR;
    PG8_STAGE(PG8_SB(1, 0), cB + kstep, voffB); PG8_STAGE_A(PG8_SA(1, 0), cA + kstep, oc, 0, kstep); PG8_STAGE(PG8_SB(1, 1), cB + hstepB + kstep, voffB);
    PG8_WAIT_V(6); PG8_BAR;
    for (;;) {
        const char* nA = GATHER ? cA : (has_next ? (const char*)g.A + (size_t)nxt.pm * tstep + (size_t)nxt.hoff * K * 2 : cA); const char* nB = has_next ? (const char*)g.Bt + (size_t)nxt.pn * tstep : cB;
        for (int t = 0; t < nt; t += 2) {
            const bool last = (t == nt - 2);
            const char* a1 = cA + (size_t)(t + 1) * kstep;
            const char* a2 = last ? nA : cA + (size_t)(t + 2) * kstep; const char* b2 = last ? nB : cB + (size_t)(t + 2) * kstep;
            const char* a3 = a2 + kstep; const char* b3 = b2 + kstep;
            const size_t k1 = (size_t)(t + 1) * kstep, k2 = last ? (size_t)0 : (size_t)(t + 2) * kstep, k3 = k2 + kstep;
            unsigned o2[4];
#pragma unroll
            for (int q = 0; q < 4; ++q) o2[q] = last ? on[q] : oc[q];
            PG8_LDB(B0, 0, 0); PG8_SCHED; PG8_LDA(At, 0, 0); PG8_STAGE_A(PG8_SA(1, 1), a1 + hstep, oc, 1, k1);
            PG8_WAIT_L(8); PG8_BAR; PG8_WAIT_L(0); PG8_MMA(0, 0, At, B0); PG8_BAR; PG8_SCHED;
            PG8_LDB(B1, 0, 1); PG8_STAGE(PG8_SB(0, 0), b2, voffB);
            PG8_BAR; PG8_WAIT_L(0); PG8_MMA(0, 1, At, B1); PG8_BAR;
            PG8_LDA(At, 0, 1); PG8_STAGE_A(PG8_SA(0, 0), a2, o2, 0, k2);
            PG8_BAR; PG8_WAIT_L(0); if (!cur.halfu) PG8_MMA(1, 0, At, B0); PG8_BAR; PG8_SCHED;
            PG8_STAGE(PG8_SB(0, 1), b2 + hstepB, voffB);
            PG8_WAIT_V(6); PG8_BAR; if (!cur.halfu) PG8_MMA(1, 1, At, B1); PG8_BAR;
            PG8_LDB(B0, 1, 0); PG8_SCHED; PG8_LDA(At, 1, 0); PG8_STAGE_A(PG8_SA(0, 1), a2 + hstep, o2, 1, k2);
            PG8_WAIT_L(8); PG8_BAR; PG8_WAIT_L(0); PG8_MMA(0, 0, At, B0); PG8_BAR; PG8_SCHED;
            PG8_LDB(B1, 1, 1); PG8_STAGE(PG8_SB(1, 0), b3, voffB);
            PG8_BAR; PG8_WAIT_L(0); PG8_MMA(0, 1, At, B1); PG8_BAR;
            PG8_LDA(At, 1, 1); PG8_STAGE_A(PG8_SA(1, 0), a3, o2, 0, k3);
            PG8_BAR; PG8_WAIT_L(0); if (!cur.halfu) PG8_MMA(1, 0, At, B0); PG8_BAR; PG8_SCHED;
            PG8_STAGE(PG8_SB(1, 1), b3 + hstepB, voffB);
            PG8_WAIT_V(6); PG8_BAR; if (!cur.halfu) PG8_MMA(1, 1, At, B1); PG8_BAR;
        }
        bool has_nn = false;
#pragma unroll
        for (int q = 0; q < 4; ++q) oc[q] = on[q];
        if (has_next) { has_nn = S.next(ui + 2, nn); if (GATHER && has_nn) PG8_OFFS_ISSUE(nn); }
        E(acc, cur, wr, wc, fr, fq);
        if (!has_next) break;
        if (GATHER && has_nn) {
            if (cur.halfu) asm volatile("s_waitcnt vmcnt(%0)" :: "n"(Epi::NSTORES / 2) : "memory"); else asm volatile("s_waitcnt vmcnt(%0)" :: "n"(Epi::NSTORES) : "memory");
            PG8_OFFS_READ(on); }
#pragma unroll
        for (int a = 0; a < 2; ++a)
#pragma unroll
            for (int b = 0; b < 2; ++b)
#pragma unroll
                for (int m = 0; m < 4; ++m)
#pragma unroll
                    for (int n = 0; n < 2; ++n) acc[a][b][m][n] = (f32x4){0.f, 0.f, 0.f, 0.f};
        cur = nxt; cA = nA; cB = nB; ++ui;
        nxt = nn; has_next = has_nn;
    }
    PG8_WAIT_V(0);
    if (wr == 0) PG8_BAR;
    PG8_BAR;
#undef PG8_SA
#undef PG8_SB
#undef PG8_STAGE
#undef PG8_STAGE_A
#undef PG8_LDA
#undef PG8_LDB
#undef PG8_MMA
#undef PG8_WAIT_V
#undef PG8_WAIT_L
#undef PG8_BAR
#undef PG8_SCHED
#undef PG8_OFFS_ISSUE
#undef PG8_OFFS_READ
}
}
using pg8::Unit;

struct Frame {
    LAS unsigned char* lds;
    int tid, lane, wave, bid, G;
    unsigned char* ws; float* out;
};
DI float* xs_row(const Frame& F, int t) { return t < TL ? F.out + (size_t)t * D : (float*)(F.ws + WS_XC) + (size_t)(t - TL) * D; }
DI int mod_row(int t) { return t < TL ? (t >> 13) : 4; }
DI const float* modp(const Frame& F, int l, int r, int chunk) { return (const float*)(F.ws + WS_MOD) + ((size_t)(l * 5 + r) * 6 + chunk) * D; }

DI void tr_item(const float* W, int N, int k0, int n0, bf16* WT, int K, int drow0, LAS float* scr, int lane) {
    float wv[32];
#pragma unroll
    for (int i = 0; i < 32; ++i) wv[i] = __builtin_nontemporal_load(W + (size_t)(k0 + 2 * i + (lane >> 5)) * N + n0 + (lane & 31));
#pragma unroll
    for (int i = 0; i < 32; ++i) scr[(2 * i + (lane >> 5)) * 33 + (lane & 31)] = wv[i];
    asm volatile("s_waitcnt lgkmcnt(0)" ::: "memory");
    const int c = lane & 7;
#pragma unroll
    for (int j = 0; j < 4; ++j) { const int n = (lane >> 3) + 8 * j; const LAS float* s = scr + (8 * c) * 33 + n;
        u32x4 o; o.x = pk2(s[0 * 33], s[1 * 33]); o.y = pk2(s[2 * 33], s[3 * 33]); o.z = pk2(s[4 * 33], s[5 * 33]); o.w = pk2(s[6 * 33], s[7 * 33]);
        *(u32x4*)(WT + (size_t)(drow0 + n) * K + k0 + 8 * c) = o; }
    asm volatile("s_waitcnt lgkmcnt(0)" ::: "memory");
}
DI void convert_experts(const Frame& F, const KP& p, int l) {
    LAS float* scr = (LAS float*)(F.lds + F.wave * 16384);
    const int gw = F.bid * NWAVES + F.wave, NGW = F.G * NWAVES;
    const float* wg = p.in[21] + (size_t)l * NE * D * DE; const float* wu = p.in[22] + (size_t)l * NE * D * DE; const float* wd = p.in[23] + (size_t)l * NE * DE * D;
    bf16* GU = (bf16*)(F.ws + WS_GU); bf16* DN = (bf16*)(F.ws + WS_DN);
    for (int it = gw; it < 3 * 8192; it += NGW) {
        const int which = it >> 13, r8 = it & 8191, e = r8 >> 8, r = r8 & 255;
        if (which < 2) { const int kb = r >> 4, nb = r & 15, n0 = 32 * nb;
            tr_item((which ? wu : wg) + (size_t)e * D * DE, DE, 64 * kb, n0, GU, D, e * 1024 + 256 * (n0 >> 7) + 64 * ((n0 & 127) >> 5) + (which ? 32 : 0), scr, F.lane); }
        else { const int kb = r >> 5, nb = r & 31, n0 = 32 * nb;
            tr_item(wd + (size_t)e * DE * D, D, 64 * kb, n0, DN, DE, e * 1024 + n0, scr, F.lane); }
    }
}
DI void p0_prologue(const Frame& F, const KP& p) {
    const int gw = F.bid * NWAVES + F.wave, NGW = F.G * NWAVES;
    {
        LAS float* sc = (LAS float*)(F.lds);
        LAS float* part = (LAS float*)(F.lds + 32768);
        for (int i = F.tid; i < 5 * D; i += NTHR) { const int r = i >> 10, k = i & 1023; const float v = r < 4 ? p.in[1][r * D + k] : p.in[3][k]; sc[i] = siluf(v); }
        __syncthreads();
        for (int item = F.bid; item < 192; item += F.G) {
            const int l = item / 96, n0 = (item % 96) * 64;
            const float* w = p.in[4] + (size_t)l * D * 6144 + n0 + F.lane;
            float a0 = 0.f, a1 = 0.f, a2 = 0.f, a3 = 0.f, a4 = 0.f;
            const int kb = F.wave * 128;
#pragma unroll 32
            for (int k = 0; k < 128; ++k) { const float wv = __builtin_nontemporal_load(w + (size_t)(kb + k) * 6144);
                a0 += sc[kb + k] * wv; a1 += sc[D + kb + k] * wv; a2 += sc[2 * D + kb + k] * wv; a3 += sc[3 * D + kb + k] * wv; a4 += sc[4 * D + kb + k] * wv; }
            part[(F.wave * 5 + 0) * 64 + F.lane] = a0; part[(F.wave * 5 + 1) * 64 + F.lane] = a1; part[(F.wave * 5 + 2) * 64 + F.lane] = a2;
            part[(F.wave * 5 + 3) * 64 + F.lane] = a3; part[(F.wave * 5 + 4) * 64 + F.lane] = a4;
            __syncthreads();
            if (F.tid < 320) { const int r = F.tid >> 6, n = F.tid & 63; float s = p.in[5][l * 6144 + n0 + n];
#pragma unroll
                for (int w8 = 0; w8 < 8; ++w8) s += part[(w8 * 5 + r) * 64 + n];
                ((float*)(F.ws + WS_MOD))[(size_t)(l * 5 + r) * 6144 + n0 + n] = s; }
            __syncthreads();
        }
        __syncthreads();
    }
    {
        LAS float* scr = (LAS float*)(F.lds + F.wave * 16384);
        constexpr int I_POOL = 128, I_IN = 2048 + 16, I_OUT = 512;
        for (int it = gw; it < I_POOL + I_IN + I_OUT; it += NGW) {
            int r = it;
            if (r < I_POOL) { const int g = r >> 5, q = r & 31, kb = q >> 3, nb = q & 7; tr_item(p.in[8] + (size_t)g * 65536, 256, 64 * kb, 32 * nb, (bf16*)(F.ws + WS_BTP), 256, g * 256 + 32 * nb, scr, F.lane); continue; }
            r -= I_POOL;
            if (r < I_IN) { const int kb = r < 2048 ? (r >> 7) : (r - 2048), nb = r < 2048 ? (r & 127) : 128; tr_item(p.in[11], DN_IN, 64 * kb, 32 * nb, (bf16*)(F.ws + WS_BTIN), D, 32 * nb, scr, F.lane); continue; }
            r -= I_IN;
            { const int kb = r >> 5, nb = r & 31; tr_item(p.in[16], D, 64 * kb, 32 * nb, (bf16*)(F.ws + WS_BTOUT), D, 32 * nb, scr, F.lane); }
        }
    }
    {
        const int gt = F.bid * NTHR + F.tid, NGT = F.G * NTHR;
        bf16* wr2 = (bf16*)(F.ws + WS_WR2);
        for (int i = gt; i < 2 * 48 * D; i += NGT) { const int l = i / (48 * D), r = i % (48 * D), j = r >> 10, k = r & 1023;
            const float w = j < 4 ? p.in[17][((size_t)l * D + k) * 4 + j] : (j < 36 ? p.in[19][((size_t)l * D + k) * 32 + (j - 4)] : 0.f);
            const unsigned hi = f2bf(w); const float rem = w - bf2f((unsigned short)hi);
            wr2[(size_t)(l * 2 + 0) * 48 * D + r] = (bf16)hi; wr2[(size_t)(l * 2 + 1) * 48 * D + r] = (bf16)f2bf(rem); }
        u32x4* zr = (u32x4*)((bf16*)(F.ws + WS_BTIN) + (size_t)4128 * D);
        for (int i = gt; i < 224 * D / 8; i += NGT) zr[i] = (u32x4){0u, 0u, 0u, 0u};
    }
    {
        float* rs = (float*)(F.ws + WS_RSTD);
        f32x4 nv[4];
        { const f32x4* xr = (const f32x4*)(p.in[0] + (size_t)gw * D) + F.lane;
#pragma unroll
          for (int j = 0; j < 4; ++j) nv[j] = xr[64 * j]; }
        for (int t = gw; t < T; t += NGW) {
            float s = 0.f; f32x4 v[4];
#pragma unroll
            for (int j = 0; j < 4; ++j) v[j] = nv[j];
            { const int tn = t + NGW; if (tn < T) { const f32x4* xr = (const f32x4*)(tn < TL ? p.in[0] + (size_t)tn * D : p.in[2] + (size_t)(tn - TL) * D) + F.lane;
#pragma unroll
                for (int j = 0; j < 4; ++j) nv[j] = xr[64 * j]; } }
#pragma unroll
            for (int j = 0; j < 4; ++j) s += (v[j].x * v[j].x + v[j].y * v[j].y) + (v[j].z * v[j].z + v[j].w * v[j].w);
            s = wave_sum(s);
            const float rstd = rsqrtf(s * (1.f / D) + EPS);
            if (F.lane == 0) rs[t] = rstd;
            if (t < TL) { bf16* xo = (bf16*)(F.ws + WS_XN) + (size_t)t * D + 4 * F.lane;
#pragma unroll
                for (int j = 0; j < 4; ++j) { u32x2 o; o.x = pk2(v[j].x * rstd, v[j].y * rstd); o.y = pk2(v[j].z * rstd, v[j].w * rstd); *(u32x2*)(xo + 256 * j) = o; } }
        }
    }
}

DI void p1_pool_diff(const Frame& F, const KP& p) {
    const float* rs = (const float*)(F.ws + WS_RSTD);
    bf16* DD = (bf16*)(F.ws + WS_DD);
    LAS f32x4* Vs = (LAS f32x4*)(F.lds);
    const int ch4 = F.tid & 63, cg = F.tid >> 6;
    {
        const int gw = F.bid * NWAVES + F.wave;
        if (gw < 2 * 5 * 36) { const int l = gw / 180, q = gw % 180, r = q / 36, j = q % 36; const float* b2 = modp(F, l, r, 3); float s = 0.f;
            float bw[16], ww[16];
#pragma unroll
            for (int i = 0; i < 16; ++i) { const int c = F.lane + 64 * i; bw[i] = b2[c]; ww[i] = j < 4 ? p.in[17][((size_t)l * D + c) * 4 + j] : p.in[19][((size_t)l * D + c) * 32 + (j - 4)]; }
#pragma unroll
            for (int i = 0; i < 16; ++i) s += bw[i] * ww[i];
            s = wave_sum(s);
            if (F.lane == 0) ((float*)(F.ws + WS_C0))[(l * 5 + r) * 48 + j] = s + (j < 4 ? p.in[18][l * 4 + j] : p.in[20][l * 32 + (j - 4)]); }
    }
    for (int it = F.bid; it < 256 + 64; it += F.G) {
        if (it < 256) {
            const int g = it & 3, bb = it >> 2, b = bb >> 4, r0 = (bb & 15) * 8, hw = 1 << g;
            const int ch = g * 256 + 4 * ch4;
            f32x4 A4 = *(const f32x4*)(p.in[6] + ch); { const f32x4 s4 = *(const f32x4*)(modp(F, 0, b, 1) + ch); A4 = A4 * (s4 + 1.f); }
            const int rlo = max(r0 - hw, 0);
            const bf16* xb = (const bf16*)(F.ws + WS_XN) + (size_t)b * SEQ * D + ch + (size_t)(8 * cg) * D;
#define P1_LD(rw, cc) (*(const u32x2*)(xb + (size_t)((rw) * 64 + (cc)) * D))
#define P1_UP(w) ((f32x4){bflo((w).x), bfhi((w).x), bflo((w).y), bfhi((w).y)})
            f32x4 S[8];
#pragma unroll
            for (int cc = 0; cc < 8; ++cc) S[cc] = (f32x4){0.f, 0.f, 0.f, 0.f};
            { const int rend = min(r0 + hw, 128); int rr = rlo;
              for (; rr + 2 <= rend; rr += 2) { u32x2 w0[8], w1[8];
#pragma unroll
                  for (int cc = 0; cc < 8; ++cc) { w0[cc] = P1_LD(rr, cc); w1[cc] = P1_LD(rr + 1, cc); }
#pragma unroll
                  for (int cc = 0; cc < 8; ++cc) S[cc] += P1_UP(w0[cc]) + P1_UP(w1[cc]); }
              if (rr < rend) {
#pragma unroll
                  for (int cc = 0; cc < 8; ++cc) { const u32x2 w0 = P1_LD(rr, cc); S[cc] += P1_UP(w0); } } }
            u32x2 nc[8], na[8], ns[8];
#define P1_ROWLOAD(r) do { const bool ha_ = ((r) + hw) < 128, hs_ = ((r) - hw) >= 0; _Pragma("unroll") for (int cc = 0; cc < 8; ++cc) { nc[cc] = P1_LD((r), cc); \
                na[cc] = ha_ ? P1_LD((r) + hw, cc) : (u32x2){0u, 0u}; ns[cc] = hs_ ? P1_LD((r) - hw, cc) : (u32x2){0u, 0u}; } } while (0)
            P1_ROWLOAD(r0);
            for (int r = r0; r < r0 + 8; ++r) {
                const int lo_r = max(r - hw, 0), hi_r = min(r + hw, 128);
                u32x2 xc[8], xa[8], xs_[8];
#pragma unroll
                for (int cc = 0; cc < 8; ++cc) { xc[cc] = nc[cc]; xa[cc] = na[cc]; xs_[cc] = ns[cc]; }
                if (r + 1 < r0 + 8) P1_ROWLOAD(r + 1);
#pragma unroll
                for (int cc = 0; cc < 8; ++cc) Vs[(8 * cg + cc) * 64 + ch4] = S[cc];
                __syncthreads();
                f32x4 h = {0.f, 0.f, 0.f, 0.f};
                { const int c0 = 8 * cg, l0 = max(c0 - hw, 0), h0 = min(c0 + hw, 64); for (int c2 = l0; c2 < h0; ++c2) h += Vs[c2 * 64 + ch4]; }
#pragma unroll
                for (int cc = 0; cc < 8; ++cc) { const int col = 8 * cg + cc, lo_c = max(col - hw, 0), hi_c = min(col + hw, 64);
                    if (cc > 0) { if (col + hw <= 64) h += Vs[(col + hw - 1) * 64 + ch4]; if (col - hw > 0) h -= Vs[(col - hw - 1) * 64 + ch4]; }
                    const int t = b * SEQ + r * 64 + col; const float inv = __builtin_amdgcn_rcpf((float)((hi_r - lo_r) * (hi_c - lo_c)));
                    const f32x4 xn = P1_UP(xc[cc]);
                    const f32x4 d = A4 * (h * inv - xn);
                    u32x2 o; o.x = pk2(d.x, d.y); o.y = pk2(d.z, d.w);
                    *(u32x2*)(DD + ((size_t)g * T + t) * 256 + 4 * ch4) = o; }
#pragma unroll
                for (int cc = 0; cc < 8; ++cc) S[cc] += P1_UP(xa[cc]) - P1_UP(xs_[cc]);
                __syncthreads();
            }
#undef P1_LD
#undef P1_UP
#undef P1_ROWLOAD
        } else {
            const int i2 = it - 256, g = i2 & 3, b = (i2 >> 2) & 3, q4 = i2 >> 4, hw = 1 << g;
            const int ch = g * 256 + 4 * ch4;
            f32x4 A4 = *(const f32x4*)(p.in[6] + ch); { const f32x4 s4 = *(const f32x4*)(modp(F, 0, 4, 1) + ch); A4 = A4 * (s4 + 1.f); }
            const int j0 = 64 * q4 + 8 * cg; const float* cx = p.in[2] + (size_t)(b * CTXL) * D + ch; const float* crs = rs + TL + b * CTXL;
            f32x4 win = {0.f, 0.f, 0.f, 0.f};
#pragma unroll 1
            for (int kb = 0; kb < 2 * hw; kb += 8) { f32x4 v[8]; float w[8];
#pragma unroll
              for (int k = 0; k < 8; ++k) { const int jj = j0 - hw + kb + k, jc = min(max(jj, 0), CTXL - 1); const bool ok = kb + k < 2 * hw && jj >= 0 && jj < CTXL;
                  v[k] = *(const f32x4*)(cx + (size_t)jc * D); w[k] = ok ? crs[jc] : 0.f; }
#pragma unroll
              for (int k = 0; k < 8; ++k) win += v[k] * w[k]; }
#pragma unroll 1
            for (int c4 = 0; c4 < 8; c4 += 4) {
            f32x4 ve[4], vl[4], xc[4]; float we[4], wl[4], wc[4];
#pragma unroll
            for (int q = 0; q < 4; ++q) { const int cc = c4 + q; const int je = j0 + cc - 1 + hw, jl = j0 + cc - 1 - hw, jec = min(max(je, 0), CTXL - 1), jlc = min(max(jl, 0), CTXL - 1);
                ve[q] = *(const f32x4*)(cx + (size_t)jec * D); we[q] = (cc > 0 && je < CTXL) ? crs[jec] : 0.f;
                vl[q] = *(const f32x4*)(cx + (size_t)jlc * D); wl[q] = (cc > 0 && jl >= 0) ? crs[jlc] : 0.f;
                xc[q] = *(const f32x4*)(cx + (size_t)(j0 + cc) * D); wc[q] = crs[j0 + cc]; }
#pragma unroll
            for (int q = 0; q < 4; ++q) { const int cc = c4 + q; const int j = j0 + cc, lo = max(j - hw, 0), hi = min(j + hw, CTXL);
                win += ve[q] * we[q] - vl[q] * wl[q];
                const int t = TL + b * CTXL + j; const float inv = 1.f / (float)(hi - lo);
                const f32x4 xn = xc[q] * wc[q];
                const f32x4 d = A4 * (win * inv - xn);
                u32x2 o; o.x = pk2(d.x, d.y); o.y = pk2(d.z, d.w);
                *(u32x2*)(DD + ((size_t)g * T + t) * 256 + 4 * ch4) = o; } }
        }
    }
}

struct PoolOrder {
    int G, c;
    DI bool next(int i, Unit& u) const { int L = i * G + c; u.hoff = 0; u.halfu = 0;
        if (G == 256 && i == 2) { if (c >= 32) return false; L = 512 + (c >> 1); u.hoff = 128 * (c & 1); u.halfu = 1; }
        if (L >= 528) return false; u.pm = L; u.pn = L / 132; u.e = 0; u.rt = 0; u.nvalid = 0; return true; }
    DI const int* row_ptr(const Unit&, int) const { return nullptr; }
    DI unsigned off_of(int) const { return 0u; }
};
struct G1Order {
    int G, c;
    DI bool next(int i, Unit& u) const {
        if (G == 256) { if (i < 8) { const int x = c & 7, j = c >> 3; u.pm = (i * 8 + x) * 2 + (j >> 4); u.pn = j & 15; }
            else { const int q = (i - 8) * 256 + c; if (q >= 48 + 132) return false; if (q < 48) { u.pm = 128 + q / 12; u.pn = q % 12; } else { u.pm = q - 48; u.pn = 16; } } }
        else { const int L = i * G + c; if (L >= 2176 + 52) return false;
            if (L < 2176) { u.pm = L / 17; u.pn = L % 17; } else { const int q = L - 2176, q13 = q % 13; u.pm = 128 + q / 13; u.pn = q13 < 12 ? q13 : 16; } }
        u.e = 0; u.rt = 0; u.nvalid = 0; return true; }
    DI const int* row_ptr(const Unit&, int) const { return nullptr; }
    DI unsigned off_of(int) const { return 0u; }
};
struct G2Order {
    int G, c;
    DI bool next(int i, Unit& u) const {
        if (G == 256) { if (i >= 2) return false; const int x = c & 7, j = c >> 3; u.pm = (i * 8 + x) * 8 + (j >> 2); u.pn = j & 3; }
        else { const int L = i * G + c; if (L >= 512) return false; u.pm = L >> 2; u.pn = L & 3; }
        u.e = 0; u.rt = 0; u.nvalid = 0; return true; }
    DI const int* row_ptr(const Unit&, int) const { return nullptr; }
    DI unsigned off_of(int) const { return 0u; }
};
struct MoeOrder {
    int G, c, total; const LAS int* tb; const LAS int* cn; const Entry* ent;
    DI bool next(int i, Unit& u) const { int rtg, ct;
        u.hoff = 0; u.halfu = 0;
        if (G == 256) { const int x = c & 7, j = c >> 3, rem = total - 64 * i;
            if (rem > 32) { ct = j & 3; rtg = 64 * i + 8 * x + (j >> 2); if (rtg >= total) return false; }
            else { if (rem <= 0) return false;
                ct = j & 3; rtg = 64 * i + 4 * x + (j >> 3); if (rtg >= total) return false; u.halfu = 1; u.hoff = 128 * ((j >> 2) & 1); } }
        else { const int L = i * G + c; if (L >= 4 * total) return false; rtg = L >> 2; ct = L & 3; }
        int e = 0;
        for (int q = 1; q < NE; ++q) e += (tb[q] <= rtg) ? 1 : 0;
        e = __builtin_amdgcn_readfirstlane(e);
        const int tbe = __builtin_amdgcn_readfirstlane(tb[e]), cne = __builtin_amdgcn_readfirstlane(cn[e]);
        u.pm = rtg; u.pn = e * 4 + ct; u.e = e; u.rt = rtg - tbe; u.nvalid = cne - u.rt * 256; return true; }
    DI const int* row_ptr(const Unit& u, int row) const { return &ent[(size_t)u.e * CAP + u.rt * 256 + min(row, u.nvalid - 1)].ts; }
    DI unsigned off_of(int ts) const { return (unsigned)(ts >> 1) * (unsigned)(D * 2); }
};
DI void moe_tables(const Frame& F, int l, LAS int* tb, LAS int* cn) {
    if (F.tid < 64) { const unsigned* cnt = (const unsigned*)(F.ws + WS_CTL) + CW_CNT + l * 32 * CNT_STRIDE;
        const int c = F.tid < NE ? (int)__hip_atomic_load(cnt + F.tid * CNT_STRIDE, __ATOMIC_RELAXED, __HIP_MEMORY_SCOPE_AGENT) : 0;
        const int ntl = (c + 255) >> 8; int inc = ntl;
#pragma unroll
        for (int o = 1; o < 32; o <<= 1) { const int up = __shfl_up(inc, o); if (F.lane >= o) inc += up; }
        if (F.tid < NE) { cn[F.tid] = c; tb[F.tid] = inc - ntl; if (F.tid == NE - 1) tb[NE] = inc; } }
    __syncthreads();
}

struct EpiRaw {
    static constexpr bool PERM = true; static constexpr int NSTORES = 16;
    bf16* o; int pool;
    DI void operator()(const f32x4 (&acc)[2][2][4][2], const Unit& u, int, int, int, int) const {
        int tz = threadIdx.x; asm volatile("" : "+v"(tz)); const int wr = tz >> 8, wc = (tz >> 6) & 3, fr = tz & 15, fq = (tz >> 4) & 3;
        const int rt = pool ? u.pm - 132 * u.pn : u.pm;
#pragma unroll
        for (int ai = 0; ai < 2; ++ai)
#pragma unroll
            for (int m = 0; m < 4; ++m) { if (ai == 1 && u.halfu) continue; bf16* dst = o + (size_t)(rt * 256 + u.hoff + ai * 128 + wr * 64 + m * 16 + fr) * D + u.pn * 256 + wc * 64 + 8 * fq;
#pragma unroll
                for (int bj = 0; bj < 2; ++bj) { const f32x4 v0 = acc[ai][bj][m][0], v1 = acc[ai][bj][m][1];
                    u32x4 w; w.x = pk2(v0.x, v0.y); w.y = pk2(v0.z, v0.w); w.z = pk2(v1.x, v1.y); w.w = pk2(v1.z, v1.w);
                    *(u32x4*)(dst + bj * 32) = w; } }
    }
};
struct EpiGU {
    static constexpr bool PERM = true; static constexpr int NSTORES = 8;
    bf16* hid;
    DI void operator()(const f32x4 (&acc)[2][2][4][2], const Unit& u, int, int, int, int) const {
        int tz = threadIdx.x; asm volatile("" : "+v"(tz)); const int wr = tz >> 8, wc = (tz >> 6) & 3, fr = tz & 15, fq = (tz >> 4) & 3;
        const int ct = u.pn & 3;
#pragma unroll
        for (int ai = 0; ai < 2; ++ai)
#pragma unroll
            for (int m = 0; m < 4; ++m) { if (ai == 1 && u.halfu) continue; const size_t row = (size_t)u.pm * 256 + u.hoff + ai * 128 + wr * 64 + m * 16 + fr;
                const f32x4 g0 = acc[ai][0][m][0], g1 = acc[ai][0][m][1], u0 = acc[ai][1][m][0], u1 = acc[ai][1][m][1];
                u32x4 w; w.x = pk2(siluf(g0.x) * u0.x, siluf(g0.y) * u0.y); w.y = pk2(siluf(g0.z) * u0.z, siluf(g0.w) * u0.w);
                w.z = pk2(siluf(g1.x) * u1.x, siluf(g1.y) * u1.y); w.w = pk2(siluf(g1.z) * u1.z, siluf(g1.w) * u1.w);
                *(u32x4*)(hid + row * DE + ct * 128 + wc * 32 + 8 * fq) = w; }
    }
};
struct EpiDown {
    static constexpr bool PERM = true; static constexpr int NSTORES = 16;
    bf16* y;
    DI void operator()(const f32x4 (&acc)[2][2][4][2], const Unit& u, int, int, int, int) const {
        int tz = threadIdx.x; asm volatile("" : "+v"(tz)); const int wr = tz >> 8, wc = (tz >> 6) & 3, fr = tz & 15, fq = (tz >> 4) & 3;
        const int ct = u.pn & 3;
#pragma unroll
        for (int ai = 0; ai < 2; ++ai)
#pragma unroll
            for (int m = 0; m < 4; ++m) { if (ai == 1 && u.halfu) continue; const size_t row = (size_t)u.pm * 256 + u.hoff + ai * 128 + wr * 64 + m * 16 + fr;
                bf16* dst = y + row * D + ct * 256 + wc * 64 + 8 * fq;
#pragma unroll
                for (int bj = 0; bj < 2; ++bj) { const f32x4 v0 = acc[ai][bj][m][0], v1 = acc[ai][bj][m][1];
                    u32x4 w; w.x = pk2(v0.x, v0.y); w.y = pk2(v0.z, v0.w); w.z = pk2(v1.x, v1.y); w.w = pk2(v1.z, v1.w);
                    *(u32x4*)(dst + bj * 32) = w; } }
    }
};
struct EpiG1 {
    static constexpr bool PERM = true; static constexpr int NSTORES = 16;
    bf16* pqkv; bf16* z; bf16* halo; float* ab;
    DI void operator()(const f32x4 (&acc)[2][2][4][2], const Unit& u, int, int, int, int) const {
        int tz = threadIdx.x; asm volatile("" : "+v"(tz)); const int wr = tz >> 8, wc = (tz >> 6) & 3, fr = tz & 15, fq = (tz >> 4) & 3;
#pragma unroll
        for (int ai = 0; ai < 2; ++ai)
#pragma unroll
            for (int m = 0; m < 4; ++m) { const int t = u.pm * 256 + ai * 128 + wr * 64 + m * 16 + fr, rr = m * 16 + fr;
#pragma unroll
                for (int bj = 0; bj < 2; ++bj) { const f32x4 v0 = acc[ai][bj][m][0], v1 = acc[ai][bj][m][1];
                    u32x4 w; w.x = pk2(v0.x, v0.y); w.y = pk2(v0.z, v0.w); w.z = pk2(v1.x, v1.y); w.w = pk2(v1.z, v1.w);
                    const int col = u.pn * 256 + wc * 64 + bj * 32 + 8 * fq;
                    if (u.pn < 12) { *(u32x4*)(pqkv + (size_t)t * 3072 + col) = w;
                        if (rr == 0 || rr >= 62) { const int slot = rr == 0 ? 0 : rr - 61; *(u32x4*)(halo + ((size_t)(t >> 6) * 3 + slot) * 3072 + col) = w; } }
                    else if (u.pn < 16) *(u32x4*)(z + (size_t)t * D + (col - 3072)) = w;
                    else if (bj == 0 && wc == 0) { *(f32x4*)(ab + (size_t)t * 32 + 8 * fq) = v0; *(f32x4*)(ab + (size_t)t * 32 + 8 * fq + 4) = v1; } } }
    }
};
DI void p_router(const Frame& F, const KP& p, int l, int ntok) {
    LAS float* A2s = (LAS float*)(F.lds); LAS float* gBs = A2s + 1024; LAS float* gAs = A2s + 2048;
    constexpr int YT_OFF = 12288, YT_ROW = 2064, YT_SIZE = 16 * YT_ROW;
    constexpr int PT_OFF = YT_OFF + 2 * YT_SIZE, PT_SIZE = 8 * 16 * 49 * 4;
    constexpr int PS_OFF = PT_OFF + 2 * PT_SIZE;
    constexpr int LG_OFF = PS_OFF + 1024, RS_OFF = LG_OFF + 16 * 49 * 4, HI_OFF = RS_OFF + 64;
    static_assert(HI_OFF + 256 + 3072 <= LDS_MISC, "router LDS map");
    LAS float* lgs = (LAS float*)(F.lds + LG_OFF);
    LAS float* rsl = (LAS float*)(F.lds + RS_OFF);
    LAS int* hist = (LAS int*)(F.lds + HI_OFF);
    LAS int* basee = (LAS int*)(F.lds + HI_OFF + 128);
    LAS int* tiE = (LAS int*)(F.lds + HI_OFF + 256);
    LAS int* tiP = (LAS int*)(F.lds + HI_OFF + 256 + 1024);
    LAS float* tiW = (LAS float*)(F.lds + HI_OFF + 256 + 2048);
    LAS float* B2s = (LAS float*)(F.lds + LDS_MISC + 1024);
    LAS float* c0s = (LAS float*)(F.lds + LDS_MISC + 1024 + 4096);
    const bf16* DL = (const bf16*)(F.ws + (l == 0 ? WS_YP : WS_Y2));
    const bf16* whi = (const bf16*)(F.ws + WS_WR2) + (size_t)(l * 2) * 48 * D; bf16* HX = (bf16*)(F.ws + WS_HX);
    unsigned* cnt = (unsigned*)(F.ws + WS_CTL) + CW_CNT + l * 32 * CNT_STRIDE;
    Entry* ent = (Entry*)(F.ws + WS_ENT);
    const float* nf = p.in[7] + l * D;
    const int fr = F.lane & 15, fq = F.lane >> 4, kw = 128 * F.wave;
    const int nunits = 256 + (ntok > TL ? 64 : 0);
    auto do_unit = [&](const int un, auto ctxtag) __attribute__((always_inline)) {
        const int t0 = un < 256 ? un * 128 : TL + (un - 256) * 16, nt16 = un < 256 ? 8 : 1, r = mod_row(t0);
        constexpr bool ctxu = decltype(ctxtag)::value;
        bf16x8 bh[4][3];
        { int zo = 0; asm volatile("" : "+s"(zo));
#pragma unroll
          for (int ks = 0; ks < 4; ++ks)
#pragma unroll
            for (int n = 0; n < 3; ++n) { bh[ks][n] = *(const bf16x8*)(whi + zo + (size_t)(16 * n + fr) * D + kw + 32 * ks + 8 * fq); } }
        if (F.tid < 48) c0s[F.tid] = ((const float*)(F.ws + WS_C0))[(l * 5 + r) * 48 + F.tid];
        {
            float vn_[2], vm_[2], vb_[2], vg_[2], vp_[2], vq_[2];
#pragma unroll
            for (int k = 0; k < 2; ++k) { const int i = F.tid + NTHR * k; vn_[k] = nf[i]; vm_[k] = modp(F, l, r, 4)[i]; vb_[k] = modp(F, l, r, 3)[i]; vg_[k] = modp(F, l, r, 2)[i];
                vp_[k] = l == 0 ? p.in[10][i] : 1.f; vq_[k] = l == 0 ? p.in[9][i] : 0.f; }
#pragma unroll
            for (int k = 0; k < 2; ++k) { const int i = F.tid + NTHR * k; A2s[i] = vn_[k] * (vm_[k] + 1.f); B2s[i] = vb_[k]; gAs[i] = vg_[k] * vp_[k]; gBs[i] = vg_[k] * vq_[k] * vp_[k]; } }
        if (F.tid < 32) hist[F.tid] = 0;
        __syncthreads();
        const float* xbase = l == 0 ? (t0 < TL ? p.in[0] + (size_t)t0 * D : p.in[2] + (size_t)(t0 - TL) * D) : nullptr;
        const bf16* xb16 = (l == 0 ? (const bf16*)(F.ws + WS_XN) : (const bf16*)F.out) + (size_t)t0 * D;
        const float* rsp = (const float*)(F.ws + WS_RSTD) + t0;
        bf16* xo16 = (bf16*)(F.ws + (l == 0 ? WS_XS1 : WS_XS3)) + (size_t)t0 * D;
        float* xo32 = (float*)(F.ws + WS_XC) + (size_t)(t0 - TL) * D;
        f32x4 xa[4], xb[4]; u32x4 xq[4], dq[4]; float rsv = 1.f;
#define RT_LOAD(mt_) do { const size_t ro_ = (size_t)(16 * (mt_) + fr) * D + kw + 8 * fq; _Pragma("unroll") for (int ks = 0; ks < 4; ++ks) { \
            if (l == 0 && ctxu) { xa[ks] = *(const f32x4*)(xbase + ro_ + 32 * ks); xb[ks] = *(const f32x4*)(xbase + ro_ + 32 * ks + 4); } else xq[ks] = *(const u32x4*)(xb16 + ro_ + 32 * ks); \
            dq[ks] = *(const u32x4*)(DL + (size_t)t0 * D + ro_ + 32 * ks); } \
            if (l == 0 && !ctxu) rsv = rsp[16 * (mt_) + fr]; } while (0)
        RT_LOAD(0);
        for (int mt = 0; mt < nt16; ++mt) {
            const int bf = mt & 1;
            LAS unsigned char* yt = F.lds + YT_OFF + bf * YT_SIZE; LAS float* part = (LAS float*)(F.lds + PT_OFF + bf * PT_SIZE); LAS float* pss = (LAS float*)(F.lds + PS_OFF + bf * 512);
            { f32x4 acc[3] = {{0.f, 0.f, 0.f, 0.f}, {0.f, 0.f, 0.f, 0.f}, {0.f, 0.f, 0.f, 0.f}}; float ssq = 0.f;
              const size_t ro = (size_t)(16 * mt + fr) * D + kw + 8 * fq;
              const float rinv = (l == 0 && !ctxu) ? __builtin_amdgcn_rcpf(rsv) : 1.f;
#pragma unroll
              for (int ks = 0; ks < 4; ++ks) {
                f32x4 x0, x1; if (l == 0 && ctxu) { x0 = xa[ks]; x1 = xb[ks]; } else { unpk8(xq[ks], x0, x1); if (l == 0) { x0 = x0 * rinv; x1 = x1 * rinv; } }
                { f32x4 da, db; unpk8(dq[ks], da, db); const LAS float* ga = gAs + kw + 32 * ks + 8 * fq; const LAS float* gb = gBs + kw + 32 * ks + 8 * fq;
                  x0 += *(const LAS f32x4*)gb + *(const LAS f32x4*)ga * da; x1 += *(const LAS f32x4*)(gb + 4) + *(const LAS f32x4*)(ga + 4) * db; }
                if (ctxu) { *(f32x4*)(xo32 + ro + 32 * ks) = x0; *(f32x4*)(xo32 + ro + 32 * ks + 4) = x1; } else *(u32x4*)(xo16 + ro + 32 * ks) = pk8(x0, x1);
                ssq += (x0.x * x0.x + x0.y * x0.y) + (x0.z * x0.z + x0.w * x0.w) + (x1.x * x1.x + x1.y * x1.y) + (x1.z * x1.z + x1.w * x1.w);
                const f32x4 y0 = x0 * *(const LAS f32x4*)(A2s + kw + 32 * ks + 8 * fq), y1 = x1 * *(const LAS f32x4*)(A2s + kw + 32 * ks + 8 * fq + 4);
                const u32x4 hq = pk8(y0, y1); f32x4 h0, h1; unpk8(hq, h0, h1);
                const bf16x8 ah = __builtin_bit_cast(bf16x8, hq), al = __builtin_bit_cast(bf16x8, pk8(y0 - h0, y1 - h1));
                *(LAS bf16x8*)(yt + fr * YT_ROW + (kw + 32 * ks + 8 * fq) * 2) = ah;
#pragma unroll
                for (int n = 0; n < 3; ++n) {
                    acc[n] = __builtin_amdgcn_mfma_f32_16x16x32_bf16(ah, bh[ks][n], acc[n], 0, 0, 0);
                    acc[n] = __builtin_amdgcn_mfma_f32_16x16x32_bf16(al, bh[ks][n], acc[n], 0, 0, 0); }
              }
              if (mt + 1 < nt16) RT_LOAD(mt + 1);
              ssq += __shfl_xor(ssq, 16); ssq += __shfl_xor(ssq, 32);
              if (fq == 0) pss[F.wave * 16 + fr] = ssq;
#pragma unroll
              for (int n = 0; n < 3; ++n)
#pragma unroll
                for (int q = 0; q < 4; ++q) part[(F.wave * 16 + 4 * fq + q) * 49 + 16 * n + fr] = acc[n][q]; }
            LDS_BAR();
            if (F.tid < 256) { const int tl = F.tid >> 4, jj = F.tid & 15; float s = 0.f;
#pragma unroll
                for (int w = 0; w < 8; ++w) s += pss[w * 16 + tl];
                const float rstd = rsqrtf(s * (1.f / D) + EPS);
                if (jj == 0) rsl[tl] = rstd;
#pragma unroll
                for (int j = jj; j < 48; j += 16) { float g = 0.f;
#pragma unroll
                    for (int w = 0; w < 8; ++w) g += part[(w * 16 + tl) * 49 + j];
                    lgs[tl * 49 + j] = g * rstd + c0s[j]; } }
            LDS_BAR();
            if (F.tid < 16) {
                const LAS float* lg = lgs + F.tid * 49;
                const float g0 = lg[0], g1 = lg[1], g2 = lg[2], g3 = lg[3];
                int gi = 0; float gm = g0; if (g1 > gm) { gm = g1; gi = 1; } if (g2 > gm) { gm = g2; gi = 2; } if (g3 > gm) { gm = g3; gi = 3; }
                const float pg = 1.f / (__expf(g0 - gm) + __expf(g1 - gm) + __expf(g2 - gm) + __expf(g3 - gm));
                float e1 = -3.0e38f, e2 = -3.0e38f; int i1 = 0, i2 = 0;
#pragma unroll
                for (int j = 0; j < 8; ++j) { const float v = lg[4 + gi * 8 + j];
                    if (v > e1) { e2 = e1; i2 = i1; e1 = v; i1 = j; } else if (v > e2) { e2 = v; i2 = j; } }
                const float w1 = pg / (1.f + __expf(e2 - e1)), w2 = pg - w1;
                const int E0 = gi * 8 + i1, E1 = gi * 8 + i2, tl = 16 * mt + F.tid;
                tiE[tl * 2] = E0; tiE[tl * 2 + 1] = E1; tiW[tl * 2] = w1; tiW[tl * 2 + 1] = w2;
                tiP[tl * 2] = atomicAdd((int*)&hist[E0], 1); tiP[tl * 2 + 1] = atomicAdd((int*)&hist[E1], 1);
            }
#pragma unroll
            for (int kk = 0; kk < 2; ++kk) { const int tk = 2 * F.wave + kk; const float rstd = rsl[tk];
#pragma unroll
                for (int i = 0; i < 2; ++i) { const int c = 8 * F.lane + 512 * i; f32x4 ya, yb; unpk8(*(const LAS u32x4*)(yt + tk * YT_ROW + c * 2), ya, yb);
                    const LAS float* b2 = B2s + c;
                    *(u32x4*)(HX + (size_t)(t0 + 16 * mt + tk) * D + c) = pk8(ya * rstd + *(const LAS f32x4*)b2, yb * rstd + *(const LAS f32x4*)(b2 + 4)); } }
        }
#undef RT_LOAD
        __syncthreads();
        { int tz = threadIdx.x; asm volatile("" : "+v"(tz));
          if (tz < 32) { const int hcount = hist[tz]; basee[tz] = hcount > 0 ? (int)__hip_atomic_fetch_add(cnt + tz * CNT_STRIDE, (unsigned)hcount, __ATOMIC_RELAXED, __HIP_MEMORY_SCOPE_AGENT) : 0; } }
        __syncthreads();
        if (F.tid < 32 * nt16) { const int tl = F.tid >> 1, E = tiE[F.tid], pos = basee[E] + tiP[F.tid]; Entry en; en.ts = (t0 + tl) * 2 + (F.tid & 1); en.w = tiW[F.tid];
            ent[(size_t)E * CAP + pos] = en;
            Entry ti; ti.ts = (E << 16) | pos; ti.w = en.w; ((Entry*)(F.ws + WS_TI))[(size_t)(t0 + tl) * 2 + (F.tid & 1)] = ti; }
        __syncthreads();
    };
    for (int un = F.bid; un < nunits; un += F.G) { if (l == 0 && un >= 256) do_unit(un, std::true_type{}); else do_unit(un, std::false_type{}); }
}

DI void p6_n1(const Frame& F, const KP& p, const LAS int* tb) {
    const int gw = F.bid * NWAVES + F.wave, NGW = F.G * NWAVES;
    const bf16* Y = (const bf16*)(F.ws + WS_Y); bf16* HX = (bf16*)(F.ws + WS_HX); const Entry* TI = (const Entry*)(F.ws + WS_TI);
    if (NGW == 2048) {
        const int c0 = 8 * F.lane;
        Entry na = TI[(size_t)2 * gw], nb = TI[(size_t)2 * gw + 1];
        u32x4 xq[2], y0[2], y1[2]; float w0 = na.w, w1 = nb.w;
        { const size_t r0 = ((size_t)tb[na.ts >> 16] * 256 + (na.ts & 0xffff)) * D, r1 = ((size_t)tb[nb.ts >> 16] * 256 + (nb.ts & 0xffff)) * D;
#pragma unroll
          for (int i = 0; i < 2; ++i) { const int c = c0 + 512 * i; xq[i] = *(const u32x4*)((const bf16*)(F.ws + WS_XS1) + (size_t)gw * D + c); y0[i] = *(const u32x4*)(Y + r0 + c); y1[i] = *(const u32x4*)(Y + r1 + c); } }
        na = TI[(size_t)2 * (gw + NGW)]; nb = TI[(size_t)2 * (gw + NGW) + 1];
        f32x4 g5[2][2], nsc[2][2], sh[2][2];
        for (int k = 0; k < 16; ++k) { const int t = gw + k * NGW;
            if ((k & 3) == 0) { const int r = k >> 2;
#pragma unroll
                for (int i = 0; i < 2; ++i) { const int c = c0 + 512 * i; const float* gp = modp(F, 0, r, 5) + c; const float* nm = p.in[6] + D + c; const float* sc = modp(F, 1, r, 1) + c; const float* shp = modp(F, 1, r, 0) + c;
#pragma unroll
                    for (int q = 0; q < 2; ++q) { g5[i][q] = *(const f32x4*)(gp + 4 * q); nsc[i][q] = *(const f32x4*)(nm + 4 * q) * (*(const f32x4*)(sc + 4 * q) + 1.f); sh[i][q] = *(const f32x4*)(shp + 4 * q); } } }
            u32x4 nxq[2], ny0[2], ny1[2]; float nw0 = 0.f, nw1 = 0.f;
#pragma unroll
            for (int i = 0; i < 2; ++i) { nxq[i] = (u32x4){0u, 0u, 0u, 0u}; ny0[i] = nxq[i]; ny1[i] = nxq[i]; }
            if (k + 1 < 16) { const int tn = t + NGW; nw0 = na.w; nw1 = nb.w;
                const size_t r0 = ((size_t)tb[na.ts >> 16] * 256 + (na.ts & 0xffff)) * D, r1 = ((size_t)tb[nb.ts >> 16] * 256 + (nb.ts & 0xffff)) * D;
#pragma unroll
                for (int i = 0; i < 2; ++i) { const int c = c0 + 512 * i; nxq[i] = *(const u32x4*)((const bf16*)(F.ws + WS_XS1) + (size_t)tn * D + c); ny0[i] = *(const u32x4*)(Y + r0 + c); ny1[i] = *(const u32x4*)(Y + r1 + c); }
                if (k + 2 < 16) { na = TI[(size_t)2 * (tn + NGW)]; nb = TI[(size_t)2 * (tn + NGW) + 1]; } }
            f32x4 va[2], vb[2]; float s = 0.f;
#pragma unroll
            for (int i = 0; i < 2; ++i) { f32x4 a0, b0, a1, b1; unpk8(xq[i], va[i], vb[i]); unpk8(y0[i], a0, b0); unpk8(y1[i], a1, b1);
                va[i] = va[i] + g5[i][0] * (a0 * w0 + a1 * w1); vb[i] = vb[i] + g5[i][1] * (b0 * w0 + b1 * w1);
                *(u32x4*)((bf16*)F.out + (size_t)t * D + c0 + 512 * i) = pk8(va[i], vb[i]);
                s += (va[i].x * va[i].x + va[i].y * va[i].y) + (va[i].z * va[i].z + va[i].w * va[i].w) + (vb[i].x * vb[i].x + vb[i].y * vb[i].y) + (vb[i].z * vb[i].z + vb[i].w * vb[i].w); }
            const float rstd = rsqrtf(wave_sum(s) * (1.f / D) + EPS);
#pragma unroll
            for (int i = 0; i < 2; ++i) { const f32x4 oa = va[i] * rstd * nsc[i][0] + sh[i][0], ob = vb[i] * rstd * nsc[i][1] + sh[i][1];
                *(u32x4*)(HX + (size_t)t * D + c0 + 512 * i) = pk8(oa, ob); }
#pragma unroll
            for (int i = 0; i < 2; ++i) { xq[i] = nxq[i]; y0[i] = ny0[i]; y1[i] = ny1[i]; }
            w0 = nw0; w1 = nw1; }
    }
    for (int t = (NGW == 2048 ? TL : 0) + gw; t < T; t += NGW) {
        const int r = mod_row(t); const bool lat = t < TL;
        float* xr = (float*)(F.ws + WS_XC) + (size_t)(t - TL) * D;
        const bf16* xi16 = (const bf16*)(F.ws + WS_XS1) + (size_t)t * D; bf16* xo16 = (bf16*)F.out + (size_t)t * D;
        const Entry ta = TI[(size_t)2 * t], tbb = TI[(size_t)2 * t + 1]; const float w0 = ta.w, w1 = tbb.w;
        const size_t r0 = ((size_t)tb[ta.ts >> 16] * 256 + (ta.ts & 0xffff)) * D, r1 = ((size_t)tb[tbb.ts >> 16] * 256 + (tbb.ts & 0xffff)) * D;
        f32x4 va[2], vb[2]; u32x4 y0[2], y1[2]; float s = 0.f;
#pragma unroll
        for (int i = 0; i < 2; ++i) { const int c = 8 * F.lane + 512 * i;
            if (lat) unpk8(*(const u32x4*)(xi16 + c), va[i], vb[i]); else { va[i] = *(const f32x4*)(xr + c); vb[i] = *(const f32x4*)(xr + c + 4); }
            y0[i] = *(const u32x4*)(Y + r0 + c); y1[i] = *(const u32x4*)(Y + r1 + c); }
#pragma unroll
        for (int i = 0; i < 2; ++i) { const int c = 8 * F.lane + 512 * i; f32x4 a0, b0, a1, b1; unpk8(y0[i], a0, b0); unpk8(y1[i], a1, b1);
            const float* gp = modp(F, 0, r, 5) + c;
            va[i] = va[i] + *(const f32x4*)gp * (a0 * w0 + a1 * w1); vb[i] = vb[i] + *(const f32x4*)(gp + 4) * (b0 * w0 + b1 * w1);
            if (lat) *(u32x4*)(xo16 + c) = pk8(va[i], vb[i]); else { *(f32x4*)(xr + c) = va[i]; *(f32x4*)(xr + c + 4) = vb[i]; }
            s += (va[i].x * va[i].x + va[i].y * va[i].y) + (va[i].z * va[i].z + va[i].w * va[i].w) + (vb[i].x * vb[i].x + vb[i].y * vb[i].y) + (vb[i].z * vb[i].z + vb[i].w * vb[i].w); }
        const float rstd = rsqrtf(wave_sum(s) * (1.f / D) + EPS);
#pragma unroll
        for (int i = 0; i < 2; ++i) { const int c = 8 * F.lane + 512 * i; const float* nm = p.in[6] + D + c; const float* sc = modp(F, 1, r, 1) + c; const float* sh = modp(F, 1, r, 0) + c;
            const f32x4 oa = va[i] * rstd * (*(const f32x4*)nm * (*(const f32x4*)sc + 1.f)) + *(const f32x4*)sh, ob = vb[i] * rstd * (*(const f32x4*)(nm + 4) * (*(const f32x4*)(sc + 4) + 1.f)) + *(const f32x4*)(sh + 4);
            *(u32x4*)(HX + (size_t)t * D + c) = pk8(oa, ob); }
    }
}

DI bf16x8 lds_frag(LAS unsigned char* base, int byteoff) { return *(const LAS bf16x8*)(base + byteoff); }
DI void p8_c1a(const Frame& F, const KP& p) {
    bf16* PQ = (bf16*)(F.ws + WS_PQKV); const bf16* HALO = (const bf16*)(F.ws + WS_HALO); const float* AB = (const float*)(F.ws + WS_AB);
    float* LM = (float*)(F.ws + WS_LM); bf16* PM = (bf16*)(F.ws + WS_PM); float* GCB = (float*)(F.ws + WS_GCB);
    constexpr int RS = 272;
    LAS unsigned char* qs = F.lds; LAS unsigned char* ks = F.lds + 64 * RS;
    LAS float* KKs = (LAS float*)(F.lds + 34816);
    LAS float* QKs = (LAS float*)(F.lds + 34816 + 17408);
    LAS float* gcs = (LAS float*)(F.lds + 69632);
    LAS float* bes = gcs + 128;
    LAS float* abst = (LAS float*)(F.lds + 70656);
    const bool vw = F.wave >= 4;
    LAS unsigned char* stg = F.lds + 71680 + (vw ? 36864 + (F.wave - 4) * 5120 : F.wave * 9216);
    const int fr = F.lane & 15, fq = F.lane >> 4;
    const int l16 = F.lane & 15, rg = F.lane >> 4, which = vw ? 2 : (F.wave >> 1), half = F.wave & 1;
    const int wrow = vw ? 16 * (F.wave - 4) : 32 * half, rb = wrow + (vw ? 4 : 8) * rg;
#define C1_STAGE(unit_) do { const int cid_ = (unit_) >> 3, h_ = (unit_) & 7, tok0_ = cid_ * 64; \
        const bool first_ = cid_ < 512 ? ((cid_ & 127) == 0) : (((cid_ - 512) & 3) == 0), last_ = cid_ < 512 ? ((cid_ & 127) == 127) : (((cid_ - 512) & 3) == 3); \
        { _Pragma("unroll") for (int q = 0; q < 9; ++q) if (q < (vw ? 5 : 9)) { const int gr = wrow - 2 + 4 * q + rg; \
                const bf16* s_ = PQ + (size_t)(tok0_ + min(max(gr, 0), 63)) * 3072; \
                if (gr < 0 && !first_) s_ = HALO + ((size_t)(cid_ - 1) * 3 + (gr + 3)) * 3072; \
                if (gr == 64 && !last_) s_ = HALO + ((size_t)(cid_ + 1) * 3 + 0) * 3072; \
                __builtin_amdgcn_global_load_lds((const unsigned*)(s_ + which * 1024 + h_ * 128 + 8 * l16), (LAS unsigned*)(stg + q * 1024), 16, 0, 0); } } \
        if (F.wave >= 6) { const int d_ = F.wave - 6, jj_ = d_ ? 63 - F.lane : F.lane; const float* ab_ = AB + (size_t)(tok0_ + jj_) * 32 + (2 * d_) * 8 + h_; \
            __builtin_amdgcn_global_load_lds((const unsigned*)ab_, (LAS unsigned*)(abst + d_ * 128), 4, 0, 0); \
            __builtin_amdgcn_global_load_lds((const unsigned*)(ab_ + 8), (LAS unsigned*)(abst + d_ * 128 + 64), 4, 0, 0); } } while (0)
    if (F.bid < NCID * NH) C1_STAGE(F.bid);
    f32x4 w0[4], w1[4]; float pA = 0.f, pD = 0.f;
    { const int hh = F.bid & 7, col = which * 1024 + hh * 128 + 8 * l16;
#pragma unroll
      for (int k = 0; k < 4; ++k) { w0[k] = (f32x4){0.f, 0.f, 0.f, 0.f}; w1[k] = w0[k]; { w0[k] = *(const f32x4*)(p.in[12] + k * 3072 + col); w1[k] = *(const f32x4*)(p.in[12] + k * 3072 + col + 4); } }
      if (F.wave >= 6) { pA = -__expf(p.in[13][(F.wave - 6) * 8 + hh]); pD = p.in[14][(F.wave - 6) * 8 + hh]; } }
    asm volatile("s_waitcnt vmcnt(0)" ::: "memory");
    for (int unit = F.bid; unit < NCID * NH; unit += F.G) {
        const int cid = unit >> 3, h = unit & 7;
        const int tok0 = cid * 64;
        const bool first = cid < 512 ? ((cid & 127) == 0) : (((cid - 512) & 3) == 0), last = cid < 512 ? ((cid & 127) == 127) : (((cid - 512) & 3) == 3);
        u32x4 res[8];
        const int col = which * 1024 + h * 128 + 8 * l16;
        asm volatile("s_waitcnt vmcnt(4)" ::: "memory");
#define C1_CONV(NR_) do { u32x4 raw[NR_ + 3]; \
            _Pragma("unroll") for (int q = 0; q < NR_ + 3; ++q) { const int gr = rb + q - 2; u32x4 v = *(const LAS u32x4*)(stg + (NR_ * rg + q) * 256 + l16 * 16); \
                if ((gr < 0 && first) || (gr > 63 && last)) v = (u32x4){0u, 0u, 0u, 0u}; \
                raw[q] = v; } \
            _Pragma("unroll") for (int j = 0; j < NR_; ++j) { float o[8]; \
                _Pragma("unroll") for (int e = 0; e < 8; ++e) o[e] = 0.f; \
                _Pragma("unroll") for (int k = 0; k < 4; ++k) { const u32x4 rw = raw[j + k]; \
                    o[0] += bflo(rw.x) * w0[k].x; o[1] += bfhi(rw.x) * w0[k].y; o[2] += bflo(rw.y) * w0[k].z; o[3] += bfhi(rw.y) * w0[k].w; \
                    o[4] += bflo(rw.z) * w1[k].x; o[5] += bfhi(rw.z) * w1[k].y; o[6] += bflo(rw.w) * w1[k].z; o[7] += bfhi(rw.w) * w1[k].w; } \
                float ss = 0.f; \
                _Pragma("unroll") for (int e = 0; e < 8; ++e) { o[e] = siluf(o[e]); ss += o[e] * o[e]; } \
                float sc = 1.f; \
                if (NR_ == 8) { ss += __shfl_xor(ss, 1); ss += __shfl_xor(ss, 2); ss += __shfl_xor(ss, 4); ss += __shfl_xor(ss, 8); \
                    sc = rsqrtf(ss + EPS) * (which == 0 ? 0.08838834764831845f : 1.f); } \
                u32x4 w; w.x = pk2(o[0] * sc, o[1] * sc); w.y = pk2(o[2] * sc, o[3] * sc); w.z = pk2(o[4] * sc, o[5] * sc); w.w = pk2(o[6] * sc, o[7] * sc); \
                res[j] = w; \
                if (NR_ == 8) *(LAS u32x4*)((which == 0 ? qs : ks) + (rb + j) * RS + l16 * 16) = w; } } while (0)
        if (!vw) C1_CONV(8); else C1_CONV(4);
#undef C1_CONV
        if (F.wave >= 6) { const int d = F.wave - 6;
            const float a = abst[d * 128 + F.lane], bb = abst[d * 128 + 64 + F.lane];
            const float g = pA * softplusf_(a + pD); const float be = sigmoidf_(bb);
            float gc = g;
#pragma unroll
            for (int o = 1; o < 64; o <<= 1) { const float up = __shfl_up(gc, o); if (F.lane >= o) gc += up; }
            gcs[d * 64 + F.lane] = gc; bes[d * 64 + F.lane] = be;
            const float eg = __expf(gc), glast = __shfl(gc, 63);
            float* gp = GCB + ((size_t)unit * 2 + d) * 256; gp[F.lane] = be; gp[64 + F.lane] = be * eg; gp[128 + F.lane] = eg; gp[192 + F.lane] = __expf(glast - gc); }
        LDS_BAR();
#pragma unroll
        for (int j = 0; j < 8; ++j) if (j < (vw ? 4 : 8)) *(u32x4*)(PQ + (size_t)(tok0 + rb + j) * 3072 + col) = res[j];
        if (unit + F.G < NCID * NH) C1_STAGE(unit + F.G);
#pragma unroll
        for (int tt = 0; tt < 2; ++tt) { const int ti = 2 * F.wave + tt, mt = ti >> 2, nt = ti & 3;
            f32x4 ak = {0.f, 0.f, 0.f, 0.f}, aq = {0.f, 0.f, 0.f, 0.f};
#pragma unroll
            for (int kk = 0; kk < 4; ++kk) { const int ko = (32 * kk + 8 * fq) * 2;
                const bf16x8 bfr = lds_frag(ks, (16 * nt + fr) * RS + ko), akf = lds_frag(ks, (16 * mt + fr) * RS + ko), aqf = lds_frag(qs, (16 * mt + fr) * RS + ko);
                ak = __builtin_amdgcn_mfma_f32_16x16x32_bf16(akf, bfr, ak, 0, 0, 0); aq = __builtin_amdgcn_mfma_f32_16x16x32_bf16(aqf, bfr, aq, 0, 0, 0); }
#pragma unroll
            for (int r = 0; r < 4; ++r) { KKs[(16 * mt + 4 * fq + r) * 68 + 16 * nt + fr] = ak[r]; QKs[(16 * mt + 4 * fq + r) * 68 + 16 * nt + fr] = aq[r]; } }
        LDS_BAR();
#pragma unroll
        for (int itr = 0; itr < 2; ++itr) { const int idx = (F.tid + NTHR * itr) * 4, i1 = idx >> 6, i2b = idx & 63; f32x4 v;
#pragma unroll
            for (int e = 0; e < 4; ++e) { const int i2 = i2b + e; float x = 0.f;
                if (i2 < i1) x = bes[i1] * KKs[i1 * 68 + i2] * __expf(gcs[i1] - gcs[i2]);
                else if (i2 > i1) { const int j1 = 63 - i1, j2 = 63 - i2; x = bes[64 + j1] * KKs[i1 * 68 + i2] * __expf(gcs[64 + j1] - gcs[64 + j2]); }
                v[e] = x; }
            *(f32x4*)(LM + (size_t)unit * 4096 + idx) = v; }
#pragma unroll
        for (int itr = 0; itr < 2; ++itr) { const int idx = (F.tid + NTHR * itr) * 8, d = idx >> 12, j1 = (idx >> 6) & 63, jb = idx & 63;
            const int t1 = d ? 63 - j1 : j1; float x[8];
#pragma unroll
            for (int e = 0; e < 8; ++e) { const int j2 = jb + e; x[e] = 0.f;
                if (j2 <= j1) { const int t2 = d ? 63 - j2 : j2; x[e] = QKs[t1 * 68 + t2] * __expf(gcs[d * 64 + j1] - gcs[d * 64 + j2]); } }
            u32x4 w; w.x = pk2(x[0], x[1]); w.y = pk2(x[2], x[3]); w.z = pk2(x[4], x[5]); w.w = pk2(x[6], x[7]);
            *(u32x4*)(PM + ((size_t)unit * 2 + d) * 4096 + j1 * 64 + jb) = w; }
        LDS_BAR();
    }
#undef C1_STAGE
}

DI void p9_c1b(const Frame& F) {
    const float* LM = (const float*)(F.ws + WS_LM); bf16* TM = (bf16*)(F.ws + WS_TM);
    constexpr int MS = 68, MSZ = 64 * MS;
    static_assert(8 * MSZ * 4 <= LDS_MISC, "inversion LDS map");
    LAS float* Ls = (LAS float*)(F.lds);
    f32x4 lv[8];
#define C9_LOAD(k0_) do { _Pragma("unroll") for (int itr = 0; itr < 8; ++itr) { const int uqs = itr >> 1; int un_ = F.bid + ((k0_) + uqs) * F.G; const bool ok_ = un_ < NCID * NH; if (!ok_) un_ = F.bid; \
        const f32x4 v_ = *(const f32x4*)(LM + (size_t)un_ * 4096 + (size_t)(F.tid + NTHR * (itr & 1)) * 4); lv[itr] = ok_ ? v_ : (f32x4){0.f, 0.f, 0.f, 0.f}; } } while (0)
    C9_LOAD(0);
    for (int k0 = 0; F.bid + k0 * F.G < NCID * NH; k0 += 4) {
        {
#pragma unroll
            for (int itr = 0; itr < 8; ++itr) { const int uq = itr >> 1, e0 = (F.tid + NTHR * (itr & 1)) * 4, i1 = e0 >> 6;
#pragma unroll
                for (int e = 0; e < 4; ++e) { const int i2 = (e0 & 63) + e; const float v = lv[itr][e];
                    if (i2 < i1) Ls[(uq * 2 + 0) * MSZ + i1 * MS + i2] = v; else if (i2 > i1) Ls[(uq * 2 + 1) * MSZ + (63 - i1) * MS + (63 - i2)] = v; } }
        }
        LDS_BAR();
        C9_LOAD(k0 + 4);
        {
            const int uq = F.wave >> 1, d = F.wave & 1, fr = F.lane & 15, fq = F.lane >> 4;
            LAS float* M = Ls + (uq * 2 + d) * MSZ;
            { LAS float* Mb = M + (16 * fq) * MS + 16 * fq;
              float Td[16];
              Td[0] = (fr == 0) ? 1.f : 0.f;
#pragma unroll
              for (int i = 1; i < 16; ++i) {
                  f32x4 lr[4];
#pragma unroll
                  for (int q = 0; q < (i + 3) / 4; ++q) lr[q] = *(const LAS f32x4*)(Mb + i * MS + 4 * q);
                  float a0 = (fr == i) ? 1.f : 0.f, a1 = 0.f, a2 = 0.f, a3 = 0.f;
#pragma unroll
                  for (int q = 0; q < (i + 3) / 4; ++q) { const f32x4 l4 = lr[q]; const int j4 = 4 * q;
                      a0 -= l4.x * Td[j4];
                      if (j4 + 1 < i) a1 -= l4.y * Td[j4 + 1];
                      if (j4 + 2 < i) a2 -= l4.z * Td[j4 + 2];
                      if (j4 + 3 < i) a3 -= l4.w * Td[j4 + 3]; }
                  Td[i] = (a0 + a1) + (a2 + a3);
              }
#pragma unroll
              for (int i = 0; i < 16; ++i) Mb[i * MS + fr] = Td[i];
            }
            asm volatile("s_waitcnt lgkmcnt(0)" ::: "memory");
#pragma unroll
            for (int dd = 1; dd < 4; ++dd) {
                f32x4 w[3], t[3];
#pragma unroll
                for (int J = 0; J + dd < 4; ++J) { const int I = J + dd; w[J] = (f32x4){0.f, 0.f, 0.f, 0.f};
#pragma unroll
                    for (int K = J; K < I; ++K)
#pragma unroll
                        for (int kk = 0; kk < 4; ++kk) { const float a = M[(16 * I + fr) * MS + 16 * K + 4 * kk + fq], b = M[(16 * J + 4 * kk + fq) * MS + 16 * K + fr];
                            w[J] = __builtin_amdgcn_mfma_f32_16x16x4f32(a, b, w[J], 0, 0, 0); } }
#pragma unroll
                for (int J = 0; J + dd < 4; ++J) { const int I = J + dd;
#pragma unroll
                    for (int r = 0; r < 4; ++r) M[(16 * J + 4 * fq + r) * MS + 16 * I + fr] = w[J][r]; }
                asm volatile("s_waitcnt lgkmcnt(0)" ::: "memory");
#pragma unroll
                for (int J = 0; J + dd < 4; ++J) { const int I = J + dd; t[J] = (f32x4){0.f, 0.f, 0.f, 0.f};
#pragma unroll
                    for (int kk = 0; kk < 4; ++kk) { const float a = M[(16 * I + fr) * MS + 16 * I + 4 * kk + fq], b = M[(16 * J + 4 * kk + fq) * MS + 16 * I + fr];
                        t[J] = __builtin_amdgcn_mfma_f32_16x16x4f32(a, b, t[J], 0, 0, 0); } }
#pragma unroll
                for (int J = 0; J + dd < 4; ++J) { const int I = J + dd;
#pragma unroll
                    for (int r = 0; r < 4; ++r) M[(16 * J + 4 * fq + r) * MS + 16 * I + fr] = -t[J][r]; }
                asm volatile("s_waitcnt lgkmcnt(0)" ::: "memory");
            }
            const int un = F.bid + (k0 + uq) * F.G;
            if (un < NCID * NH) { bf16* dst = TM + ((size_t)un * 2 + d) * 4096;
#pragma unroll
                for (int q = 0; q < 8; ++q) { const int ch = q * 64 + F.lane, i = ch >> 3, col8 = (ch & 7) * 8, I = i >> 4, r = i & 15, J = col8 >> 4, c0 = col8 & 15;
                    f32x4 v0 = {0.f, 0.f, 0.f, 0.f}, v1 = {0.f, 0.f, 0.f, 0.f};
                    if (J <= I) { const LAS float* s = (J < I) ? M + (16 * J + r) * MS + 16 * I + c0 : M + (16 * I + r) * MS + 16 * I + c0;
                        v0 = *(const LAS f32x4*)s; v1 = *(const LAS f32x4*)(s + 4); }
                    *(u32x4*)(dst + (size_t)ch * 8) = pk8(v0, v1); } }
        }
        LDS_BAR();
    }
#undef C9_LOAD
}

typedef short s16x4 __attribute__((ext_vector_type(4)));
constexpr int SB_K = 0, SB_Q = 16384, SB_T = 32768, SB_P = 40960, SB_V = 49152, SB_G = 53248, SB_SIZE = 54272;
constexpr int SW_SBT = 2 * SB_SIZE, SW_XT = SW_SBT + 8704, SW_VNT = SW_XT + 4608, SW_VDT = SW_VNT + 4608;
static_assert(SW_VDT + 4608 <= LDS_MISC, "scan LDS map");
DI unsigned offb(unsigned row, unsigned ch) { return 256u * row + 16u * (ch ^ (((row & 3u) << 2) | ((row >> 2) & 3u))); }
DI unsigned offt(unsigned row, unsigned ch) { return 128u * row + 16u * (ch ^ ((row >> 1) & 7u)); }
#define SC_GLDS(src, ldsoff) __builtin_amdgcn_global_load_lds((const unsigned*)(src), (LAS unsigned*)(F.lds + (ldsoff)), 16, 0, 0)
#define SC_LBAR() do { asm volatile("s_waitcnt lgkmcnt(0)" ::: "memory"); __builtin_amdgcn_s_barrier(); asm volatile("" ::: "memory"); } while (0)
DI void scan_chunk(int s, int b, int d, int& cid, int& outp) {
    if (s < 4) { const int cc = d ? 3 - s : s; cid = 512 + b * 4 + cc; outp = 0; } else { const int c2 = s - 4, cc = d ? 127 - c2 : c2; cid = b * 128 + cc; outp = 1; }
}
DI void scan_issue(const Frame& F, int buf, int s, int b, int h, int d, int v0) {
    const unsigned char* PQ = F.ws + WS_PQKV; const float* GCB = (const float*)(F.ws + WS_GCB);
    int cid, outp; scan_chunk(s, b, d, cid, outp);
    const int tok0 = cid * 64, w = F.wave, L = F.lane, bo = buf * SB_SIZE;
    const size_t mb = ((size_t)(cid * 8 + h) * 2 + d);
    const unsigned char* TMb = F.ws + WS_TM + mb * 8192; const unsigned char* PMb = F.ws + WS_PM + mb * 8192;
#pragma unroll
    for (int ii = 0; ii < 2; ++ii) { const int i = 2 * w + ii, row = 4 * i + (L >> 4), slot = L & 15, ch = slot ^ (((row & 3) << 2) | ((row >> 2) & 3)), tok = tok0 + (d ? 63 - row : row);
        const unsigned off = (unsigned)tok * 6144u + (unsigned)(h * 256 + ch * 16);
        SC_GLDS(PQ + 2048 + off, bo + SB_K + i * 1024); if (outp) SC_GLDS(PQ + off, bo + SB_Q + i * 1024); }
    { const int row = 8 * w + (L >> 3), slot = L & 7, ch = slot ^ ((row >> 1) & 7); const unsigned off = (unsigned)(row * 128 + ch * 16);
        SC_GLDS(TMb + off, bo + SB_T + w * 1024); if (outp) SC_GLDS(PMb + off, bo + SB_P + w * 1024); }
    if (w < 4) { const int row = 16 * w + (L >> 2), c = L & 3, tok = tok0 + (d ? 63 - row : row);
        SC_GLDS(PQ + 4096 + ((unsigned)tok * 6144u + (unsigned)(h * 256 + v0 * 2 + 16 * c)), bo + SB_V + w * 1024); }
    else if (w == 4) SC_GLDS(GCB + mb * 256 + L * 4, bo + SB_G);
}
DI void scan_step(const Frame& F, int buf, int s, int b, int h, int d, int v0, f32x4 (&Sacc)[2], int mt, int nt, int fr, int fq) {
    LAS unsigned char* L = F.lds; LAS unsigned char* B = F.lds + buf * SB_SIZE;
    bf16* OD = (bf16*)(F.ws + WS_O) + (size_t)d * TL * D;
    int cid, outp; scan_chunk(s, b, d, cid, outp);
    const int tok0 = cid * 64;
    f32x4 aX = {0.f, 0.f, 0.f, 0.f}, aO = {0.f, 0.f, 0.f, 0.f};
#pragma unroll
    for (int ks = 0; ks < 4; ++ks) { const bf16x8 sb = *(const LAS bf16x8*)(L + SW_SBT + (16 * nt + fr) * 272 + (32 * ks + 8 * fq) * 2);
        const bf16x8 kA = *(const LAS bf16x8*)(B + SB_K + offb(16 * mt + fr, 4 * ks + fq));
        aX = __builtin_amdgcn_mfma_f32_16x16x32_bf16(kA, sb, aX, 0, 0, 0);
        if (outp) { const bf16x8 qA = *(const LAS bf16x8*)(B + SB_Q + offb(16 * mt + fr, 4 * ks + fq)); aO = __builtin_amdgcn_mfma_f32_16x16x32_bf16(sb, qA, aO, 0, 0, 0); } }
    const LAS unsigned char* Gr = B + SB_G + (16 * mt + 4 * fq) * 4;
    const f32x4 be = *(const LAS f32x4*)Gr, s1 = *(const LAS f32x4*)(Gr + 256), dr = *(const LAS f32x4*)(Gr + 768);
    float x[4];
#pragma unroll
    for (int r = 0; r < 4; ++r) { const float vv = bf2f(*(const LAS unsigned short*)(B + SB_V + (16 * mt + 4 * fq + r) * 64 + (16 * nt + fr) * 2));
        x[r] = vv * be[r] - s1[r] * aX[r]; }
    if (outp) { const float egj = *(const LAS float*)(B + SB_G + 512 + (16 * mt + fr) * 4); aO = aO * egj; }
    { u32x2 w; w.x = pk2(x[0], x[1]); w.y = pk2(x[2], x[3]); *(LAS u32x2*)(L + SW_XT + (16 * nt + fr) * 144 + (16 * mt + 4 * fq) * 2) = w; }
    SC_LBAR();
    f32x4 aV = {0.f, 0.f, 0.f, 0.f};
#pragma unroll
    for (int ks = 0; ks < 2; ++ks) { const bf16x8 xb = *(const LAS bf16x8*)(L + SW_XT + (16 * nt + fr) * 144 + (32 * ks + 8 * fq) * 2);
        const bf16x8 tA = *(const LAS bf16x8*)(B + SB_T + offt(16 * mt + fr, 4 * ks + fq));
        aV = __builtin_amdgcn_mfma_f32_16x16x32_bf16(tA, xb, aV, 0, 0, 0); }
    { u32x2 w; w.x = pk2(aV[0], aV[1]); w.y = pk2(aV[2], aV[3]); *(LAS u32x2*)(L + SW_VNT + (16 * nt + fr) * 144 + (16 * mt + 4 * fq) * 2) = w;
      w.x = pk2(aV[0] * dr[0], aV[1] * dr[1]); w.y = pk2(aV[2] * dr[2], aV[3] * dr[3]); *(LAS u32x2*)(L + SW_VDT + (16 * nt + fr) * 144 + (16 * mt + 4 * fq) * 2) = w; }
    SC_LBAR();
    const float decay = *(const LAS float*)(B + SB_G + 512 + 63 * 4);
    const int w8 = 2 * mt + nt;
    bf16x8 kt[2];
    { const unsigned q4 = (unsigned)fr >> 2, p4 = (unsigned)fr & 3u, kb = (unsigned)(size_t)(B + SB_K) + 8u * (p4 & 1u);
      const unsigned a00 = kb + offb(8 * fq + 0 + q4, 2 * w8 + (p4 >> 1)), a01 = kb + offb(8 * fq + 4 + q4, 2 * w8 + (p4 >> 1));
      const unsigned a10 = kb + offb(32 + 8 * fq + 0 + q4, 2 * w8 + (p4 >> 1)), a11 = kb + offb(32 + 8 * fq + 4 + q4, 2 * w8 + (p4 >> 1));
      s16x4 t00, t01, t10, t11;
      asm volatile("ds_read_b64_tr_b16 %0, %4\n\tds_read_b64_tr_b16 %1, %5\n\tds_read_b64_tr_b16 %2, %6\n\tds_read_b64_tr_b16 %3, %7\n\ts_waitcnt lgkmcnt(0)"
                   : "=&v"(t00), "=&v"(t01), "=&v"(t10), "=&v"(t11) : "v"(a00), "v"(a01), "v"(a10), "v"(a11) : "memory");
      kt[0] = (bf16x8){t00[0], t00[1], t00[2], t00[3], t01[0], t01[1], t01[2], t01[3]};
      kt[1] = (bf16x8){t10[0], t10[1], t10[2], t10[3], t11[0], t11[1], t11[2], t11[3]}; }
#pragma unroll
    for (int n = 0; n < 2; ++n) { Sacc[n] = Sacc[n] * decay;
#pragma unroll
        for (int ks = 0; ks < 2; ++ks) { const bf16x8 vd = *(const LAS bf16x8*)(L + SW_VDT + (16 * n + fr) * 144 + (32 * ks + 8 * fq) * 2);
            Sacc[n] = __builtin_amdgcn_mfma_f32_16x16x32_bf16(kt[ks], vd, Sacc[n], 0, 0, 0); } }
    if (outp) {
#pragma unroll
        for (int ks = 0; ks < 2; ++ks) { const bf16x8 vn = *(const LAS bf16x8*)(L + SW_VNT + (16 * nt + fr) * 144 + (32 * ks + 8 * fq) * 2);
            const bf16x8 pA = *(const LAS bf16x8*)(B + SB_P + offt(16 * mt + fr, 4 * ks + fq));
            aO = __builtin_amdgcn_mfma_f32_16x16x32_bf16(vn, pA, aO, 0, 0, 0); }
    }
#pragma unroll
    for (int n = 0; n < 2; ++n) { u32x2 w; w.x = pk2(Sacc[n][0], Sacc[n][1]); w.y = pk2(Sacc[n][2], Sacc[n][3]);
        *(LAS u32x2*)(L + SW_SBT + (16 * n + fr) * 272 + (16 * w8 + 4 * fq) * 2) = w; }
    if (outp) {
        { const int jc = 16 * mt + fr, tc = tok0 + (d ? 63 - jc : jc); u32x2 w; w.x = pk2(aO[0], aO[1]); w.y = pk2(aO[2], aO[3]);
          *(u32x2*)(OD + (size_t)tc * D + h * 128 + v0 + 16 * nt + 4 * fq) = w; }
        asm volatile("s_waitcnt vmcnt(1)" ::: "memory");
    } else asm volatile("s_waitcnt vmcnt(0)" ::: "memory");
    SC_LBAR();
}
DI void p10_scan(const Frame& F) {
    const int mt = F.wave >> 1, nt = F.wave & 1, fr = F.lane & 15, fq = F.lane >> 4;
    for (int u0 = F.bid; u0 < 256; u0 += F.G) {
        const int xcd = u0 & 7, qq = u0 >> 3, sl = qq & 3, chain = xcd + 8 * (qq >> 2);
        const int d = chain & 1, h = (chain >> 1) & 7, b = chain >> 4, v0 = sl * 32;
        for (int i = F.tid; i < 8704 / 4; i += NTHR) ((LAS unsigned*)(F.lds + SW_SBT))[i] = 0u;
        f32x4 Sacc[2] = {{0.f, 0.f, 0.f, 0.f}, {0.f, 0.f, 0.f, 0.f}};
        scan_issue(F, 0, 0, b, h, d, v0);
        asm volatile("s_waitcnt vmcnt(0)" ::: "memory");
        SC_LBAR();
        for (int s = 0; s < 132; ++s) {
            if (s + 1 < 132) scan_issue(F, (s + 1) & 1, s + 1, b, h, d, v0);
            scan_step(F, s & 1, s, b, h, d, v0, Sacc, mt, nt, fr, fq);
        }
    }
}

DI void p11_onorm(const Frame& F, const KP& p) {
    const int gw = F.bid * NWAVES + F.wave, NGW = F.G * NWAVES;
    const bf16* O0 = (const bf16*)(F.ws + WS_O); const bf16* O1 = O0 + (size_t)TL * D; const bf16* Z = (const bf16*)(F.ws + WS_Z); bf16* HX = (bf16*)(F.ws + WS_HX);
    const int c = 16 * F.lane;
    float nw[16];
#pragma unroll
    for (int q = 0; q < 4; ++q) { const f32x4 v = *(const f32x4*)(p.in[15] + (c & 127) + 4 * q); nw[4 * q] = v.x; nw[4 * q + 1] = v.y; nw[4 * q + 2] = v.z; nw[4 * q + 3] = v.w; }
    u32x4 na[2], nb[2], nz[2];
    if (gw < TL) {
#pragma unroll
        for (int q = 0; q < 2; ++q) { na[q] = *(const u32x4*)(O0 + (size_t)gw * D + c + 8 * q); nb[q] = *(const u32x4*)(O1 + (size_t)gw * D + c + 8 * q); nz[q] = *(const u32x4*)(Z + (size_t)gw * D + c + 8 * q); } }
    for (int t = gw; t < TL; t += NGW) {
        u32x4 ca[2], cb[2], cz[2];
#pragma unroll
        for (int q = 0; q < 2; ++q) { ca[q] = na[q]; cb[q] = nb[q]; cz[q] = nz[q]; }
        if (t + NGW < TL) { const size_t o = (size_t)(t + NGW) * D + c;
#pragma unroll
            for (int q = 0; q < 2; ++q) { na[q] = *(const u32x4*)(O0 + o + 8 * q); nb[q] = *(const u32x4*)(O1 + o + 8 * q); nz[q] = *(const u32x4*)(Z + o + 8 * q); } }
        float o[16], zz[16]; float ss = 0.f;
#pragma unroll
        for (int q = 0; q < 2; ++q) { const u32x4 a = ca[q], bq = cb[q], zq = cz[q];
            o[8 * q + 0] = bflo(a.x) + bflo(bq.x); o[8 * q + 1] = bfhi(a.x) + bfhi(bq.x); o[8 * q + 2] = bflo(a.y) + bflo(bq.y); o[8 * q + 3] = bfhi(a.y) + bfhi(bq.y);
            o[8 * q + 4] = bflo(a.z) + bflo(bq.z); o[8 * q + 5] = bfhi(a.z) + bfhi(bq.z); o[8 * q + 6] = bflo(a.w) + bflo(bq.w); o[8 * q + 7] = bfhi(a.w) + bfhi(bq.w);
            zz[8 * q + 0] = bflo(zq.x); zz[8 * q + 1] = bfhi(zq.x); zz[8 * q + 2] = bflo(zq.y); zz[8 * q + 3] = bfhi(zq.y); zz[8 * q + 4] = bflo(zq.z); zz[8 * q + 5] = bfhi(zq.z); zz[8 * q + 6] = bflo(zq.w); zz[8 * q + 7] = bfhi(zq.w); }
#pragma unroll
        for (int e = 0; e < 16; ++e) ss += o[e] * o[e];
        ss += __shfl_xor(ss, 1); ss += __shfl_xor(ss, 2); ss += __shfl_xor(ss, 4);
        const float rs = rsqrtf(ss * (1.f / 128.f) + EPS);
        unsigned w[8];
#pragma unroll
        for (int e = 0; e < 8; ++e) w[e] = pk2(o[2 * e] * rs * nw[2 * e] * siluf(zz[2 * e]), o[2 * e + 1] * rs * nw[2 * e + 1] * siluf(zz[2 * e + 1]));
        *(u32x4*)(HX + (size_t)t * D + c) = (u32x4){w[0], w[1], w[2], w[3]}; *(u32x4*)(HX + (size_t)t * D + c + 8) = (u32x4){w[4], w[5], w[6], w[7]};
    }
}

DI void p16_final(const Frame& F, const KP& p, const LAS int* tb) {
    const int gw = F.bid * NWAVES + F.wave, NGW = F.G * NWAVES;
    const bf16* Y = (const bf16*)(F.ws + WS_Y); const Entry* TI = (const Entry*)(F.ws + WS_TI);
    if (NGW == 2048) {
        const int c0 = 8 * F.lane;
        Entry na = TI[(size_t)2 * gw], nb = TI[(size_t)2 * gw + 1];
        u32x4 xq[2], y0[2], y1[2]; float w0 = na.w, w1 = nb.w;
        { const size_t r0 = ((size_t)tb[na.ts >> 16] * 256 + (na.ts & 0xffff)) * D, r1 = ((size_t)tb[nb.ts >> 16] * 256 + (nb.ts & 0xffff)) * D;
#pragma unroll
          for (int i = 0; i < 2; ++i) { const int c = c0 + 512 * i; xq[i] = *(const u32x4*)((const bf16*)(F.ws + WS_XS3) + (size_t)gw * D + c); y0[i] = *(const u32x4*)(Y + r0 + c); y1[i] = *(const u32x4*)(Y + r1 + c); } }
        na = TI[(size_t)2 * (gw + NGW)]; nb = TI[(size_t)2 * (gw + NGW) + 1];
        f32x4 g5[2][2], fw[2][2];
#pragma unroll
        for (int i = 0; i < 2; ++i)
#pragma unroll
            for (int q = 0; q < 2; ++q) fw[i][q] = *(const f32x4*)(p.in[24] + c0 + 512 * i + 4 * q);
        for (int k = 0; k < 16; ++k) { const int t = gw + k * NGW;
            if ((k & 3) == 0) { const int r = k >> 2;
#pragma unroll
                for (int i = 0; i < 2; ++i)
#pragma unroll
                    for (int q = 0; q < 2; ++q) g5[i][q] = *(const f32x4*)(modp(F, 1, r, 5) + c0 + 512 * i + 4 * q); }
            u32x4 nxq[2], ny0[2], ny1[2]; float nw0 = 0.f, nw1 = 0.f;
#pragma unroll
            for (int i = 0; i < 2; ++i) { nxq[i] = (u32x4){0u, 0u, 0u, 0u}; ny0[i] = nxq[i]; ny1[i] = nxq[i]; }
            if (k + 1 < 16) { const int tn = t + NGW; nw0 = na.w; nw1 = nb.w;
                const size_t r0 = ((size_t)tb[na.ts >> 16] * 256 + (na.ts & 0xffff)) * D, r1 = ((size_t)tb[nb.ts >> 16] * 256 + (nb.ts & 0xffff)) * D;
#pragma unroll
                for (int i = 0; i < 2; ++i) { const int c = c0 + 512 * i; nxq[i] = *(const u32x4*)((const bf16*)(F.ws + WS_XS3) + (size_t)tn * D + c); ny0[i] = *(const u32x4*)(Y + r0 + c); ny1[i] = *(const u32x4*)(Y + r1 + c); }
                if (k + 2 < 16) { na = TI[(size_t)2 * (tn + NGW)]; nb = TI[(size_t)2 * (tn + NGW) + 1]; } }
            f32x4 va[2], vb[2]; float s = 0.f;
#pragma unroll
            for (int i = 0; i < 2; ++i) { f32x4 a0, b0, a1, b1; unpk8(xq[i], va[i], vb[i]); unpk8(y0[i], a0, b0); unpk8(y1[i], a1, b1);
                va[i] = va[i] + g5[i][0] * (a0 * w0 + a1 * w1); vb[i] = vb[i] + g5[i][1] * (b0 * w0 + b1 * w1);
                s += (va[i].x * va[i].x + va[i].y * va[i].y) + (va[i].z * va[i].z + va[i].w * va[i].w) + (vb[i].x * vb[i].x + vb[i].y * vb[i].y) + (vb[i].z * vb[i].z + vb[i].w * vb[i].w); }
            const float rstd = rsqrtf(wave_sum(s) * (1.f / D) + EPS);
            float* xr = F.out + (size_t)t * D + c0;
#pragma unroll
            for (int i = 0; i < 2; ++i) { *(f32x4*)(xr + 512 * i) = va[i] * rstd * fw[i][0]; *(f32x4*)(xr + 512 * i + 4) = vb[i] * rstd * fw[i][1]; }
#pragma unroll
            for (int i = 0; i < 2; ++i) { xq[i] = nxq[i]; y0[i] = ny0[i]; y1[i] = ny1[i]; }
            w0 = nw0; w1 = nw1; }
        return;
    }
    for (int t = gw; t < TL; t += NGW) {
        const int r = t >> 13; float* xr = F.out + (size_t)t * D; const bf16* xi16 = (const bf16*)(F.ws + WS_XS3) + (size_t)t * D;
        const Entry ta = TI[(size_t)2 * t], tbb = TI[(size_t)2 * t + 1]; const float w0 = ta.w, w1 = tbb.w;
        const size_t r0 = ((size_t)tb[ta.ts >> 16] * 256 + (ta.ts & 0xffff)) * D, r1 = ((size_t)tb[tbb.ts >> 16] * 256 + (tbb.ts & 0xffff)) * D;
        f32x4 va[2], vb[2]; u32x4 y0[2], y1[2]; float s = 0.f;
#pragma unroll
        for (int i = 0; i < 2; ++i) { const int c = 8 * F.lane + 512 * i; unpk8(*(const u32x4*)(xi16 + c), va[i], vb[i]); y0[i] = *(const u32x4*)(Y + r0 + c); y1[i] = *(const u32x4*)(Y + r1 + c); }
#pragma unroll
        for (int i = 0; i < 2; ++i) { const int c = 8 * F.lane + 512 * i; f32x4 a0, b0, a1, b1; unpk8(y0[i], a0, b0); unpk8(y1[i], a1, b1);
            const float* gp = modp(F, 1, r, 5) + c;
            va[i] = va[i] + *(const f32x4*)gp * (a0 * w0 + a1 * w1); vb[i] = vb[i] + *(const f32x4*)(gp + 4) * (b0 * w0 + b1 * w1);
            s += (va[i].x * va[i].x + va[i].y * va[i].y) + (va[i].z * va[i].z + va[i].w * va[i].w) + (vb[i].x * vb[i].x + vb[i].y * vb[i].y) + (vb[i].z * vb[i].z + vb[i].w * vb[i].w); }
        const float rstd = rsqrtf(wave_sum(s) * (1.f / D) + EPS);
#pragma unroll
        for (int i = 0; i < 2; ++i) { const int c = 8 * F.lane + 512 * i; *(f32x4*)(xr + c) = va[i] * rstd * *(const f32x4*)(p.in[24] + c); *(f32x4*)(xr + c + 4) = vb[i] * rstd * *(const f32x4*)(p.in[24] + c + 4); }
    }
}

__global__ void __launch_bounds__(NTHR, 2) fwd_kernel(KP kp) {
    extern __shared__ __attribute__((aligned(16))) unsigned char lds_raw[];
    Frame F;
    F.lds = (LAS unsigned char*)lds_raw; F.tid = threadIdx.x; F.lane = F.tid & 63; F.wave = __builtin_amdgcn_readfirstlane(F.tid >> 6);
    F.bid = blockIdx.x; F.G = gridDim.x; F.ws = kp.ws; F.out = kp.out;
    volatile LAS unsigned* misc = (volatile LAS unsigned*)(F.lds + LDS_MISC);
    if (F.tid < 4) misc[F.tid] = 0u;
    __syncthreads();
    const int lo = kp.ph_lo, hi = kp.ph_hi;
    XcdBarrier bar; bar.bar = (unsigned*)(F.ws + WS_CTL) + CW_BAR; bar.x = 0; bar.st = misc;
    if (hi - lo > 1) bar = xcd_barrier_post((unsigned*)(F.ws + WS_CTL) + CW_BAR, misc);
#ifndef PHSEL
#define PHSEL 0x1FFFF
#endif
#define IN(k) (((PHSEL >> (k)) & 1) && lo <= (k) && (k) < hi)
#define SEAM(k) do { if (IN(k) && IN((k) + 1)) xcd_barrier(bar); } while (0)
    LAS int* tb = (LAS int*)(F.lds + LDS_MISC + 64); LAS int* cn = (LAS int*)(F.lds + LDS_MISC + 64 + 256);
    const float* MOD = (const float*)(F.ws + WS_MOD);

    if (IN(0)) { p0_prologue(F, kp); } SEAM(0);
    if (IN(1)) { p1_pool_diff(F, kp); __syncthreads(); convert_experts(F, kp, 0); } SEAM(1);
    if (IN(2)) { pg8::Gemm g{(const bf16*)(F.ws + WS_DD), (const bf16*)(F.ws + WS_BTP), 256}; PoolOrder S{F.G, F.bid};
        EpiRaw E{(bf16*)(F.ws + WS_YP), 1};
        pg8::gemm_phase<EpiRaw, PoolOrder, false>(F.lds, g, S, E); } SEAM(2);
    if (IN(3)) { p_router(F, kp, 0, T); } SEAM(3);
    if (IN(4)) { moe_tables(F, 0, tb, cn);
        pg8::Gemm g{(const bf16*)(F.ws + WS_HX), (const bf16*)(F.ws + WS_GU), 1024}; MoeOrder S{F.G, F.bid, tb[NE], tb, cn, (const Entry*)(F.ws + WS_ENT)};
        EpiGU E{(bf16*)(F.ws + WS_HID)};
        pg8::gemm_phase<EpiGU, MoeOrder, true>(F.lds, g, S, E); } SEAM(4);
    if (IN(5)) { if (!IN(4)) moe_tables(F, 0, tb, cn);
        pg8::Gemm g{(const bf16*)(F.ws + WS_HID), (const bf16*)(F.ws + WS_DN), 512}; MoeOrder S{F.G, F.bid, tb[NE], tb, cn, (const Entry*)(F.ws + WS_ENT)};
        EpiDown E{(bf16*)(F.ws + WS_Y)};
        pg8::gemm_phase<EpiDown, MoeOrder, false>(F.lds, g, S, E); } SEAM(5);
    if (IN(6)) { if (!IN(4)) moe_tables(F, 0, tb, cn); p6_n1(F, kp, tb); } SEAM(6);
    if (IN(7)) { pg8::Gemm g{(const bf16*)(F.ws + WS_HX), (const bf16*)(F.ws + WS_BTIN), 1024}; G1Order S{F.G, F.bid};
        EpiG1 E{(bf16*)(F.ws + WS_PQKV), (bf16*)(F.ws + WS_Z), (bf16*)(F.ws + WS_HALO), (float*)(F.ws + WS_AB)};
        pg8::gemm_phase<EpiG1, G1Order, false>(F.lds, g, S, E); } SEAM(7);
    if (IN(8)) { p8_c1a(F, kp); asm volatile("s_waitcnt vmcnt(0)" ::: "memory"); __syncthreads(); }
#ifdef PROBE_K
    SEAM(8);
#endif
    if (IN(9)) { p9_c1b(F); } SEAM(9);
    if (IN(10)) { p10_scan(F); } SEAM(10);
    if (IN(11)) { p11_onorm(F, kp); convert_experts(F, kp, 1); } SEAM(11);
    if (IN(12)) { pg8::Gemm g{(const bf16*)(F.ws + WS_HX), (const bf16*)(F.ws + WS_BTOUT), 1024}; G2Order S{F.G, F.bid};
        EpiRaw E{(bf16*)(F.ws + WS_Y2), 0};
        pg8::gemm_phase<EpiRaw, G2Order, false>(F.lds, g, S, E); } SEAM(12);
    if (IN(13)) { p_router(F, kp, 1, TL); } SEAM(13);
    if (IN(14)) { moe_tables(F, 1, tb, cn);
        pg8::Gemm g{(const bf16*)(F.ws + WS_HX), (const bf16*)(F.ws + WS_GU), 1024}; MoeOrder S{F.G, F.bid, tb[NE], tb, cn, (const Entry*)(F.ws + WS_ENT)};
        EpiGU E{(bf16*)(F.ws + WS_HID)};
        pg8::gemm_phase<EpiGU, MoeOrder, true>(F.lds, g, S, E); } SEAM(14);
    if (IN(15)) { if (!IN(14)) moe_tables(F, 1, tb, cn);
        pg8::Gemm g{(const bf16*)(F.ws + WS_HID), (const bf16*)(F.ws + WS_DN), 512}; MoeOrder S{F.G, F.bid, tb[NE], tb, cn, (const Entry*)(F.ws + WS_ENT)};
        EpiDown E{(bf16*)(F.ws + WS_Y)};
        pg8::gemm_phase<EpiDown, MoeOrder, false>(F.lds, g, S, E); } SEAM(15);
    if (IN(16)) { if (!IN(14)) moe_tables(F, 1, tb, cn); p16_final(F, kp, tb); }
#undef IN
#undef SEAM
}

extern "C" void kernel_launch(void* const* d_in, const int* in_sizes, int n_in, void* d_out, int out_size, void* d_ws, size_t ws_size, hipStream_t stream) {
    static int grid = 0;
    if (grid == 0) {
        if (n_in != 25 || out_size != TL * D || ws_size < WS_END) { fprintf(stderr, "kernel_launch: unexpected shapes (n_in %d, out %d, ws %zu < %zu)\n", n_in, out_size, ws_size, (size_t)WS_END); grid = -1; return; }
        int dev = 0, cus = 0, per_cu = 0;
        if (hipGetDevice(&dev) != hipSuccess || hipDeviceGetAttribute(&cus, hipDeviceAttributeMultiprocessorCount, dev) != hipSuccess) { grid = -1; return; }
        if (hipFuncSetAttribute((const void*)fwd_kernel, hipFuncAttributeMaxDynamicSharedMemorySize, LDS_BYTES) != hipSuccess) { fprintf(stderr, "kernel_launch: hipFuncSetAttribute failed\n"); grid = -1; return; }
        if (hipOccupancyMaxActiveBlocksPerMultiprocessor(&per_cu, (const void*)fwd_kernel, NTHR, LDS_BYTES) != hipSuccess || per_cu < 1) fprintf(stderr, "kernel_launch: occupancy query says %d\n", per_cu);
        (void)hipGetLastError();
        grid = cus & ~7;
    }
    if (grid < 0) return;
    (void)hipMemsetAsync((char*)d_ws + WS_CTL, 0, CTL_BYTES, stream);
    KP kp{};
    for (int i = 0; i < 25; ++i) kp.in[i] = (const float*)d_in[i];
    kp.out = (float*)d_out; kp.ws = (unsigned char*)d_ws;
#if MK_ONE_LAUNCH
    kp.ph_lo = 0; kp.ph_hi = PH_N;
    hipLaunchKernelGGL(fwd_kernel, dim3(grid), dim3(NTHR), LDS_BYTES, stream, kp);
#else
    for (int ph = 0; ph < PH_N; ++ph) { kp.ph_lo = ph; kp.ph_hi = ph + 1; hipLaunchKernelGGL(fwd_kernel, dim3(grid), dim3(NTHR), LDS_BYTES, stream, kp); }
#endif
}
```
